# Optimizing an MI355X kernel written in HIP

```python
import jax, jax.numpy as jnp
from jax import lax
import numpy as np

D_MODEL = 1024
BATCH = 16
SEQ = 4096
DEPTH = 1
DEC_BATCH = 32
DEC_SEQ = 16
PAST_LEN = 4096

CHUNK = 64
POOL_WIDTH = D_MODEL // 1
POOL_GROUPS = 4
POOL_GROUP_DIM = POOL_WIDTH // POOL_GROUPS
POOL_WINDOWS = (2, 4, 8, 16)
POOL_HIST = max(POOL_WINDOWS) - 1
SSD_WIDTH = D_MODEL
SSD_HEAD_DIM = 64
SSD_HEADS = SSD_WIDTH // SSD_HEAD_DIM
SSD_GROUPS = 2
SSD_HEADS_PER_GROUP = SSD_HEADS // SSD_GROUPS
SSD_STATE = 128
SSD_CONV = 4
SSD_CHUNK = CHUNK
CONV_DIM = SSD_WIDTH + 2 * SSD_GROUPS * SSD_STATE
MIX_WIDTH = POOL_WIDTH + SSD_WIDTH
D_IN_PROJ = POOL_WIDTH + SSD_WIDTH + CONV_DIM + SSD_HEADS
D_FF = 4 * D_MODEL
EPS = 1e-6

kernel_name = "hymba_pool_ssd_streaming_step"


def rms_norm(x, w):
    xf = x.astype(jnp.float32)
    y = xf * lax.rsqrt(jnp.mean(xf * xf, axis=-1, keepdims=True) + EPS)
    return y.astype(x.dtype) * w


def pool_mixer(u, hist, pos0, pool_w, pool_b, pool_scale):
    b, L, _ = u.shape
    full = jnp.concatenate([hist, u], axis=1)
    cs = jnp.cumsum(full.astype(jnp.float32), axis=1)
    cs = jnp.concatenate([jnp.zeros((b, 1, POOL_WIDTH), jnp.float32), cs], axis=1)
    end = cs[:, POOL_HIST + 1:]
    pos = (jnp.arange(L) + pos0).astype(jnp.float32)
    means = []
    for g, w in enumerate(POOL_WINDOWS):
        lo, hi = g * POOL_GROUP_DIM, (g + 1) * POOL_GROUP_DIM
        start = cs[:, POOL_HIST + 1 - w:POOL_HIST + 1 - w + L, lo:hi]
        cnt = jnp.minimum(jnp.float32(w), pos + 1.0)[None, :, None]
        means.append((end[:, :, lo:hi] - start) / cnt)
    pooled = jnp.stack(means, axis=2) - u.reshape(b, L, POOL_GROUPS, POOL_GROUP_DIM).astype(jnp.float32)
    out = jnp.einsum('blgc,gcd->blgd', pooled.astype(u.dtype), pool_w) + pool_b
    return out.reshape(b, L, POOL_WIDTH) * pool_scale, full[:, -POOL_HIST:]


def causal_conv(xbc, hist, conv_w, conv_b):
    L = xbc.shape[1]
    full = jnp.concatenate([hist, xbc], axis=1)
    out = conv_b
    for k in range(SSD_CONV):
        out = out + conv_w[k] * full[:, k:k + L]
    return jax.nn.silu(out), full[:, -(SSD_CONV - 1):]


def ssd_scan(xh, dt, A, Bm, Cm, h0):
    b, L, H, P = xh.shape
    G, Hg, N = SSD_GROUPS, SSD_HEADS_PER_GROUP, SSD_STATE
    Q = min(SSD_CHUNK, L)
    nc = L // Q
    x = xh.astype(jnp.float32).reshape(b, nc, Q, G, Hg, P)
    dtc = dt.reshape(b, nc, Q, G, Hg)
    Bc = Bm.astype(jnp.float32).reshape(b, nc, Q, G, N)
    Cc = Cm.astype(jnp.float32).reshape(b, nc, Q, G, N)
    a = dtc * A.reshape(G, Hg)
    acs = jnp.moveaxis(jnp.cumsum(a, axis=2), 2, -1)
    xdt = x * dtc[..., None]
    mask = jnp.tril(jnp.ones((Q, Q), dtype=bool))
    seg = acs[..., :, None] - acs[..., None, :]
    Lmat = jnp.where(mask, jnp.exp(jnp.where(mask, seg, 0.0)), 0.0)
    CB = jnp.einsum('bcign,bcjgn->bcgij', Cc, Bc)
    M = CB[:, :, :, None] * Lmat
    y_diag = jnp.einsum('bcghij,bcjghp->bcighp', M, xdt)
    decay_states = jnp.exp(acs[..., -1:] - acs)
    states = jnp.einsum('bcjgn,bcghj,bcjghp->bcghpn', Bc, decay_states, xdt)
    chunk_decay = jnp.exp(acs[..., -1])

    def step(h, inp):
        dec, st = inp
        return h * dec[..., None, None] + st, h

    h_init = h0.astype(jnp.float32).reshape(b, G, Hg, P, N)
    h_final, h_enter = lax.scan(step, h_init, (jnp.moveaxis(chunk_decay, 1, 0), jnp.moveaxis(states, 1, 0)))
    h_enter = jnp.moveaxis(h_enter, 0, 1)
    y_off = jnp.einsum('bcign,bcghpn,bcghi->bcighp', Cc, h_enter, jnp.exp(acs))
    y = (y_diag + y_off).reshape(b, L, H, P)
    return y, h_final.reshape(b, H, P, N)


def ssd_mixer(z, xbc, dt_raw, conv_hist, h0, conv_w, conv_b, dt_bias, a_log, d_skip, ssd_norm_w):
    b, L, _ = z.shape
    xbc, new_conv = causal_conv(xbc, conv_hist, conv_w, conv_b)
    xs, Bm, Cm = jnp.split(xbc, [SSD_WIDTH, SSD_WIDTH + SSD_GROUPS * SSD_STATE], axis=-1)
    xh = xs.reshape(b, L, SSD_HEADS, SSD_HEAD_DIM)
    Bm = Bm.reshape(b, L, SSD_GROUPS, SSD_STATE)
    Cm = Cm.reshape(b, L, SSD_GROUPS, SSD_STATE)
    dt = jax.nn.softplus(dt_raw.astype(jnp.float32) + dt_bias.astype(jnp.float32))
    A = -jnp.exp(a_log.astype(jnp.float32))
    y, h_new = ssd_scan(xh, dt, A, Bm, Cm, h0)
    y = y + d_skip.astype(jnp.float32)[:, None] * xh.astype(jnp.float32)
    y = y.reshape(b, L, SSD_WIDTH) * jax.nn.silu(z.astype(jnp.float32))
    yg = y.reshape(b, L, SSD_GROUPS, SSD_WIDTH // SSD_GROUPS)
    yg = yg * lax.rsqrt(jnp.mean(yg * yg, axis=-1, keepdims=True) + EPS)
    y = yg.reshape(b, L, SSD_WIDTH).astype(z.dtype) * ssd_norm_w
    return y, new_conv, h_new.astype(h0.dtype)


def trunk_layer(x, c, pool_hist, conv_hist, h0, pos0, norm_mix_w, norm_ffn_w, w_ada, b_ada, w_in,
                pool_w, pool_b, pool_scale, conv_w, conv_b, dt_bias, a_log, d_skip, ssd_norm_w,
                w_out, w_ff1, b_ff1, w_ff2, b_ff2):
    mod = (jax.nn.silu(c) @ w_ada + b_ada)[:, None, :]
    sh1, sc1, g1, sh2, sc2, g2 = jnp.split(mod, 6, axis=-1)
    h = rms_norm(x, norm_mix_w) * (1.0 + sc1) + sh1
    proj = h @ w_in
    u, z, xbc, dt_raw = jnp.split(proj, [POOL_WIDTH, POOL_WIDTH + SSD_WIDTH,
                                         POOL_WIDTH + SSD_WIDTH + CONV_DIM], axis=-1)
    ya, new_pool = pool_mixer(u, pool_hist, pos0, pool_w, pool_b, pool_scale)
    yb, new_conv, new_h = ssd_mixer(z, xbc, dt_raw, conv_hist, h0, conv_w, conv_b,
                                    dt_bias, a_log, d_skip, ssd_norm_w)
    x = x + g1 * (jnp.concatenate([ya, yb], axis=-1) @ w_out)
    h = rms_norm(x, norm_ffn_w) * (1.0 + sc2) + sh2
    f = jnp.square(jax.nn.relu(h @ w_ff1 + b_ff1)) @ w_ff2 + b_ff2
    x = x + g2 * f
    return x, new_pool, new_conv, new_h


def setup_inputs(seed: int = 0) -> dict:
    key = jax.random.key(seed)
    ks = jax.random.split(key, 32)
    f32 = jnp.float32
    nrm = lambda k, shape, s=1.0: jax.random.normal(k, shape, f32) * s
    dt0 = jnp.exp(jax.random.uniform(ks[17], (DEPTH, SSD_HEADS), f32) * (np.log(0.1) - np.log(0.001)) + np.log(0.001))
    dt_bias = dt0 + jnp.log(-jnp.expm1(-dt0))
    return {
        "x_prompt": nrm(ks[0], (BATCH, SEQ, D_MODEL)),
        "x_sample": nrm(ks[1], (DEC_BATCH, DEC_SEQ, D_MODEL)),
        "cache_pool": nrm(ks[2], (DEPTH, DEC_BATCH, POOL_HIST, POOL_WIDTH)),
        "cache_conv": nrm(ks[3], (DEPTH, DEC_BATCH, SSD_CONV - 1, CONV_DIM)),
        "state_ssm": nrm(ks[4], (DEPTH, DEC_BATCH, SSD_HEADS, SSD_HEAD_DIM, SSD_STATE), 0.5),
        "c_prompt": nrm(ks[5], (BATCH, D_MODEL)),
        "c_sample": nrm(ks[6], (DEC_BATCH, D_MODEL)),
        "norm_mix_w": 1.0 + nrm(ks[7], (DEPTH, D_MODEL), 0.05),
        "norm_ffn_w": 1.0 + nrm(ks[8], (DEPTH, D_MODEL), 0.05),
        "w_ada": nrm(ks[9], (DEPTH, D_MODEL, 6 * D_MODEL), 0.5 * D_MODEL ** -0.5),
        "b_ada": nrm(ks[10], (DEPTH, 6 * D_MODEL), 0.02),
        "w_in": nrm(ks[11], (DEPTH, D_MODEL, D_IN_PROJ), D_MODEL ** -0.5),
        "pool_w": nrm(ks[12], (DEPTH, POOL_GROUPS, POOL_GROUP_DIM, POOL_GROUP_DIM), POOL_GROUP_DIM ** -0.5),
        "pool_b": nrm(ks[13], (DEPTH, POOL_GROUPS, POOL_GROUP_DIM), 0.02),
        "pool_scale": 1.0 + nrm(ks[14], (DEPTH, POOL_WIDTH), 0.1),
        "conv_w": nrm(ks[15], (DEPTH, SSD_CONV, CONV_DIM), 0.5),
        "conv_b": nrm(ks[16], (DEPTH, CONV_DIM), 0.02),
        "dt_bias": dt_bias,
        "a_log": jnp.log(jax.random.uniform(ks[18], (DEPTH, SSD_HEADS), f32, 1.0, 16.0)),
        "d_skip": 1.0 + nrm(ks[19], (DEPTH, SSD_HEADS), 0.1),
        "ssd_norm_w": 1.0 + nrm(ks[20], (DEPTH, SSD_WIDTH), 0.05),
        "w_out": nrm(ks[21], (DEPTH, MIX_WIDTH, D_MODEL), MIX_WIDTH ** -0.5),
        "w_ff1": nrm(ks[22], (DEPTH, D_MODEL, D_FF), D_MODEL ** -0.5),
        "b_ff1": nrm(ks[23], (DEPTH, D_FF), 0.02),
        "w_ff2": nrm(ks[24], (DEPTH, D_FF, D_MODEL), D_FF ** -0.5),
        "b_ff2": nrm(ks[25], (DEPTH, D_MODEL), 0.02),
        "final_norm_w": 1.0 + nrm(ks[26], (D_MODEL,), 0.05),
    }


def reference(x_prompt, x_sample, cache_pool, cache_conv, state_ssm, c_prompt, c_sample,
              norm_mix_w, norm_ffn_w, w_ada, b_ada, w_in, pool_w, pool_b, pool_scale,
              conv_w, conv_b, dt_bias, a_log, d_skip, ssd_norm_w, w_out,
              w_ff1, b_ff1, w_ff2, b_ff2, final_norm_w):
    dt = x_prompt.dtype
    xp, xs = x_prompt, x_sample
    pool_p, conv_p, ssm_p = [], [], []
    pool_s, conv_s, ssm_s = [], [], []
    for l in range(DEPTH):
        w = (norm_mix_w[l], norm_ffn_w[l], w_ada[l], b_ada[l], w_in[l], pool_w[l], pool_b[l],
             pool_scale[l], conv_w[l], conv_b[l], dt_bias[l], a_log[l], d_skip[l], ssd_norm_w[l],
             w_out[l], w_ff1[l], b_ff1[l], w_ff2[l], b_ff2[l])
        zp = jnp.zeros((BATCH, POOL_HIST, POOL_WIDTH), dt)
        zc = jnp.zeros((BATCH, SSD_CONV - 1, CONV_DIM), dt)
        zh = jnp.zeros((BATCH, SSD_HEADS, SSD_HEAD_DIM, SSD_STATE), dt)
        xp, npool, nconv, nh = trunk_layer(xp, c_prompt, zp, zc, zh, 0, *w)
        pool_p.append(npool); conv_p.append(nconv); ssm_p.append(nh)
        xs, npool, nconv, nh = trunk_layer(xs, c_sample, cache_pool[l], cache_conv[l], state_ssm[l], PAST_LEN, *w)
        pool_s.append(npool); conv_s.append(nconv); ssm_s.append(nh)
    y_prompt = rms_norm(xp, final_norm_w)
    y_sample = rms_norm(xs, final_norm_w)
    return (y_prompt, y_sample, jnp.stack(pool_p, 0), jnp.stack(conv_p, 0), jnp.stack(ssm_p, 0),
            jnp.stack(pool_s, 0), jnp.stack(conv_s, 0), jnp.stack(ssm_s, 0))
```

```cpp
#include <hip/hip_runtime.h>
#include <hip/hip_cooperative_groups.h>
#include <cstdio>
#include <cstdint>
namespace cg = cooperative_groups;

constexpr int DM = 1024, NB_P = 16, SEQ = 4096, NB_S = 32, DSEQ = 16;
constexpr int MP = NB_P * SEQ, MS = NB_S * DSEQ, MT = MP + MS, NBT = NB_P + NB_S;
constexpr int NPROJ = 3584, LDWIN = 3600, DFF = 4096, MIXW = 2048, CONVD = 1536, NH = 16, HD = 64, NST = 128, NMOD = 6 * DM;
constexpr float EPS = 1e-6f;
constexpr size_t O_Y = 0, O_PP = (size_t)MT * DM, O_CP = O_PP + (size_t)NB_P * 15 * DM, O_SP = O_CP + (size_t)NB_P * 3 * CONVD,
                 O_PS = O_SP + (size_t)NB_P * NH * HD * NST, O_CS = O_PS + (size_t)NB_S * 15 * DM, O_SS = O_CS + (size_t)NB_S * 3 * CONVD,
                 O_END = O_SS + (size_t)NB_S * NH * HD * NST;
namespace pg8 {
#define PG8_LAS __attribute__((address_space(3)))
typedef unsigned short bf16_t;
typedef short bf16x8 __attribute__((ext_vector_type(8)));
typedef float f32x4 __attribute__((ext_vector_type(4)));
typedef unsigned u32x4 __attribute__((ext_vector_type(4)));
constexpr int BM = 256, BK = 64, HALF = 128, HTB = HALF * BK * 2  , STAGE_BYTES = 8 * HTB, NXCD = 8, WGM = 8;

__host__ __device__ __forceinline__ int lds_byte(int r, int c) { const int st = (r >> 4) * 2 + (c >> 5), rr = r & 15, cc = c & 31, ob = rr * 64 + cc * 2; return st * 1024 + (ob ^ (((ob >> 9) & 1) << 5)); }
__host__ __device__ __forceinline__ void stage_rc(int b, int& R, int& C) { const int st = b / 1024, sb = b % 1024, swz = sb ^ (((sb >> 9) & 1) << 5); R = (st >> 1) * 16 + swz / 64; C = (st & 1) * 32 + (swz % 64) / 2; }
__host__ __device__ __forceinline__ int perm32(int rho) { const int n = rho >> 4, i = rho & 15; return 8 * (i >> 2) + 4 * n + (i & 3); }

struct Unit { int pm, pn; };
struct Gemm { const bf16_t* A; const bf16_t* Bt; int M, N, K; };

struct StaticOrder {
    int nM, nN, nwg, G, c;
    __host__ __device__ void init(int M, int N, int G_, int c_) { nM = M / BM; nN = N / BM; nwg = nM * nN; G = G_; c = c_; }
    __host__ __device__ bool next(int i, Unit& u) const {
        const long L = (long)i * G + c; if (L >= nwg) return false;
        int wgid = (int)L; { const int q = nwg / NXCD, r = nwg % NXCD, xcd = wgid % NXCD, off = wgid / NXCD; wgid = (xcd < r ? xcd * (q + 1) : r * (q + 1) + (xcd - r) * q) + off; }
        const int nig = WGM * nN, gid = wgid / nig, fm = gid * WGM, gsz = (nM - fm) < WGM ? (nM - fm) : WGM;
        u.pm = fm + ((wgid % nig) % gsz); u.pn = (wgid % nig) / gsz; return true;
    }
    __device__ __forceinline__ void a_ready(const Unit&) const {}
    __device__ __forceinline__ void done(const Unit&) const {}
};
__device__ __forceinline__ unsigned cvt_pk_bf16(float lo, float hi) { unsigned r; asm volatile("v_cvt_pk_bf16_f32 %0, %1, %2" : "=v"(r) : "v"(lo), "v"(hi)); return r; }
typedef unsigned u32x2 __attribute__((ext_vector_type(2)));
struct EpiProj {
    static constexpr bool PERM = true, AFTER_DRAIN = false;
    bf16_t* O; float* out;
    size_t o_pp, o_cp, o_ps, o_cs;
    __device__ __forceinline__ void operator()(const f32x4 (&acc)[2][2][4][2], const Unit& u, int wr, int wc, int fr, int fq) const {
        const int row0 = u.pm * BM + wr * 64 + fr, col0 = u.pn * BM + wc * 32 + 8 * fq;
#pragma unroll
        for (int ai = 0; ai < 2; ++ai)
#pragma unroll
            for (int m = 0; m < 4; ++m) { bf16_t* rowp = O + (size_t)(row0 + ai * HALF + m * 16) * 3584 + col0;
#pragma unroll
                for (int bj = 0; bj < 2; ++bj) { const f32x4 v0 = acc[ai][bj][m][0], v1 = acc[ai][bj][m][1];
                    u32x4 w; w.x = cvt_pk_bf16(v0[0], v0[1]); w.y = cvt_pk_bf16(v0[2], v0[3]); w.z = cvt_pk_bf16(v1[0], v1[1]); w.w = cvt_pk_bf16(v1[2], v1[3]);
                    *(u32x4*)(rowp + bj * HALF) = w; } }
        const bool is_u = u.pn < 4, is_c = u.pn >= 8;
        if (!(is_u || is_c)) return;
        if (u.pm < 256) {
            if ((u.pm & 15) != 15 || wr != 1) return;
            const int b = u.pm >> 4, lr = 240 + fr;
            if (is_u) { if (fr >= 1) { float* dst = out + o_pp + ((size_t)(b * 15 + (fr - 1)) * 1024 + col0);
#pragma unroll
                    for (int bj = 0; bj < 2; ++bj) { *(f32x4*)(dst + bj * HALF) = acc[1][bj][3][0]; *(f32x4*)(dst + bj * HALF + 4) = acc[1][bj][3][1]; } } }
            else { if (fr >= 13) { float* dst = out + o_cp + ((size_t)(b * 3 + (fr - 13)) * 1536 + (col0 - 2048));
#pragma unroll
                    for (int bj = 0; bj < 2; ++bj) { *(f32x4*)(dst + bj * HALF) = acc[1][bj][3][0]; *(f32x4*)(dst + bj * HALF + 4) = acc[1][bj][3][1]; } } }
            (void)lr;
        } else {
#pragma unroll
            for (int ai = 0; ai < 2; ++ai)
#pragma unroll
                for (int m = 0; m < 4; ++m) { const int sb = (u.pm - 256) * 16 + 8 * ai + 4 * wr + m;
                    if (is_u) { if (fr >= 1) { float* dst = out + o_ps + ((size_t)(sb * 15 + (fr - 1)) * 1024 + col0);
#pragma unroll
                            for (int bj = 0; bj < 2; ++bj) { *(f32x4*)(dst + bj * HALF) = acc[ai][bj][m][0]; *(f32x4*)(dst + bj * HALF + 4) = acc[ai][bj][m][1]; } } }
                    else { if (fr >= 13) { float* dst = out + o_cs + ((size_t)(sb * 3 + (fr - 13)) * 1536 + (col0 - 2048));
#pragma unroll
                            for (int bj = 0; bj < 2; ++bj) { *(f32x4*)(dst + bj * HALF) = acc[ai][bj][m][0]; *(f32x4*)(dst + bj * HALF + 4) = acc[ai][bj][m][1]; } } } }
        }
    }
};
struct EpiRelu2 {
    static constexpr bool PERM = true, AFTER_DRAIN = false;
    bf16_t* O; const float* bias;
    __device__ __forceinline__ void operator()(const f32x4 (&acc)[2][2][4][2], const Unit& u, int wr, int wc, int fr, int fq) const {
        const int row0 = u.pm * BM + wr * 64 + fr, col0 = u.pn * BM + wc * 32 + 8 * fq;
        f32x4 bv[2][2];
#pragma unroll
        for (int bj = 0; bj < 2; ++bj)
#pragma unroll
            for (int n = 0; n < 2; ++n) bv[bj][n] = *(const f32x4*)(bias + col0 + bj * HALF + 4 * n);
#pragma unroll
        for (int ai = 0; ai < 2; ++ai)
#pragma unroll
            for (int m = 0; m < 4; ++m) { bf16_t* rowp = O + (size_t)(row0 + ai * HALF + m * 16) * 4096 + col0;
#pragma unroll
                for (int bj = 0; bj < 2; ++bj) { f32x4 v0 = acc[ai][bj][m][0] + bv[bj][0], v1 = acc[ai][bj][m][1] + bv[bj][1];
#pragma unroll
                    for (int j = 0; j < 4; ++j) { const float a = fmaxf(v0[j], 0.f), b = fmaxf(v1[j], 0.f); v0[j] = a * a; v1[j] = b * b; }
                    u32x4 w; w.x = cvt_pk_bf16(v0[0], v0[1]); w.y = cvt_pk_bf16(v0[2], v0[3]); w.z = cvt_pk_bf16(v1[0], v1[1]); w.w = cvt_pk_bf16(v1[2], v1[3]);
                    *(u32x4*)(rowp + bj * HALF) = w; } }
    }
};
struct EpiRes {
    static constexpr bool PERM = false, AFTER_DRAIN = false;
    const float* baseP; const float* baseS;
    float* out;
    const float* bias;
    const float* gate;
    __device__ __forceinline__ void operator()(const f32x4 (&acc)[2][2][4][2], const Unit& u, int wr, int wc, int fr, int fq) const {
        const bool smp = u.pm >= 256;
        const float* bp = smp ? baseS + (size_t)(u.pm - 256) * BM * 1024 : baseP + (size_t)u.pm * BM * 1024;
        float* op = out + (size_t)u.pm * BM * 1024;
        const int col0 = u.pn * BM + wc * 32 + 4 * fq;
        f32x4 bv[2][2];
#pragma unroll
        for (int bj = 0; bj < 2; ++bj)
#pragma unroll
            for (int n = 0; n < 2; ++n) bv[bj][n] = *(const f32x4*)(bias + col0 + bj * HALF + n * 16);
#pragma unroll
        for (int ai = 0; ai < 2; ++ai)
#pragma unroll
            for (int m = 0; m < 4; ++m) { const int lr = ai * HALF + wr * 64 + m * 16 + fr;
                const int b = smp ? 16 + (u.pm - 256) * 16 + (lr >> 4) : (u.pm >> 4);
                const float* gp = gate + (size_t)b * 6144 + col0; const size_t off = (size_t)lr * 1024 + col0;
#pragma unroll
                for (int bj = 0; bj < 2; ++bj)
#pragma unroll
                    for (int n = 0; n < 2; ++n) { const f32x4 g = *(const f32x4*)(gp + bj * HALF + n * 16), x = *(const f32x4*)(bp + off + bj * HALF + n * 16);
                        *(f32x4*)(op + off + bj * HALF + n * 16) = x + g * (acc[ai][bj][m][n] + bv[bj][n]); }
                asm volatile("" ::: "memory"); }
    }
};

template <class Epi, class Sched, bool ALIGN_EPI = false, bool SP2 = false>
__device__ __forceinline__ void gemm_phase(PG8_LAS unsigned char* lds, const Gemm g, const Sched& S, const Epi& E) {
    const int tid = threadIdx.x, wid = __builtin_amdgcn_readfirstlane(tid >> 6), lane = tid & 63, wr = wid >> 2, wc = wid & 3, fr = lane & 15, fq = lane >> 4;
    const int K = g.K, nt = K / BK;
    unsigned voffA[2], voffB[2];
#pragma unroll
    for (int i = 0; i < 2; ++i) { int R, C; stage_rc(tid * 16 + i * 8192, R, C); const int Rb = Epi::PERM ? ((R & ~31) + perm32(R & 31)) : R;
        voffA[i] = (unsigned)(R * K + C) * 2u; voffB[i] = (unsigned)(Rb * K + C) * 2u; }
    const size_t kstep = (size_t)(BK * 2);
    const size_t hstep = (size_t)HALF * K * 2;
    const size_t tstep = 2 * hstep;
    const unsigned ldsw = (unsigned)wid * 1024u;
    const int aoff = lds_byte(wr * 64 + fr, fq * 8), boff = lds_byte(wc * 32 + fr, fq * 8);
#define PG8_SA(b, h) (((b) * 2 + (h)) * HTB)
#define PG8_SB(b, h) ((4 + (b) * 2 + (h)) * HTB)
#define PG8_STAGE(bufoff, gbase, voff) do { _Pragma("unroll") for (int _i = 0; _i < 2; ++_i) \
        __builtin_amdgcn_global_load_lds((const unsigned*)((const char*)(gbase) + (voff)[_i]), (PG8_LAS unsigned*)(lds + (bufoff) + ldsw + _i * 8192), 16, 0, 0); } while (0)
#define PG8_LDA(dst, b, h) do { _Pragma("unroll") for (int m = 0; m < 4; ++m) _Pragma("unroll") for (int k = 0; k < 2; ++k) dst[m][k] = *(const PG8_LAS bf16x8*)(lds + PG8_SA(b, h) + aoff + m * 2048 + k * 1024); } while (0)
#define PG8_LDB(dst, b, h) do { _Pragma("unroll") for (int n = 0; n < 2; ++n) _Pragma("unroll") for (int k = 0; k < 2; ++k) dst[n][k] = *(const PG8_LAS bf16x8*)(lds + PG8_SB(b, h) + boff + n * 2048 + k * 1024); } while (0)
#define PG8_MMA(ai, bj, At, Bt) do { __builtin_amdgcn_s_setprio(1); _Pragma("unroll") for (int m = 0; m < 4; ++m) _Pragma("unroll") for (int n = 0; n < 2; ++n) _Pragma("unroll") for (int k = 0; k < 2; ++k) \
        acc[ai][bj][m][n] = __builtin_amdgcn_mfma_f32_16x16x32_bf16(Bt[n][k], At[m][k], acc[ai][bj][m][n], 0, 0, 0); __builtin_amdgcn_s_setprio(0); } while (0)
#define PG8_WAIT_V(n) asm volatile("s_waitcnt vmcnt(" #n ")" ::: "memory")
#define PG8_WAIT_L(n) asm volatile("s_waitcnt lgkmcnt(" #n ")" ::: "memory")
#define PG8_BAR __builtin_amdgcn_s_barrier()
#define PG8_SCHED __builtin_amdgcn_sched_barrier(0)
    Unit cur, nxt; int ui = 0;
    if (!S.next(0, cur)) return;
    f32x4 acc[2][2][4][2];
#pragma unroll
    for (int a = 0; a < 2; ++a)
#pragma unroll
        for (int b = 0; b < 2; ++b)
#pragma unroll
            for (int m = 0; m < 4; ++m)
#pragma unroll
                for (int n = 0; n < 2; ++n) acc[a][b][m][n] = (f32x4){0.f, 0.f, 0.f, 0.f};
    bf16x8 At[4][2], B0[2][2], B1[2][2];
    const char* cA = (const char*)g.A + (size_t)cur.pm * tstep; const char* cB = (const char*)g.Bt + (size_t)cur.pn * tstep;
    S.a_ready(cur);
    if constexpr (SP2) {
        PG8_STAGE(PG8_SB(0, 0), cB, voffB); PG8_STAGE(PG8_SB(0, 1), cB + hstep, voffB); PG8_STAGE(PG8_SA(0, 0), cA, voffA); PG8_STAGE(PG8_SA(0, 1), cA + hstep, voffA);
        if (wr == 1) PG8_BAR;
        PG8_WAIT_V(2); PG8_BAR;
        PG8_STAGE(PG8_SB(1, 0), cB + kstep, voffB); PG8_STAGE(PG8_SA(1, 0), cA + kstep, voffA); PG8_STAGE(PG8_SB(1, 1), cB + hstep + kstep, voffB);
        PG8_WAIT_V(6); PG8_BAR;
    } else {
        PG8_STAGE(PG8_SB(0, 0), cB, voffB); PG8_STAGE(PG8_SA(0, 0), cA, voffA); PG8_STAGE(PG8_SB(0, 1), cB + hstep, voffB); PG8_STAGE(PG8_SA(0, 1), cA + hstep, voffA);
        if (wr == 1) PG8_BAR;
        PG8_WAIT_V(4); PG8_BAR;
        PG8_STAGE(PG8_SB(1, 0), cB + kstep, voffB); PG8_STAGE(PG8_SA(1, 0), cA + kstep, voffA); PG8_STAGE(PG8_SB(1, 1), cB + hstep + kstep, voffB);
        PG8_WAIT_V(6); PG8_BAR;
    }
    for (;;) {
        const bool has_next = S.next(ui + 1, nxt);
        const char* nA = has_next ? (const char*)g.A + (size_t)nxt.pm * tstep : cA; const char* nB = has_next ? (const char*)g.Bt + (size_t)nxt.pn * tstep : cB;
        for (int t = 0; t < nt; t += 2) {
            const bool last = (t == nt - 2);
            const char* a1 = cA + (size_t)(t + 1) * kstep;
            const char* a2 = last ? nA : cA + (size_t)(t + 2) * kstep; const char* b2 = last ? nB : cB + (size_t)(t + 2) * kstep;
            const char* a3 = a2 + kstep; const char* b3 = b2 + kstep;
            if (last && has_next) S.a_ready(nxt);
            if constexpr (SP2) {
            PG8_LDB(B0, 0, 0); PG8_LDB(B1, 0, 1); PG8_SCHED; PG8_LDA(At, 0, 0); PG8_STAGE(PG8_SA(1, 1), a1 + hstep, voffA);
            PG8_WAIT_V(8); PG8_WAIT_L(0); PG8_BAR; PG8_MMA(0, 0, At, B0); PG8_MMA(0, 1, At, B1); PG8_BAR; PG8_SCHED;
            PG8_LDA(At, 0, 1); PG8_STAGE(PG8_SB(0, 0), b2, voffB); PG8_STAGE(PG8_SB(0, 1), b2 + hstep, voffB); PG8_STAGE(PG8_SA(0, 0), a2, voffA);
            PG8_WAIT_V(8); PG8_WAIT_L(0); PG8_BAR; PG8_MMA(1, 0, At, B0); PG8_MMA(1, 1, At, B1); PG8_BAR; PG8_SCHED;
            PG8_LDB(B0, 1, 0); PG8_LDB(B1, 1, 1); PG8_SCHED; PG8_LDA(At, 1, 0); PG8_STAGE(PG8_SA(0, 1), a2 + hstep, voffA);
            PG8_WAIT_V(8); PG8_WAIT_L(0); PG8_BAR; PG8_MMA(0, 0, At, B0); PG8_MMA(0, 1, At, B1); PG8_BAR; PG8_SCHED;
            PG8_LDA(At, 1, 1); PG8_STAGE(PG8_SB(1, 0), b3, voffB); PG8_STAGE(PG8_SB(1, 1), b3 + hstep, voffB); PG8_STAGE(PG8_SA(1, 0), a3, voffA);
            PG8_WAIT_V(8); PG8_WAIT_L(0); PG8_BAR; PG8_MMA(1, 0, At, B0); PG8_MMA(1, 1, At, B1); PG8_BAR; PG8_SCHED;
            } else {
            PG8_LDB(B0, 0, 0); PG8_SCHED; PG8_LDA(At, 0, 0); PG8_STAGE(PG8_SA(1, 1), a1 + hstep, voffA);
            PG8_WAIT_L(8); PG8_BAR; PG8_WAIT_L(0); PG8_MMA(0, 0, At, B0); PG8_BAR; PG8_SCHED;
            PG8_LDB(B1, 0, 1); PG8_STAGE(PG8_SB(0, 0), b2, voffB);
            PG8_BAR; PG8_WAIT_L(0); PG8_MMA(0, 1, At, B1); PG8_BAR;
            PG8_LDA(At, 0, 1); PG8_STAGE(PG8_SA(0, 0), a2, voffA);
            PG8_BAR; PG8_WAIT_L(0); PG8_MMA(1, 0, At, B0); PG8_BAR; PG8_SCHED;
            PG8_STAGE(PG8_SB(0, 1), b2 + hstep, voffB);
            PG8_WAIT_V(6); PG8_BAR; PG8_MMA(1, 1, At, B1); PG8_BAR;
            PG8_LDB(B0, 1, 0); PG8_SCHED; PG8_LDA(At, 1, 0); PG8_STAGE(PG8_SA(0, 1), a2 + hstep, voffA);
            PG8_WAIT_L(8); PG8_BAR; PG8_WAIT_L(0); PG8_MMA(0, 0, At, B0); PG8_BAR; PG8_SCHED;
            PG8_LDB(B1, 1, 1); PG8_STAGE(PG8_SB(1, 0), b3, voffB);
            PG8_BAR; PG8_WAIT_L(0); PG8_MMA(0, 1, At, B1); PG8_BAR;
            PG8_LDA(At, 1, 1); PG8_STAGE(PG8_SA(1, 0), a3, voffA);
            PG8_BAR; PG8_WAIT_L(0); PG8_MMA(1, 0, At, B0); PG8_BAR; PG8_SCHED;
            PG8_STAGE(PG8_SB(1, 1), b3 + hstep, voffB);
            PG8_WAIT_V(6); PG8_BAR; PG8_MMA(1, 1, At, B1); PG8_BAR;
            }
        }
        if constexpr (ALIGN_EPI) { if (wr == 0) PG8_BAR; }
        if constexpr (!Epi::AFTER_DRAIN) { E(acc, cur, wr, wc, fr, fq); S.done(cur); }
        if (!has_next) break;
#pragma unroll
        for (int a = 0; a < 2; ++a)
#pragma unroll
            for (int b = 0; b < 2; ++b)
#pragma unroll
                for (int m = 0; m < 4; ++m)
#pragma unroll
                    for (int n = 0; n < 2; ++n) acc[a][b][m][n] = (f32x4){0.f, 0.f, 0.f, 0.f};
        cur = nxt; cA = nA; cB = nB; ++ui;
        if constexpr (ALIGN_EPI) { if (wr == 1) PG8_BAR; }
    }
    PG8_WAIT_V(0);
    if constexpr (!ALIGN_EPI) { if (wr == 0) PG8_BAR; }
    PG8_BAR;
    if constexpr (Epi::AFTER_DRAIN) { E.fused(acc, cur, wr, wc, fr, fq, lds, wid, lane); S.done(cur); }
#undef PG8_SA
#undef PG8_SB
#undef PG8_STAGE
#undef PG8_LDA
#undef PG8_LDB
#undef PG8_MMA
#undef PG8_WAIT_V
#undef PG8_WAIT_L
#undef PG8_BAR
#undef PG8_SCHED
}
}
constexpr size_t MiB = 1u << 20;
constexpr size_t WS_CTL = 0, CTL_ZERO_BYTES = 1 * MiB;
constexpr size_t WS_MOD = 1 * MiB;
constexpr size_t WS_BIASA = 2 * MiB + 512 * 1024;
constexpr size_t WS_WIN = 3 * MiB, WS_WOUT = 10 * MiB, WS_W1 = 14 * MiB, WS_W2 = 22 * MiB;
constexpr size_t WS_H = 32 * MiB;
constexpr size_t WS_PROJ = 161 * MiB;
constexpr size_t WS_DT = 613 * MiB;
constexpr size_t WS_MIX = 618 * MiB;
constexpr size_t WS_SSQ = 876 * MiB;
constexpr size_t WS_HMID = 161 * MiB;
constexpr size_t WS_END = 882 * MiB;
static_assert(WS_H + (size_t)MT * DM * 2 <= WS_PROJ && WS_PROJ + (size_t)MT * NPROJ * 2 <= WS_DT && WS_DT + (size_t)MT * 16 * 4 <= WS_MIX && WS_MIX + (size_t)MT * MIXW * 2 <= WS_SSQ
              && WS_SSQ + (size_t)MT * 16 * 4 <= WS_END && WS_HMID + (size_t)MT * DFF * 2 <= WS_SSQ && WS_MOD + (size_t)NBT * NMOD * 4 <= WS_BIASA && WS_W2 + (size_t)DM * DFF * 2 <= WS_H, "d_ws map");

constexpr int NWAVES = 8;
constexpr int RING_OFF = 0, RING_BYTES = 131072;
constexpr int LDS_BYTES = 147456;

#define GAS __attribute__((address_space(1)))
#define LAS __attribute__((address_space(3)))
typedef unsigned short bf16;
typedef unsigned v4u __attribute__((ext_vector_type(4)));
typedef unsigned v2u __attribute__((ext_vector_type(2)));
typedef float f32x4 __attribute__((ext_vector_type(4)));
#define LDS_WAIT() asm volatile("s_waitcnt lgkmcnt(0)" ::: "memory")
__device__ __forceinline__ unsigned f2bf(float f) { unsigned u = __builtin_bit_cast(unsigned, f); return (u + 0x7fffu + ((u >> 16) & 1u)) >> 16; }
__device__ __forceinline__ unsigned pk2(float lo, float hi) { return f2bf(lo) | (f2bf(hi) << 16); }
__device__ __forceinline__ float bflo(unsigned w) { return __builtin_bit_cast(float, w << 16); }
__device__ __forceinline__ float bfhi(unsigned w) { return __builtin_bit_cast(float, w & 0xffff0000u); }
__device__ __forceinline__ float wave_sum(float v) {
#pragma unroll
    for (int o = 1; o < 64; o <<= 1) v += __shfl_xor(v, o);
    return v;
}
__device__ __forceinline__ float silu_f(float x) { return x / (1.f + __expf(-x)); }

struct Frame {
    LAS unsigned char* lds;
    int tid, lane, wave, vcu, G;
    const float* in[27]; float* out; unsigned char* ws;
};
#define IN_XP 0
#define IN_XS 1
#define IN_CPOOL 2
#define IN_CCONV 3
#define IN_SSM 4
#define IN_CP 5
#define IN_CS 6
#define IN_NW1 7
#define IN_NW2 8
#define IN_WADA 9
#define IN_BADA 10
#define IN_WIN 11
#define IN_POOLW 12
#define IN_POOLB 13
#define IN_POOLS 14
#define IN_CONVW 15
#define IN_CONVB 16
#define IN_DTB 17
#define IN_ALOG 18
#define IN_DSKIP 19
#define IN_SNW 20
#define IN_WOUT 21
#define IN_W1 22
#define IN_B1 23
#define IN_W2 24
#define IN_B2 25
#define IN_FNW 26

__device__ __forceinline__ void p0_mod(Frame& F) {
    const float* w_ada = F.in[IN_WADA]; const float* b_ada = F.in[IN_BADA]; float* mod = (float*)(F.ws + WS_MOD);
    LAS float* red = (LAS float*)(F.lds + RING_OFF);
    const int lane = F.lane, li = lane & 15, kq = lane >> 4;
    for (int ct = blockIdx.x; ct < NMOD / 16; ct += F.G) {
        f32x4 acc[3];
#pragma unroll
        for (int mt = 0; mt < 3; ++mt) acc[mt] = (f32x4){0.f, 0.f, 0.f, 0.f};
        const int k0 = F.wave * 128, col = ct * 16 + li;
        const float* cp[3]; cp[0] = F.in[IN_CP] + (size_t)li * DM; cp[1] = F.in[IN_CS] + (size_t)li * DM; cp[2] = F.in[IN_CS] + (size_t)(16 + li) * DM;
#pragma unroll 8
        for (int s = 0; s < 32; ++s) { const int k = k0 + 4 * s + kq; const float bval = w_ada[(size_t)k * NMOD + col];
#pragma unroll
            for (int mt = 0; mt < 3; ++mt) { const float a = silu_f(cp[mt][k]); acc[mt] = __builtin_amdgcn_mfma_f32_16x16x4f32(a, bval, acc[mt], 0, 0, 0); } }
#pragma unroll
        for (int mt = 0; mt < 3; ++mt)
#pragma unroll
            for (int r = 0; r < 4; ++r) red[((F.wave * 3 + mt) * 4 + r) * 64 + lane] = acc[mt][r];
        __syncthreads();
        for (int e = F.tid; e < 768; e += NWAVES * 64) { const int mt = e >> 8, r = (e >> 6) & 3, ln = e & 63; float s = 0.f;
#pragma unroll
            for (int w = 0; w < 8; ++w) s += red[((w * 3 + mt) * 4 + r) * 64 + ln];
            const int batch = 16 * mt + 4 * (ln >> 4) + r, c = ct * 16 + (ln & 15);
            mod[(size_t)batch * NMOD + c] = s + b_ada[c]; }
        __syncthreads();
    }
}
__device__ __forceinline__ void p0_transpose_item(const float* W, int ldw, int nblk, bf16* WT, int ldt, int kofs, const float* kscale, LAS float* scr, int item, int lane) {
    const int kb = item / nblk, nb = item % nblk, k0 = 64 * kb, n0 = 32 * nb;
#pragma unroll 8
    for (int i = 0; i < 32; ++i) { const int kk = 2 * i + (lane >> 5); float v = W[(size_t)(k0 + kk) * ldw + n0 + (lane & 31)]; if (kscale) v *= kscale[k0 + kk]; scr[kk * 33 + (lane & 31)] = v; }
    LDS_WAIT(); asm volatile("" ::: "memory");
    const int c = lane & 7;
#pragma unroll
    for (int j = 0; j < 4; ++j) { const int n = (lane >> 3) + 8 * j; const LAS float* s = scr + (8 * c) * 33 + n;
        v4u o; o.x = pk2(s[0 * 33], s[1 * 33]); o.y = pk2(s[2 * 33], s[3 * 33]); o.z = pk2(s[4 * 33], s[5 * 33]); o.w = pk2(s[6 * 33], s[7 * 33]);
        *(GAS v4u*)(WT + (size_t)(n0 + n) * ldt + kofs + k0 + 8 * c) = o; }
    LDS_WAIT(); asm volatile("" ::: "memory");
}
__device__ __forceinline__ void p0_weights(Frame& F) {
    LAS float* scr = (LAS float*)(F.lds + RING_OFF + 32768 + F.wave * 12288);
    const int gw = F.vcu * NWAVES + F.wave, NGW = F.G * NWAVES;
    bf16* Win_t = (bf16*)(F.ws + WS_WIN); bf16* Wout_t = (bf16*)(F.ws + WS_WOUT); bf16* W1_t = (bf16*)(F.ws + WS_W1); bf16* W2_t = (bf16*)(F.ws + WS_W2);
    constexpr int I_IN = (DM / 64) * (NPROJ / 32), I_OB = (DM / 64) * (DM / 32), I_1 = (DM / 64) * (DFF / 32), I_2 = (DFF / 64) * (DM / 32);
    constexpr int NITEMS = I_IN + I_OB + I_1 + I_2;
    for (int it = gw; it < NITEMS; it += NGW) {
        int r = it;
        if (r < I_IN) { p0_transpose_item(F.in[IN_WIN], LDWIN, NPROJ / 32, Win_t, DM, 0, nullptr, scr, r, F.lane); continue; } r -= I_IN;
        if (r < I_OB) { p0_transpose_item(F.in[IN_WOUT] + (size_t)DM * DM, DM, DM / 32, Wout_t, MIXW, DM, F.in[IN_SNW], scr, r, F.lane); continue; } r -= I_OB;
        if (r < I_1) { p0_transpose_item(F.in[IN_W1], DFF, DFF / 32, W1_t, DM, 0, nullptr, scr, r, F.lane); continue; } r -= I_1;
        p0_transpose_item(F.in[IN_W2], DM, DM / 32, W2_t, DFF, 0, nullptr, scr, r, F.lane);
    }
    const float* pw = F.in[IN_POOLW]; const float* ps = F.in[IN_POOLS]; const float* wo = F.in[IN_WOUT];
    const int li = F.lane & 15, kq = F.lane >> 4;
    for (int t = gw; t < 64 * 64; t += NGW) { const int it = t >> 6, nt = t & 63, g = it >> 4;
        f32x4 acc = (f32x4){0.f, 0.f, 0.f, 0.f};
        const float* arow = pw + ((size_t)(16 * it + li)) * 256;
#pragma unroll 8
        for (int s = 0; s < 64; ++s) { const int d = 4 * s + kq; const float a = arow[d] * ps[256 * g + d]; const float b = wo[(size_t)(256 * g + d) * DM + nt * 16 + li];
            acc = __builtin_amdgcn_mfma_f32_16x16x4f32(a, b, acc, 0, 0, 0); }
        v2u o; o.x = pk2(acc[0], acc[1]); o.y = pk2(acc[2], acc[3]);
        *(GAS v2u*)(Wout_t + (size_t)(nt * 16 + li) * MIXW + 16 * it + 4 * kq) = o; }
    if (blockIdx.x < 16) { const float* pb = F.in[IN_POOLB]; LAS float* red = (LAS float*)(F.lds + RING_OFF);
        const int n = blockIdx.x * 64 + F.lane; float s = 0.f;
        for (int k = F.wave * 128; k < F.wave * 128 + 128; ++k) s += pb[k] * ps[k] * wo[(size_t)k * DM + n];
        __syncthreads(); red[F.wave * 64 + F.lane] = s; __syncthreads();
        if (F.wave == 0) { float t = 0.f;
#pragma unroll
            for (int w = 0; w < 8; ++w) t += red[w * 64 + F.lane];
            ((float*)(F.ws + WS_BIASA))[n] = t; }
        __syncthreads(); }
}

template <bool WITH_DT>
__device__ __forceinline__ void norm_rows(Frame& F, const float* xrows  , int nrows, int grow0  , int batch, const float* nw, int sc_off, int sh_off, LAS float* wdt) {
    const float* mod = (const float*)(F.ws + WS_MOD) + (size_t)batch * NMOD; bf16* H = (bf16*)(F.ws + WS_H); float* DT = (float*)(F.ws + WS_DT);
    const int lane = F.lane;
    f32x4 a1[4], s1[4];
#pragma unroll
    for (int j = 0; j < 4; ++j) { const f32x4 w = *(const f32x4*)(nw + 256 * j + 4 * lane), sc = *(const f32x4*)(mod + sc_off + 256 * j + 4 * lane); a1[j] = w * (sc + 1.0f); s1[j] = *(const f32x4*)(mod + sh_off + 256 * j + 4 * lane); }
    for (int r = 0; r < nrows; ++r) {
        const GAS f32x4* xr = (const GAS f32x4*)(xrows + (size_t)r * DM) + lane;
        f32x4 v[4]; float ss = 0.f;
#pragma unroll
        for (int j = 0; j < 4; ++j) { v[j] = xr[64 * j]; ss += (v[j].x * v[j].x + v[j].y * v[j].y) + (v[j].z * v[j].z + v[j].w * v[j].w); }
        const float rs = 1.0f / sqrtf(wave_sum(ss) * (1.f / DM) + EPS);
#pragma unroll
        for (int j = 0; j < 4; ++j) v[j] = v[j] * rs * a1[j] + s1[j];
        GAS unsigned long long* o8 = (GAS unsigned long long*)(H + (size_t)(grow0 + r) * DM) + lane;
#pragma unroll
        for (int j = 0; j < 4; ++j) o8[64 * j] = (unsigned long long)pk2(v[j].x, v[j].y) | ((unsigned long long)pk2(v[j].z, v[j].w) << 32);
        if constexpr (WITH_DT) {
            float acc[16];
#pragma unroll
            for (int c = 0; c < 16; ++c) acc[c] = 0.f;
#pragma unroll
            for (int j = 0; j < 4; ++j)
#pragma unroll
                for (int i = 0; i < 4; ++i) { const float hv = v[j][i]; const LAS f32x4* wr = (const LAS f32x4*)(wdt + (i * 256 + j * 64 + lane) * 20);
#pragma unroll
                    for (int q = 0; q < 4; ++q) { const f32x4 w = wr[q]; acc[4 * q + 0] += hv * w.x; acc[4 * q + 1] += hv * w.y; acc[4 * q + 2] += hv * w.z; acc[4 * q + 3] += hv * w.w; }
                    if (i & 1) asm volatile("" ::: "memory"); }
#pragma unroll
            for (int c = 0; c < 8; ++c) { const bool hi = lane & 1; const float keep = hi ? acc[c + 8] : acc[c], send = hi ? acc[c] : acc[c + 8]; acc[c] = keep + __shfl_xor(send, 1); }
#pragma unroll
            for (int c = 0; c < 4; ++c) { const bool hi = lane & 2; const float keep = hi ? acc[c + 4] : acc[c], send = hi ? acc[c] : acc[c + 4]; acc[c] = keep + __shfl_xor(send, 2); }
#pragma unroll
            for (int c = 0; c < 2; ++c) { const bool hi = lane & 4; const float keep = hi ? acc[c + 2] : acc[c], send = hi ? acc[c] : acc[c + 2]; acc[c] = keep + __shfl_xor(send, 4); }
            { const bool hi = lane & 8; const float keep = hi ? acc[1] : acc[0], send = hi ? acc[0] : acc[1]; acc[0] = keep + __shfl_xor(send, 8); }
            float t = acc[0]; t += __shfl_xor(t, 16); t += __shfl_xor(t, 32);
            if (lane < 16) { const int ch = 8 * (lane & 1) + 4 * ((lane >> 1) & 1) + 2 * ((lane >> 2) & 1) + ((lane >> 3) & 1); DT[(size_t)(grow0 + r) * 16 + ch] = t; }
        }
    }
}
template <bool FIRST>
__device__ __forceinline__ void p_norm(Frame& F) {
    LAS float* wdt = (LAS float*)(F.lds + RING_OFF);
    if constexpr (FIRST) {
        for (int k = F.tid; k < DM; k += NWAVES * 64) { const f32x4* src = (const f32x4*)(F.in[IN_WIN] + (size_t)k * LDWIN + NPROJ);
            LAS f32x4* dst = (LAS f32x4*)(wdt + ((k & 3) * 256 + (k >> 8) * 64 + ((k >> 2) & 63)) * 20);
            dst[0] = src[0]; dst[1] = src[1]; dst[2] = src[2]; dst[3] = src[3]; }
        __syncthreads();
    }
    const int gw = F.vcu * NWAVES + F.wave;
    const float* nw = F.in[FIRST ? IN_NW1 : IN_NW2]; const int sc_off = FIRST ? DM : 4 * DM, sh_off = FIRST ? 0 : 3 * DM;
    for (int w = gw; w < MP / 32; w += F.G * NWAVES) {
        const float* src = FIRST ? F.in[IN_XP] + (size_t)w * 32 * DM : F.out + O_Y + (size_t)w * 32 * DM;
        norm_rows<FIRST>(F, src, 32, w * 32, w >> 7, nw, sc_off, sh_off, wdt); }
    for (int w = gw; w < MS; w += F.G * NWAVES) {
        const float* src = FIRST ? F.in[IN_XS] + (size_t)w * DM : F.out + O_Y + (size_t)(MP + w) * DM;
        norm_rows<FIRST>(F, src, 1, MP + w, NB_P + (w >> 4), nw, sc_off, sh_off, wdt); }
}

template <int W>
__device__ __forceinline__ void pool_item(const bf16* PROJ, bf16* MIX, int row0, int nblk16, bool seq_start, const float* hist  , int c0) {
    float px[16], py[16];
#pragma unroll
    for (int i = 0; i < 16; ++i) { px[i] = 0.f; py[i] = 0.f; }
    if (hist) {
#pragma unroll
        for (int i = 0; i < 15; ++i) { const float2 h = *(const float2*)(hist + (size_t)i * DM + c0); px[i + 1] = h.x; py[i + 1] = h.y; }
    } else if (!seq_start) {
#pragma unroll
        for (int i = 0; i < 16; ++i) { const unsigned w = *(const unsigned*)(PROJ + (size_t)(row0 - 16 + i) * NPROJ + c0); px[i] = bflo(w); py[i] = bfhi(w); }
    }
    for (int blk = 0; blk < nblk16; ++blk) {
        float cx[16], cy[16];
#pragma unroll
        for (int j = 0; j < 16; ++j) { const unsigned w = *(const unsigned*)(PROJ + (size_t)(row0 + 16 * blk + j) * NPROJ + c0); cx[j] = bflo(w); cy[j] = bfhi(w); }
        float sx = 0.f, sy = 0.f;
#pragma unroll
        for (int i = 1; i < W; ++i) { sx += px[16 - i]; sy += py[16 - i]; }
        const bool first = seq_start && blk == 0;
#pragma unroll
        for (int j = 0; j < 16; ++j) {
            sx += cx[j]; sy += cy[j];
            const float inv = (first && j + 1 < W) ? 1.0f / (float)(j + 1) : 1.0f / (float)W;
            const float ox = sx * inv - cx[j], oy = sy * inv - cy[j];
            *(unsigned*)(MIX + (size_t)(row0 + 16 * blk + j) * MIXW + c0) = pk2(ox, oy);
            const int idx = j - (W - 1);
            if (idx < 0) { sx -= px[16 + idx]; sy -= py[16 + idx]; } else { sx -= cx[idx]; sy -= cy[idx]; }
        }
#pragma unroll
        for (int i = 0; i < 16; ++i) { px[i] = cx[i]; py[i] = cy[i]; }
    }
}
__device__ __forceinline__ void p3_pool(Frame& F) {
    const bf16* PROJ = (const bf16*)(F.ws + WS_PROJ); bf16* MIX = (bf16*)(F.ws + WS_MIX);
    const int c0 = 2 * F.tid, g = F.tid >> 7;
    for (int it = blockIdx.x; it < MP / 64 + NB_S; it += F.G) {
        int row0, nb; bool st; const float* hist = nullptr;
        if (it < MP / 64) { row0 = it * 64; nb = 4; st = (row0 & (SEQ - 1)) == 0; }
        else { const int sb = it - MP / 64; row0 = MP + sb * DSEQ; nb = 1; st = false; hist = F.in[IN_CPOOL] + (size_t)sb * 15 * DM; }
        if (g == 0) pool_item<2>(PROJ, MIX, row0, nb, st, hist, c0);
        else if (g == 1) pool_item<4>(PROJ, MIX, row0, nb, st, hist, c0);
        else if (g == 2) pool_item<8>(PROJ, MIX, row0, nb, st, hist, c0);
        else pool_item<16>(PROJ, MIX, row0, nb, st, hist, c0);
    }
}
__device__ __forceinline__ void p3_conv(Frame& F) {
    const bf16* PROJ = (const bf16*)(F.ws + WS_PROJ); bf16* XB = (bf16*)(F.out + O_Y);
    const float* cw = F.in[IN_CONVW]; const float* cb = F.in[IN_CONVB];
    const int gw = F.vcu * NWAVES + F.wave, NGW = F.G * NWAVES;
    constexpr int NQ_P = (MP / 64) * 12, NQ = NQ_P + NB_S * 12;
    for (int q = gw; q < NQ; q += NGW) {
        int row0, nr, strip; bool zero_hist; const float* hist = nullptr;
        if (q < NQ_P) { const int blk = q / 12; strip = q - blk * 12; row0 = blk * 64; nr = 64; zero_hist = (row0 & (SEQ - 1)) == 0; }
        else { const int qq = q - NQ_P, sb = qq / 12; strip = qq - sb * 12; row0 = MP + sb * DSEQ; nr = DSEQ; zero_hist = false; hist = F.in[IN_CCONV] + (size_t)sb * 3 * CONVD; }
        const int c0 = strip * 128 + 2 * F.lane;
        float w0x = cw[c0], w0y = cw[c0 + 1], w1x = cw[CONVD + c0], w1y = cw[CONVD + c0 + 1], w2x = cw[2 * CONVD + c0], w2y = cw[2 * CONVD + c0 + 1], w3x = cw[3 * CONVD + c0], w3y = cw[3 * CONVD + c0 + 1];
        const float bx = cb[c0], by = cb[c0 + 1];
        float x3x = 0.f, x3y = 0.f, x2x = 0.f, x2y = 0.f, x1x = 0.f, x1y = 0.f;
        if (hist) { x3x = hist[c0]; x3y = hist[c0 + 1]; x2x = hist[CONVD + c0]; x2y = hist[CONVD + c0 + 1]; x1x = hist[2 * CONVD + c0]; x1y = hist[2 * CONVD + c0 + 1]; }
        else if (!zero_hist) { const unsigned a = *(const unsigned*)(PROJ + (size_t)(row0 - 3) * NPROJ + 2048 + c0), b = *(const unsigned*)(PROJ + (size_t)(row0 - 2) * NPROJ + 2048 + c0), c = *(const unsigned*)(PROJ + (size_t)(row0 - 1) * NPROJ + 2048 + c0);
            x3x = bflo(a); x3y = bfhi(a); x2x = bflo(b); x2y = bfhi(b); x1x = bflo(c); x1y = bfhi(c); }
#pragma unroll 8
        for (int j = 0; j < nr; ++j) {
            const unsigned w = *(const unsigned*)(PROJ + (size_t)(row0 + j) * NPROJ + 2048 + c0); const float x0x = bflo(w), x0y = bfhi(w);
            const float ox = bx + w0x * x3x + w1x * x2x + w2x * x1x + w3x * x0x, oy = by + w0y * x3y + w1y * x2y + w2y * x1y + w3y * x0y;
            *(unsigned*)(XB + (size_t)(row0 + j) * CONVD + c0) = pk2(silu_f(ox), silu_f(oy));
            x3x = x2x; x3y = x2y; x2x = x1x; x2y = x1y; x1x = x0x; x1y = x0y;
        }
    }
}

__device__ __forceinline__ void p4_ssd(Frame& F) {
    const bf16* XB = (const bf16*)(F.out + O_Y); const bf16* PROJ = (const bf16*)(F.ws + WS_PROJ); bf16* MIX = (bf16*)(F.ws + WS_MIX);
    const float* DT = (const float*)(F.ws + WS_DT); float* SSQ = (float*)(F.ws + WS_SSQ);
    LAS float* Xs = (LAS float*)(F.lds + RING_OFF); LAS float* Bs = Xs + 64 * 64; LAS float* Cs = Bs + 64 * 128; LAS float* Ys = Cs + 64 * 128; LAS float* dts = Ys + 64 * 64; LAS float* as = dts + 64;
    const int tid = F.tid, pg = tid >> 5, ngi = tid & 31;
    for (int it = blockIdx.x; it < NB_P * NH + NB_S * NH; it += F.G) {
        int rowbase, L, h; float* sout; f32x4 st[4];
        if (it < NB_P * NH) { const int b = it >> 4; h = it & 15; rowbase = b * SEQ; L = SEQ; sout = F.out + O_SP + (size_t)it * HD * NST;
#pragma unroll
            for (int i = 0; i < 4; ++i) st[i] = (f32x4){0.f, 0.f, 0.f, 0.f}; }
        else { const int s = it - NB_P * NH, sb = s >> 4; h = s & 15; rowbase = MP + sb * DSEQ; L = DSEQ; sout = F.out + O_SS + (size_t)s * HD * NST;
            const float* sin = F.in[IN_SSM] + (size_t)s * HD * NST;
#pragma unroll
            for (int i = 0; i < 4; ++i) st[i] = *(const f32x4*)(sin + (size_t)(4 * pg + i) * NST + 4 * ngi); }
        const int g = h >> 3; const float Ah = -expf(F.in[IN_ALOG][h]), dtb = F.in[IN_DTB][h], Dh = F.in[IN_DSKIP][h];
        for (int t0 = 0; t0 < L; t0 += 64) {
            const int nt = (L - t0) < 64 ? (L - t0) : 64;
            { const int tt = tid >> 3, p8 = (tid & 7) * 8;
              if (tt < nt) { const v4u w = *(const v4u*)(XB + (size_t)(rowbase + t0 + tt) * CONVD + h * HD + p8); LAS f32x4* d = (LAS f32x4*)(Xs + tt * 64 + p8);
                  d[0] = (f32x4){bflo(w.x), bfhi(w.x), bflo(w.y), bfhi(w.y)}; d[1] = (f32x4){bflo(w.z), bfhi(w.z), bflo(w.w), bfhi(w.w)}; } }
#pragma unroll
            for (int rep = 0; rep < 2; ++rep) { const int tt = (tid >> 4) + 32 * rep, n8 = (tid & 15) * 8;
                if (tt < nt) { const bf16* rp = XB + (size_t)(rowbase + t0 + tt) * CONVD + 1024 + g * NST + n8; const v4u wb = *(const v4u*)rp, wc = *(const v4u*)(rp + 256);
                    LAS f32x4* db = (LAS f32x4*)(Bs + tt * 128 + n8); LAS f32x4* dc = (LAS f32x4*)(Cs + tt * 128 + n8);
                    db[0] = (f32x4){bflo(wb.x), bfhi(wb.x), bflo(wb.y), bfhi(wb.y)}; db[1] = (f32x4){bflo(wb.z), bfhi(wb.z), bflo(wb.w), bfhi(wb.w)};
                    dc[0] = (f32x4){bflo(wc.x), bfhi(wc.x), bflo(wc.y), bfhi(wc.y)}; dc[1] = (f32x4){bflo(wc.z), bfhi(wc.z), bflo(wc.w), bfhi(wc.w)}; } }
            if (tid < nt) { const float r = DT[(size_t)(rowbase + t0 + tid) * 16 + h] + dtb; const float d = fmaxf(r, 0.f) + log1pf(expf(-fabsf(r))); dts[tid] = d; as[tid] = expf(d * Ah); }
            __syncthreads();
            for (int t = 0; t < nt; ++t) {
                const float a = as[t], d = dts[t];
                const f32x4 xv = *(const LAS f32x4*)(Xs + t * 64 + 4 * pg), bv = *(const LAS f32x4*)(Bs + t * 128 + 4 * ngi), cv = *(const LAS f32x4*)(Cs + t * 128 + 4 * ngi);
                float yp[4];
#pragma unroll
                for (int i = 0; i < 4; ++i) { const float xd = xv[i] * d; st[i] = st[i] * a + bv * xd; yp[i] = (st[i].x * cv.x + st[i].y * cv.y) + (st[i].z * cv.z + st[i].w * cv.w); }
                { const bool hi = ngi & 1; const float k0 = hi ? yp[2] : yp[0], s0 = hi ? yp[0] : yp[2], k1 = hi ? yp[3] : yp[1], s1 = hi ? yp[1] : yp[3]; yp[0] = k0 + __shfl_xor(s0, 1); yp[1] = k1 + __shfl_xor(s1, 1); }
                { const bool hi = ngi & 2; const float k0 = hi ? yp[1] : yp[0], s0 = hi ? yp[0] : yp[1]; yp[0] = k0 + __shfl_xor(s0, 2); }
                float y = yp[0]; y += __shfl_xor(y, 4); y += __shfl_xor(y, 8); y += __shfl_xor(y, 16);
                if (ngi < 4) Ys[t * 64 + 4 * pg + 2 * (ngi & 1) + ((ngi >> 1) & 1)] = y;
            }
            __syncthreads();
            { const int tt = tid >> 3, p8 = (tid & 7) * 8;
              if (tt < nt) { const size_t row = (size_t)(rowbase + t0 + tt);
                  const v4u zw = *(const v4u*)(PROJ + row * NPROJ + 1024 + h * HD + p8);
                  const f32x4 y0 = *(const LAS f32x4*)(Ys + tt * 64 + p8), y1 = *(const LAS f32x4*)(Ys + tt * 64 + p8 + 4), x0 = *(const LAS f32x4*)(Xs + tt * 64 + p8), x1 = *(const LAS f32x4*)(Xs + tt * 64 + p8 + 4);
                  const float z[8] = {bflo(zw.x), bfhi(zw.x), bflo(zw.y), bfhi(zw.y), bflo(zw.z), bfhi(zw.z), bflo(zw.w), bfhi(zw.w)};
                  float o[8]; float ss = 0.f;
#pragma unroll
                  for (int i = 0; i < 4; ++i) { o[i] = (y0[i] + Dh * x0[i]) * silu_f(z[i]); o[4 + i] = (y1[i] + Dh * x1[i]) * silu_f(z[4 + i]); }
#pragma unroll
                  for (int i = 0; i < 8; ++i) ss += o[i] * o[i];
                  ss += __shfl_xor(ss, 1); ss += __shfl_xor(ss, 2); ss += __shfl_xor(ss, 4);
                  if ((tid & 7) == 0) SSQ[row * 16 + h] = ss;
                  v4u ow; ow.x = pk2(o[0], o[1]); ow.y = pk2(o[2], o[3]); ow.z = pk2(o[4], o[5]); ow.w = pk2(o[6], o[7]);
                  *(v4u*)(MIX + row * MIXW + 1024 + h * HD + p8) = ow; }
            }
            __syncthreads();
        }
#pragma unroll
        for (int i = 0; i < 4; ++i) *(f32x4*)(sout + (size_t)(4 * pg + i) * NST + 4 * ngi) = st[i];
    }
}
__device__ __forceinline__ void p4b_gnorm(Frame& F) {
    bf16* MIX = (bf16*)(F.ws + WS_MIX); const float* SSQ = (const float*)(F.ws + WS_SSQ);
    const int gw = F.vcu * NWAVES + F.wave, NGW = F.G * NWAVES, lane = F.lane;
    for (int row = gw; row < MT; row += NGW) {
        float s = SSQ[(size_t)row * 16 + (lane & 15)];
        s += __shfl_xor(s, 1); s += __shfl_xor(s, 2); s += __shfl_xor(s, 4);
        const float sg = __shfl(s, (lane >> 5) * 8);
        const float rs = 1.0f / sqrtf(sg * (1.f / 512.f) + EPS);
        v4u* p = (v4u*)(MIX + (size_t)row * MIXW + 1024 + 16 * lane);
#pragma unroll
        for (int q = 0; q < 2; ++q) { v4u w = p[q];
            w.x = pk2(bflo(w.x) * rs, bfhi(w.x) * rs); w.y = pk2(bflo(w.y) * rs, bfhi(w.y) * rs); w.z = pk2(bflo(w.z) * rs, bfhi(w.z) * rs); w.w = pk2(bflo(w.w) * rs, bfhi(w.w) * rs);
            p[q] = w; }
    }
}
__device__ __forceinline__ void p9_final(Frame& F) {
    const float* fw = F.in[IN_FNW]; const int gw = F.vcu * NWAVES + F.wave, NGW = F.G * NWAVES, lane = F.lane;
    f32x4 w[4];
#pragma unroll
    for (int j = 0; j < 4; ++j) w[j] = *(const f32x4*)(fw + 256 * j + 4 * lane);
    for (int row = gw; row < MT; row += NGW) {
        GAS f32x4* xr = (GAS f32x4*)(F.out + O_Y + (size_t)row * DM) + lane;
        f32x4 v[4]; float ss = 0.f;
#pragma unroll
        for (int j = 0; j < 4; ++j) { v[j] = xr[64 * j]; ss += (v[j].x * v[j].x + v[j].y * v[j].y) + (v[j].z * v[j].z + v[j].w * v[j].w); }
        const float rs = 1.0f / sqrtf(wave_sum(ss) * (1.f / DM) + EPS);
#pragma unroll
        for (int j = 0; j < 4; ++j) xr[64 * j] = v[j] * rs * w[j];
    }
}

constexpr int N_PHASES = 11;
struct Args { const float* in[27]; float* out; unsigned char* ws; int ph_lo, ph_hi; };
__global__ void __launch_bounds__(NWAVES * 64, 2) hymba_fwd(Args args) {
    extern __shared__ __attribute__((aligned(16))) unsigned char lds[];
    Frame F;
    F.lds = (LAS unsigned char*)lds;
    F.tid = threadIdx.x; F.lane = F.tid & 63; F.wave = __builtin_amdgcn_readfirstlane(F.tid >> 6);
    F.G = gridDim.x; { const int bx = blockIdx.x; F.vcu = (F.G % 8 == 0) ? (bx % 8) * (F.G / 8) + bx / 8 : bx; }
#pragma unroll
    for (int i = 0; i < 27; ++i) F.in[i] = args.in[i];
    F.out = args.out; F.ws = args.ws;
    const int lo = args.ph_lo, hi = args.ph_hi;
#ifndef PHASE_MASK
#define PHASE_MASK 0x7ff
#endif
#define IN(k) (((PHASE_MASK >> (k)) & 1) && lo <= (k) && (k) < hi)
#define SEAM(k) do { if (IN(k) && IN((k) + 1)) { cg::this_grid().sync(); } } while (0)
    bf16* Hb = (bf16*)(F.ws + WS_H); bf16* PROJ = (bf16*)(F.ws + WS_PROJ); bf16* MIX = (bf16*)(F.ws + WS_MIX); bf16* HMID = (bf16*)(F.ws + WS_HMID);
    const float* mod = (const float*)(F.ws + WS_MOD);

    if (IN(0)) { p0_mod(F); p0_weights(F); } SEAM(0);
    if (IN(1)) { p_norm<true>(F); } SEAM(1);
    if (IN(2)) {
        pg8::Gemm g{Hb, (const bf16*)(F.ws + WS_WIN), MT, NPROJ, DM}; pg8::StaticOrder S; S.init(MT, NPROJ, F.G, (int)blockIdx.x);
        pg8::EpiProj E{PROJ, F.out, O_PP, O_CP, O_PS, O_CS};
        pg8::gemm_phase<pg8::EpiProj, pg8::StaticOrder, true, true>(F.lds + RING_OFF, g, S, E);
    } SEAM(2);
    if (IN(3)) { p3_pool(F); p3_conv(F); } SEAM(3);
    if (IN(4)) { p4_ssd(F); } SEAM(4);
    if (IN(5)) { p4b_gnorm(F); } SEAM(5);
    if (IN(6)) {
        pg8::Gemm g{MIX, (const bf16*)(F.ws + WS_WOUT), MT, DM, MIXW}; pg8::StaticOrder S; S.init(MT, DM, F.G, (int)blockIdx.x);
        pg8::EpiRes E{F.in[IN_XP], F.in[IN_XS], F.out + O_Y, (const float*)(F.ws + WS_BIASA), mod + 2 * DM};
        pg8::gemm_phase<pg8::EpiRes, pg8::StaticOrder, true, true>(F.lds + RING_OFF, g, S, E);
    } SEAM(6);
    if (IN(7)) { p_norm<false>(F); } SEAM(7);
    if (IN(8)) {
        pg8::Gemm g{Hb, (const bf16*)(F.ws + WS_W1), MT, DFF, DM}; pg8::StaticOrder S; S.init(MT, DFF, F.G, (int)blockIdx.x);
        pg8::EpiRelu2 E{HMID, F.in[IN_B1]};
        pg8::gemm_phase<pg8::EpiRelu2, pg8::StaticOrder, true, true>(F.lds + RING_OFF, g, S, E);
    } SEAM(8);
    if (IN(9)) {
        pg8::Gemm g{HMID, (const bf16*)(F.ws + WS_W2), MT, DM, DFF}; pg8::StaticOrder S; S.init(MT, DM, F.G, (int)blockIdx.x);
        pg8::EpiRes E{F.out + O_Y, F.out + O_Y + (size_t)MP * DM, F.out + O_Y, F.in[IN_B2], mod + 5 * DM};
        pg8::gemm_phase<pg8::EpiRes, pg8::StaticOrder, true, true>(F.lds + RING_OFF, g, S, E);
    } SEAM(9);
    if (IN(10)) { p9_final(F); }
#undef IN
#undef SEAM
}

#ifndef MK_ONE_LAUNCH
#define MK_ONE_LAUNCH 0
#endif
extern "C" void kernel_launch(void* const* d_in, const int* in_sizes, int n_in, void* d_out, int out_size, void* d_ws, size_t ws_size, hipStream_t stream) {
    static int grid = 0;
    if (grid == 0) {
        if (n_in != 27 || in_sizes[0] != MP * DM || (size_t)out_size != O_END || ws_size < WS_END) {
            fprintf(stderr, "kernel_launch: shape mismatch: n_in %d in0 %d out %d ws %zu (need %zu)\n", n_in, n_in > 0 ? in_sizes[0] : -1, out_size, ws_size, (size_t)WS_END); grid = -1; return; }
        int dev = 0, cus = 0, per_cu = 0;
        if (hipGetDevice(&dev) != hipSuccess || hipDeviceGetAttribute(&cus, hipDeviceAttributeMultiprocessorCount, dev) != hipSuccess) { grid = -1; return; }
        if (hipFuncSetAttribute((const void*)hymba_fwd, hipFuncAttributeMaxDynamicSharedMemorySize, LDS_BYTES) != hipSuccess) { fprintf(stderr, "kernel_launch: hipFuncSetAttribute failed\n"); grid = -1; return; }
        if (hipOccupancyMaxActiveBlocksPerMultiprocessor(&per_cu, (const void*)hymba_fwd, NWAVES * 64, LDS_BYTES) != hipSuccess || per_cu < 1) { fprintf(stderr, "kernel_launch: occupancy query says %d blocks per CU\n", per_cu); per_cu = 1; }
        (void)hipGetLastError();
        grid = cus;
        if (grid > cus * per_cu) grid = cus * per_cu;
    }
    if (grid < 0) return;
    Args a{};
    for (int i = 0; i < 27; ++i) a.in[i] = (const float*)d_in[i];
    a.out = (float*)d_out; a.ws = (unsigned char*)d_ws;
#if MK_ONE_LAUNCH
    a.ph_lo = 0; a.ph_hi = N_PHASES;
    void* kargs[] = {&a};
    hipError_t e = hipLaunchCooperativeKernel((const void*)hymba_fwd, dim3(grid), dim3(NWAVES * 64), kargs, LDS_BYTES, stream);
    if (e != hipSuccess) fprintf(stderr, "kernel_launch: cooperative launch failed: %s (grid %d)\n", hipGetErrorString(e), grid);
#else
    for (int p = 0; p < N_PHASES; ++p) { a.ph_lo = p; a.ph_hi = p + 1;
        hipLaunchKernelGGL(hymba_fwd, dim3(grid), dim3(NWAVES * 64), LDS_BYTES, stream, a);
        const hipError_t le = hipPeekAtLastError(); if (le != hipSuccess) { fprintf(stderr, "kernel_launch: launch %d failed: %s\n", p, hipGetErrorName(le)); break; } }
#endif
}
```

```cpp
#include <hip/hip_runtime.h>
#include <hip/hip_cooperative_groups.h>
#include <cstdio>
#include <cstdint>
namespace cg = cooperative_groups;

constexpr int DM = 1024, NB_P = 16, SEQ = 4096, NB_S = 32, DSEQ = 16;
constexpr int MP = NB_P * SEQ, MS = NB_S * DSEQ, MT = MP + MS, NBT = NB_P + NB_S;
constexpr int NPROJ = 3584, LDWIN = 3600, DFF = 4096, MIXW = 2048, CONVD = 1536, NH = 16, HD = 64, NST = 128, NMOD = 6 * DM;
constexpr float EPS = 1e-6f;
constexpr size_t O_Y = 0, O_PP = (size_t)MT * DM, O_CP = O_PP + (size_t)NB_P * 15 * DM, O_SP = O_CP + (size_t)NB_P * 3 * CONVD,
                 O_PS = O_SP + (size_t)NB_P * NH * HD * NST, O_CS = O_PS + (size_t)NB_S * 15 * DM, O_SS = O_CS + (size_t)NB_S * 3 * CONVD,
                 O_END = O_SS + (size_t)NB_S * NH * HD * NST;
namespace pg8 {
#define PG8_LAS __attribute__((address_space(3)))
typedef unsigned short bf16_t;
typedef short bf16x8 __attribute__((ext_vector_type(8)));
typedef float f32x4 __attribute__((ext_vector_type(4)));
typedef unsigned u32x4 __attribute__((ext_vector_type(4)));
constexpr int BM = 256, BK = 64, HALF = 128, HTB = HALF * BK * 2  , STAGE_BYTES = 8 * HTB, NXCD = 8, WGM = 8;

__host__ __device__ __forceinline__ int lds_byte(int r, int c) { const int st = (r >> 4) * 2 + (c >> 5), rr = r & 15, cc = c & 31, ob = rr * 64 + cc * 2; return st * 1024 + (ob ^ (((ob >> 9) & 1) << 5)); }
__host__ __device__ __forceinline__ void stage_rc(int b, int& R, int& C) { const int st = b / 1024, sb = b % 1024, swz = sb ^ (((sb >> 9) & 1) << 5); R = (st >> 1) * 16 + swz / 64; C = (st & 1) * 32 + (swz % 64) / 2; }
__host__ __device__ __forceinline__ int perm32(int rho) { const int n = rho >> 4, i = rho & 15; return 8 * (i >> 2) + 4 * n + (i & 3); }

struct Unit { int pm, pn; };
struct Gemm { const bf16_t* A; const bf16_t* Bt; int M, N, K; };

struct StaticOrder {
    int nM, nN, nwg, G, c;
    __host__ __device__ void init(int M, int N, int G_, int c_) { nM = M / BM; nN = N / BM; nwg = nM * nN; G = G_; c = c_; }
    __host__ __device__ bool next(int i, Unit& u) const {
        const long L = (long)i * G + c; if (L >= nwg) return false;
        int wgid = (int)L; { const int q = nwg / NXCD, r = nwg % NXCD, xcd = wgid % NXCD, off = wgid / NXCD; wgid = (xcd < r ? xcd * (q + 1) : r * (q + 1) + (xcd - r) * q) + off; }
        const int nig = WGM * nN, gid = wgid / nig, fm = gid * WGM, gsz = (nM - fm) < WGM ? (nM - fm) : WGM;
        u.pm = fm + ((wgid % nig) % gsz); u.pn = (wgid % nig) / gsz; return true;
    }
    __device__ __forceinline__ void a_ready(const Unit&) const {}
    __device__ __forceinline__ void done(const Unit&) const {}
};
__device__ __forceinline__ unsigned cvt_pk_bf16(float lo, float hi) { unsigned r; asm volatile("v_cvt_pk_bf16_f32 %0, %1, %2" : "=v"(r) : "v"(lo), "v"(hi)); return r; }
typedef unsigned u32x2 __attribute__((ext_vector_type(2)));
struct EpiProj {
    static constexpr bool PERM = true, AFTER_DRAIN = false;
    bf16_t* O; float* out;
    size_t o_pp, o_cp, o_ps, o_cs;
    __device__ __forceinline__ void operator()(const f32x4 (&acc)[2][2][4][2], const Unit& u, int wr, int wc, int fr, int fq) const {
        const int row0 = u.pm * BM + wr * 64 + fr, col0 = u.pn * BM + wc * 32 + 8 * fq;
#pragma unroll
        for (int ai = 0; ai < 2; ++ai)
#pragma unroll
            for (int m = 0; m < 4; ++m) { bf16_t* rowp = O + (size_t)(row0 + ai * HALF + m * 16) * 3584 + col0;
#pragma unroll
                for (int bj = 0; bj < 2; ++bj) { const f32x4 v0 = acc[ai][bj][m][0], v1 = acc[ai][bj][m][1];
                    u32x4 w; w.x = cvt_pk_bf16(v0[0], v0[1]); w.y = cvt_pk_bf16(v0[2], v0[3]); w.z = cvt_pk_bf16(v1[0], v1[1]); w.w = cvt_pk_bf16(v1[2], v1[3]);
                    *(u32x4*)(rowp + bj * HALF) = w; } }
        const bool is_u = u.pn < 4, is_c = u.pn >= 8;
        if (!(is_u || is_c)) return;
        if (u.pm < 256) {
            if ((u.pm & 15) != 15 || wr != 1) return;
            const int b = u.pm >> 4, lr = 240 + fr;
            if (is_u) { if (fr >= 1) { float* dst = out + o_pp + ((size_t)(b * 15 + (fr - 1)) * 1024 + col0);
#pragma unroll
                    for (int bj = 0; bj < 2; ++bj) { *(f32x4*)(dst + bj * HALF) = acc[1][bj][3][0]; *(f32x4*)(dst + bj * HALF + 4) = acc[1][bj][3][1]; } } }
            else { if (fr >= 13) { float* dst = out + o_cp + ((size_t)(b * 3 + (fr - 13)) * 1536 + (col0 - 2048));
#pragma unroll
                    for (int bj = 0; bj < 2; ++bj) { *(f32x4*)(dst + bj * HALF) = acc[1][bj][3][0]; *(f32x4*)(dst + bj * HALF + 4) = acc[1][bj][3][1]; } } }
            (void)lr;
        } else {
#pragma unroll
            for (int ai = 0; ai < 2; ++ai)
#pragma unroll
                for (int m = 0; m < 4; ++m) { const int sb = (u.pm - 256) * 16 + 8 * ai + 4 * wr + m;
                    if (is_u) { if (fr >= 1) { float* dst = out + o_ps + ((size_t)(sb * 15 + (fr - 1)) * 1024 + col0);
#pragma unroll
                            for (int bj = 0; bj < 2; ++bj) { *(f32x4*)(dst + bj * HALF) = acc[ai][bj][m][0]; *(f32x4*)(dst + bj * HALF + 4) = acc[ai][bj][m][1]; } } }
                    else { if (fr >= 13) { float* dst = out + o_cs + ((size_t)(sb * 3 + (fr - 13)) * 1536 + (col0 - 2048));
#pragma unroll
                            for (int bj = 0; bj < 2; ++bj) { *(f32x4*)(dst + bj * HALF) = acc[ai][bj][m][0]; *(f32x4*)(dst + bj * HALF + 4) = acc[ai][bj][m][1]; } } } }
        }
    }
};
struct EpiRelu2 {
    static constexpr bool PERM = true, AFTER_DRAIN = false;
    bf16_t* O; const float* bias;
    __device__ __forceinline__ void operator()(const f32x4 (&acc)[2][2][4][2], const Unit& u, int wr, int wc, int fr, int fq) const {
        const int row0 = u.pm * BM + wr * 64 + fr, col0 = u.pn * BM + wc * 32 + 8 * fq;
        f32x4 bv[2][2];
#pragma unroll
        for (int bj = 0; bj < 2; ++bj)
#pragma unroll
            for (int n = 0; n < 2; ++n) bv[bj][n] = *(const f32x4*)(bias + col0 + bj * HALF + 4 * n);
#pragma unroll
        for (int ai = 0; ai < 2; ++ai)
#pragma unroll
            for (int m = 0; m < 4; ++m) { bf16_t* rowp = O + (size_t)(row0 + ai * HALF + m * 16) * 4096 + col0;
#pragma unroll
                for (int bj = 0; bj < 2; ++bj) { f32x4 v0 = acc[ai][bj][m][0] + bv[bj][0], v1 = acc[ai][bj][m][1] + bv[bj][1];
#pragma unroll
                    for (int j = 0; j < 4; ++j) { const float a = fmaxf(v0[j], 0.f), b = fmaxf(v1[j], 0.f); v0[j] = a * a; v1[j] = b * b; }
                    u32x4 w; w.x = cvt_pk_bf16(v0[0], v0[1]); w.y = cvt_pk_bf16(v0[2], v0[3]); w.z = cvt_pk_bf16(v1[0], v1[1]); w.w = cvt_pk_bf16(v1[2], v1[3]);
                    *(u32x4*)(rowp + bj * HALF) = w; } }
    }
};
struct EpiRes {
    static constexpr bool PERM = false, AFTER_DRAIN = false;
    const float* baseP; const float* baseS;
    float* out;
    const float* bias;
    const float* gate;
    __device__ __forceinline__ void operator()(const f32x4 (&acc)[2][2][4][2], const Unit& u, int wr, int wc, int fr, int fq) const {
        const bool smp = u.pm >= 256;
        const float* bp = smp ? baseS + (size_t)(u.pm - 256) * BM * 1024 : baseP + (size_t)u.pm * BM * 1024;
        float* op = out + (size_t)u.pm * BM * 1024;
        const int col0 = u.pn * BM + wc * 32 + 4 * fq;
        f32x4 bv[2][2];
#pragma unroll
        for (int bj = 0; bj < 2; ++bj)
#pragma unroll
            for (int n = 0; n < 2; ++n) bv[bj][n] = *(const f32x4*)(bias + col0 + bj * HALF + n * 16);
#pragma unroll
        for (int ai = 0; ai < 2; ++ai)
#pragma unroll
            for (int m = 0; m < 4; ++m) { const int lr = ai * HALF + wr * 64 + m * 16 + fr;
                const int b = smp ? 16 + (u.pm - 256) * 16 + (lr >> 4) : (u.pm >> 4);
                const float* gp = gate + (size_t)b * 6144 + col0; const size_t off = (size_t)lr * 1024 + col0;
#pragma unroll
                for (int bj = 0; bj < 2; ++bj)
#pragma unroll
                    for (int n = 0; n < 2; ++n) { const f32x4 g = *(const f32x4*)(gp + bj * HALF + n * 16), x = *(const f32x4*)(bp + off + bj * HALF + n * 16);
                        *(f32x4*)(op + off + bj * HALF + n * 16) = x + g * (acc[ai][bj][m][n] + bv[bj][n]); }
                asm volatile("" ::: "memory"); }
    }
};

template <class Epi, class Sched, bool ALIGN_EPI = false, bool SP2 = false>
__device__ __forceinline__ void gemm_phase(PG8_LAS unsigned char* lds, const Gemm g, const Sched& S, const Epi& E) {
    const int tid = threadIdx.x, wid = __builtin_amdgcn_readfirstlane(tid >> 6), lane = tid & 63, wr = wid >> 2, wc = wid & 3, fr = lane & 15, fq = lane >> 4;
    const int K = g.K, nt = K / BK;
    unsigned voffA[2], voffB[2];
#pragma unroll
    for (int i = 0; i < 2; ++i) { int R, C; stage_rc(tid * 16 + i * 8192, R, C); const int Rb = Epi::PERM ? ((R & ~31) + perm32(R & 31)) : R;
        voffA[i] = (unsigned)(R * K + C) * 2u; voffB[i] = (unsigned)(Rb * K + C) * 2u; }
    const size_t kstep = (size_t)(BK * 2);
    const size_t hstep = (size_t)HALF * K * 2;
    const size_t tstep = 2 * hstep;
    const unsigned ldsw = (unsigned)wid * 1024u;
    const int aoff = lds_byte(wr * 64 + fr, fq * 8), boff = lds_byte(wc * 32 + fr, fq * 8);
#define PG8_SA(b, h) (((b) * 2 + (h)) * HTB)
#define PG8_SB(b, h) ((4 + (b) * 2 + (h)) * HTB)
#define PG8_STAGE(bufoff, gbase, voff) do { _Pragma("unroll") for (int _i = 0; _i < 2; ++_i) \
        __builtin_amdgcn_global_load_lds((const unsigned*)((const char*)(gbase) + (voff)[_i]), (PG8_LAS unsigned*)(lds + (bufoff) + ldsw + _i * 8192), 16, 0, 0); } while (0)
#define PG8_LDA(dst, b, h) do { _Pragma("unroll") for (int m = 0; m < 4; ++m) _Pragma("unroll") for (int k = 0; k < 2; ++k) dst[m][k] = *(const PG8_LAS bf16x8*)(lds + PG8_SA(b, h) + aoff + m * 2048 + k * 1024); } while (0)
#define PG8_LDB(dst, b, h) do { _Pragma("unroll") for (int n = 0; n < 2; ++n) _Pragma("unroll") for (int k = 0; k < 2; ++k) dst[n][k] = *(const PG8_LAS bf16x8*)(lds + PG8_SB(b, h) + boff + n * 2048 + k * 1024); } while (0)
#define PG8_MMA(ai, bj, At, Bt) do { __builtin_amdgcn_s_setprio(1); _Pragma("unroll") for (int m = 0; m < 4; ++m) _Pragma("unroll") for (int n = 0; n < 2; ++n) _Pragma("unroll") for (int k = 0; k < 2; ++k) \
        acc[ai][bj][m][n] = __builtin_amdgcn_mfma_f32_16x16x32_bf16(Bt[n][k], At[m][k], acc[ai][bj][m][n], 0, 0, 0); __builtin_amdgcn_s_setprio(0); } while (0)
#define PG8_WAIT_V(n) asm volatile("s_waitcnt vmcnt(" #n ")" ::: "memory")
#define PG8_WAIT_L(n) asm volatile("s_waitcnt lgkmcnt(" #n ")" ::: "memory")
#define PG8_BAR __builtin_amdgcn_s_barrier()
#define PG8_SCHED __builtin_amdgcn_sched_barrier(0)
    Unit cur, nxt; int ui = 0;
    if (!S.next(0, cur)) return;
    f32x4 acc[2][2][4][2];
#pragma unroll
    for (int a = 0; a < 2; ++a)
#pragma unroll
        for (int b = 0; b < 2; ++b)
#pragma unroll
            for (int m = 0; m < 4; ++m)
#pragma unroll
                for (int n = 0; n < 2; ++n) acc[a][b][m][n] = (f32x4){0.f, 0.f, 0.f, 0.f};
    bf16x8 At[4][2], B0[2][2], B1[2][2];
    const char* cA = (const char*)g.A + (size_t)cur.pm * tstep; const char* cB = (const char*)g.Bt + (size_t)cur.pn * tstep;
    S.a_ready(cur);
    if constexpr (SP2) {
        PG8_STAGE(PG8_SB(0, 0), cB, voffB); PG8_STAGE(PG8_SB(0, 1), cB + hstep, voffB); PG8_STAGE(PG8_SA(0, 0), cA, voffA); PG8_STAGE(PG8_SA(0, 1), cA + hstep, voffA);
        if (wr == 1) PG8_BAR;
        PG8_WAIT_V(2); PG8_BAR;
        PG8_STAGE(PG8_SB(1, 0), cB + kstep, voffB); PG8_STAGE(PG8_SA(1, 0), cA + kstep, voffA); PG8_STAGE(PG8_SB(1, 1), cB + hstep + kstep, voffB);
        PG8_WAIT_V(6); PG8_BAR;
    } else {
        PG8_STAGE(PG8_SB(0, 0), cB, voffB); PG8_STAGE(PG8_SA(0, 0), cA, voffA); PG8_STAGE(PG8_SB(0, 1), cB + hstep, voffB); PG8_STAGE(PG8_SA(0, 1), cA + hstep, voffA);
        if (wr == 1) PG8_BAR;
        PG8_WAIT_V(4); PG8_BAR;
        PG8_STAGE(PG8_SB(1, 0), cB + kstep, voffB); PG8_STAGE(PG8_SA(1, 0), cA + kstep, voffA); PG8_STAGE(PG8_SB(1, 1), cB + hstep + kstep, voffB);
        PG8_WAIT_V(6); PG8_BAR;
    }
    for (;;) {
        const bool has_next = S.next(ui + 1, nxt);
        const char* nA = has_next ? (const char*)g.A + (size_t)nxt.pm * tstep : cA; const char* nB = has_next ? (const char*)g.Bt + (size_t)nxt.pn * tstep : cB;
        for (int t = 0; t < nt; t += 2) {
            const bool last = (t == nt - 2);
            const char* a1 = cA + (size_t)(t + 1) * kstep;
            const char* a2 = last ? nA : cA + (size_t)(t + 2) * kstep; const char* b2 = last ? nB : cB + (size_t)(t + 2) * kstep;
            const char* a3 = a2 + kstep; const char* b3 = b2 + kstep;
            if (last && has_next) S.a_ready(nxt);
            if constexpr (SP2) {
            PG8_LDB(B0, 0, 0); PG8_LDB(B1, 0, 1); PG8_SCHED; PG8_LDA(At, 0, 0); PG8_STAGE(PG8_SA(1, 1), a1 + hstep, voffA);
            PG8_WAIT_V(8); PG8_WAIT_L(0); PG8_BAR; PG8_MMA(0, 0, At, B0); PG8_MMA(0, 1, At, B1); PG8_BAR; PG8_SCHED;
            PG8_LDA(At, 0, 1); PG8_STAGE(PG8_SB(0, 0), b2, voffB); PG8_STAGE(PG8_SB(0, 1), b2 + hstep, voffB); PG8_STAGE(PG8_SA(0, 0), a2, voffA);
            PG8_WAIT_V(8); PG8_WAIT_L(0); PG8_BAR; PG8_MMA(1, 0, At, B0); PG8_MMA(1, 1, At, B1); PG8_BAR; PG8_SCHED;
            PG8_LDB(B0, 1, 0); PG8_LDB(B1, 1, 1); PG8_SCHED; PG8_LDA(At, 1, 0); PG8_STAGE(PG8_SA(0, 1), a2 + hstep, voffA);
            PG8_WAIT_V(8); PG8_WAIT_L(0); PG8_BAR; PG8_MMA(0, 0, At, B0); PG8_MMA(0, 1, At, B1); PG8_BAR; PG8_SCHED;
            PG8_LDA(At, 1, 1); PG8_STAGE(PG8_SB(1, 0), b3, voffB); PG8_STAGE(PG8_SB(1, 1), b3 + hstep, voffB); PG8_STAGE(PG8_SA(1, 0), a3, voffA);
            PG8_WAIT_V(8); PG8_WAIT_L(0); PG8_BAR; PG8_MMA(1, 0, At, B0); PG8_MMA(1, 1, At, B1); PG8_BAR; PG8_SCHED;
            } else {
            PG8_LDB(B0, 0, 0); PG8_SCHED; PG8_LDA(At, 0, 0); PG8_STAGE(PG8_SA(1, 1), a1 + hstep, voffA);
            PG8_WAIT_L(8); PG8_BAR; PG8_WAIT_L(0); PG8_MMA(0, 0, At, B0); PG8_BAR; PG8_SCHED;
            PG8_LDB(B1, 0, 1); PG8_STAGE(PG8_SB(0, 0), b2, voffB);
            PG8_BAR; PG8_WAIT_L(0); PG8_MMA(0, 1, At, B1); PG8_BAR;
            PG8_LDA(At, 0, 1); PG8_STAGE(PG8_SA(0, 0), a2, voffA);
            PG8_BAR; PG8_WAIT_L(0); PG8_MMA(1, 0, At, B0); PG8_BAR; PG8_SCHED;
            PG8_STAGE(PG8_SB(0, 1), b2 + hstep, voffB);
            PG8_WAIT_V(6); PG8_BAR; PG8_MMA(1, 1, At, B1); PG8_BAR;
            PG8_LDB(B0, 1, 0); PG8_SCHED; PG8_LDA(At, 1, 0); PG8_STAGE(PG8_SA(0, 1), a2 + hstep, voffA);
            PG8_WAIT_L(8); PG8_BAR; PG8_WAIT_L(0); PG8_MMA(0, 0, At, B0); PG8_BAR; PG8_SCHED;
            PG8_LDB(B1, 1, 1); PG8_STAGE(PG8_SB(1, 0), b3, voffB);
            PG8_BAR; PG8_WAIT_L(0); PG8_MMA(0, 1, At, B1); PG8_BAR;
            PG8_LDA(At, 1, 1); PG8_STAGE(PG8_SA(1, 0), a3, voffA);
            PG8_BAR; PG8_WAIT_L(0); PG8_MMA(1, 0, At, B0); PG8_BAR; PG8_SCHED;
            PG8_STAGE(PG8_SB(1, 1), b3 + hstep, voffB);
            PG8_WAIT_V(6); PG8_BAR; PG8_MMA(1, 1, At, B1); PG8_BAR;
            }
        }
        if constexpr (ALIGN_EPI) { if (wr == 0) PG8_BAR; }
        if constexpr (!Epi::AFTER_DRAIN) { E(acc, cur, wr, wc, fr, fq); S.done(cur); }
        if (!has_next) break;
#pragma unroll
        for (int a = 0; a < 2; ++a)
#pragma unroll
            for (int b = 0; b < 2; ++b)
#pragma unroll
                for (int m = 0; m < 4; ++m)
#pragma unroll
                    for (int n = 0; n < 2; ++n) acc[a][b][m][n] = (f32x4){0.f, 0.f, 0.f, 0.f};
        cur = nxt; cA = nA; cB = nB; ++ui;
        if constexpr (ALIGN_EPI) { if (wr == 1) PG8_BAR; }
    }
    PG8_WAIT_V(0);
    if constexpr (!ALIGN_EPI) { if (wr == 0) PG8_BAR; }
    PG8_BAR;
    if constexpr (Epi::AFTER_DRAIN) { E.fused(acc, cur, wr, wc, fr, fq, lds, wid, lane); S.done(cur); }
#undef PG8_SA
#undef PG8_SB
#undef PG8_STAGE
#undef PG8_LDA
#undef PG8_LDB
#undef PG8_MMA
#undef PG8_WAIT_V
#undef PG8_WAIT_L
#undef PG8_BAR
#undef PG8_SCHED
}
}
constexpr size_t MiB = 1u << 20;
constexpr size_t WS_CTL = 0, CTL_ZERO_BYTES = 1 * MiB;
constexpr size_t WS_MOD = 1 * MiB;
constexpr size_t WS_BIASA = 2 * MiB + 512 * 1024;
constexpr size_t WS_WIN = 3 * MiB, WS_WOUT = 10 * MiB, WS_W1 = 14 * MiB, WS_W2 = 22 * MiB;
constexpr size_t WS_H = 32 * MiB;
constexpr size_t WS_PROJ = 161 * MiB;
constexpr size_t WS_DT = 613 * MiB;
constexpr size_t WS_MIX = 618 * MiB;
constexpr size_t WS_SSQ = 876 * MiB;
constexpr size_t WS_HMID = 161 * MiB;
constexpr size_t WS_END = 882 * MiB;
static_assert(WS_H + (size_t)MT * DM * 2 <= WS_PROJ && WS_PROJ + (size_t)MT * NPROJ * 2 <= WS_DT && WS_DT + (size_t)MT * 16 * 4 <= WS_MIX && WS_MIX + (size_t)MT * MIXW * 2 <= WS_SSQ
              && WS_SSQ + (size_t)MT * 16 * 4 <= WS_END && WS_HMID + (size_t)MT * DFF * 2 <= WS_SSQ && WS_MOD + (size_t)NBT * NMOD * 4 <= WS_BIASA && WS_W2 + (size_t)DM * DFF * 2 <= WS_H, "d_ws map");

constexpr int NWAVES = 8;
constexpr int RING_OFF = 0, RING_BYTES = 131072;
constexpr int LDS_BYTES = 147456;

#define GAS __attribute__((address_space(1)))
#define LAS __attribute__((address_space(3)))
typedef unsigned short bf16;
typedef unsigned v4u __attribute__((ext_vector_type(4)));
typedef unsigned v2u __attribute__((ext_vector_type(2)));
typedef float f32x4 __attribute__((ext_vector_type(4)));
#define LDS_WAIT() asm volatile("s_waitcnt lgkmcnt(0)" ::: "memory")
__device__ __forceinline__ unsigned f2bf(float f) { unsigned u = __builtin_bit_cast(unsigned, f); return (u + 0x7fffu + ((u >> 16) & 1u)) >> 16; }
__device__ __forceinline__ unsigned pk2(float lo, float hi) { return f2bf(lo) | (f2bf(hi) << 16); }
__device__ __forceinline__ float bflo(unsigned w) { return __builtin_bit_cast(float, w << 16); }
__device__ __forceinline__ float bfhi(unsigned w) { return __builtin_bit_cast(float, w & 0xffff0000u); }
__device__ __forceinline__ float wave_sum(float v) {
#pragma unroll
    for (int o = 1; o < 64; o <<= 1) v += __shfl_xor(v, o);
    return v;
}
__device__ __forceinline__ float silu_f(float x) { return x / (1.f + __expf(-x)); }

struct Frame {
    LAS unsigned char* lds;
    int tid, lane, wave, vcu, G;
    const float* in[27]; float* out; unsigned char* ws;
};
#define IN_XP 0
#define IN_XS 1
#define IN_CPOOL 2
#define IN_CCONV 3
#define IN_SSM 4
#define IN_CP 5
#define IN_CS 6
#define IN_NW1 7
#define IN_NW2 8
#define IN_WADA 9
#define IN_BADA 10
#define IN_WIN 11
#define IN_POOLW 12
#define IN_POOLB 13
#define IN_POOLS 14
#define IN_CONVW 15
#define IN_CONVB 16
#define IN_DTB 17
#define IN_ALOG 18
#define IN_DSKIP 19
#define IN_SNW 20
#define IN_WOUT 21
#define IN_W1 22
#define IN_B1 23
#define IN_W2 24
#define IN_B2 25
#define IN_FNW 26

__device__ __forceinline__ void p0_mod(Frame& F) {
    const float* w_ada = F.in[IN_WADA]; const float* b_ada = F.in[IN_BADA]; float* mod = (float*)(F.ws + WS_MOD);
    LAS float* red = (LAS float*)(F.lds + RING_OFF);
    const int lane = F.lane, li = lane & 15, kq = lane >> 4;
    for (int ct = blockIdx.x; ct < NMOD / 16; ct += F.G) {
        f32x4 acc[3];
#pragma unroll
        for (int mt = 0; mt < 3; ++mt) acc[mt] = (f32x4){0.f, 0.f, 0.f, 0.f};
        const int k0 = F.wave * 128, col = ct * 16 + li;
        const float* cp[3]; cp[0] = F.in[IN_CP] + (size_t)li * DM; cp[1] = F.in[IN_CS] + (size_t)li * DM; cp[2] = F.in[IN_CS] + (size_t)(16 + li) * DM;
#pragma unroll 8
        for (int s = 0; s < 32; ++s) { const int k = k0 + 4 * s + kq; const float bval = w_ada[(size_t)k * NMOD + col];
#pragma unroll
            for (int mt = 0; mt < 3; ++mt) { const float a = silu_f(cp[mt][k]); acc[mt] = __builtin_amdgcn_mfma_f32_16x16x4f32(a, bval, acc[mt], 0, 0, 0); } }
#pragma unroll
        for (int mt = 0; mt < 3; ++mt)
#pragma unroll
            for (int r = 0; r < 4; ++r) red[((F.wave * 3 + mt) * 4 + r) * 64 + lane] = acc[mt][r];
        __syncthreads();
        for (int e = F.tid; e < 768; e += NWAVES * 64) { const int mt = e >> 8, r = (e >> 6) & 3, ln = e & 63; float s = 0.f;
#pragma unroll
            for (int w = 0; w < 8; ++w) s += red[((w * 3 + mt) * 4 + r) * 64 + ln];
            const int batch = 16 * mt + 4 * (ln >> 4) + r, c = ct * 16 + (ln & 15);
            mod[(size_t)batch * NMOD + c] = s + b_ada[c]; }
        __syncthreads();
    }
}
__device__ __forceinline__ void p0_transpose_item(const float* W, int ldw, int nblk, bf16* WT, int ldt, int kofs, const float* kscale, LAS float* scr, int item, int lane) {
    const int kb = item / nblk, nb = item % nblk, k0 = 64 * kb, n0 = 32 * nb;
#pragma unroll 8
    for (int i = 0; i < 32; ++i) { const int kk = 2 * i + (lane >> 5); float v = W[(size_t)(k0 + kk) * ldw + n0 + (lane & 31)]; if (kscale) v *= kscale[k0 + kk]; scr[kk * 33 + (lane & 31)] = v; }
    LDS_WAIT(); asm volatile("" ::: "memory");
    const int c = lane & 7;
#pragma unroll
    for (int j = 0; j < 4; ++j) { const int n = (lane >> 3) + 8 * j; const LAS float* s = scr + (8 * c) * 33 + n;
        v4u o; o.x = pk2(s[0 * 33], s[1 * 33]); o.y = pk2(s[2 * 33], s[3 * 33]); o.z = pk2(s[4 * 33], s[5 * 33]); o.w = pk2(s[6 * 33], s[7 * 33]);
        *(GAS v4u*)(WT + (size_t)(n0 + n) * ldt + kofs + k0 + 8 * c) = o; }
    LDS_WAIT(); asm volatile("" ::: "memory");
}
__device__ __forceinline__ void p0_weights(Frame& F) {
    LAS float* scr = (LAS float*)(F.lds + RING_OFF + 32768 + F.wave * 12288);
    const int gw = F.vcu * NWAVES + F.wave, NGW = F.G * NWAVES;
    bf16* Win_t = (bf16*)(F.ws + WS_WIN); bf16* Wout_t = (bf16*)(F.ws + WS_WOUT); bf16* W1_t = (bf16*)(F.ws + WS_W1); bf16* W2_t = (bf16*)(F.ws + WS_W2);
    constexpr int I_IN = (DM / 64) * (NPROJ / 32), I_OB = (DM / 64) * (DM / 32), I_1 = (DM / 64) * (DFF / 32), I_2 = (DFF / 64) * (DM / 32);
    constexpr int NITEMS = I_IN + I_OB + I_1 + I_2;
    for (int it = gw; it < NITEMS; it += NGW) {
        int r = it;
        if (r < I_IN) { p0_transpose_item(F.in[IN_WIN], LDWIN, NPROJ / 32, Win_t, DM, 0, nullptr, scr, r, F.lane); continue; } r -= I_IN;
        if (r < I_OB) { p0_transpose_item(F.in[IN_WOUT] + (size_t)DM * DM, DM, DM / 32, Wout_t, MIXW, DM, F.in[IN_SNW], scr, r, F.lane); continue; } r -= I_OB;
        if (r < I_1) { p0_transpose_item(F.in[IN_W1], DFF, DFF / 32, W1_t, DM, 0, nullptr, scr, r, F.lane); continue; } r -= I_1;
        p0_transpose_item(F.in[IN_W2], DM, DM / 32, W2_t, DFF, 0, nullptr, scr, r, F.lane);
    }
    const float* pw = F.in[IN_POOLW]; const float* ps = F.in[IN_POOLS]; const float* wo = F.in[IN_WOUT];
    const int li = F.lane & 15, kq = F.lane >> 4;
    for (int t = gw; t < 64 * 64; t += NGW) { const int it = t >> 6, nt = t & 63, g = it >> 4;
        f32x4 acc = (f32x4){0.f, 0.f, 0.f, 0.f};
        const float* arow = pw + ((size_t)(16 * it + li)) * 256;
#pragma unroll 8
        for (int s = 0; s < 64; ++s) { const int d = 4 * s + kq; const float a = arow[d] * ps[256 * g + d]; const float b = wo[(size_t)(256 * g + d) * DM + nt * 16 + li];
            acc = __builtin_amdgcn_mfma_f32_16x16x4f32(a, b, acc, 0, 0, 0); }
        v2u o; o.x = pk2(acc[0], acc[1]); o.y = pk2(acc[2], acc[3]);
        *(GAS v2u*)(Wout_t + (size_t)(nt * 16 + li) * MIXW + 16 * it + 4 * kq) = o; }
    if (blockIdx.x < 16) { const float* pb = F.in[IN_POOLB]; LAS float* red = (LAS float*)(F.lds + RING_OFF);
        const int n = blockIdx.x * 64 + F.lane; float s = 0.f;
        for (int k = F.wave * 128; k < F.wave * 128 + 128; ++k) s += pb[k] * ps[k] * wo[(size_t)k * DM + n];
        __syncthreads(); red[F.wave * 64 + F.lane] = s; __syncthreads();
        if (F.wave == 0) { float t = 0.f;
#pragma unroll
            for (int w = 0; w < 8; ++w) t += red[w * 64 + F.lane];
            ((float*)(F.ws + WS_BIASA))[n] = t; }
        __syncthreads(); }
}

template <bool WITH_DT>
__device__ __forceinline__ void norm_rows(Frame& F, const float* xrows  , int nrows, int grow0  , int batch, const float* nw, int sc_off, int sh_off, LAS float* wdt) {
    const float* mod = (const float*)(F.ws + WS_MOD) + (size_t)batch * NMOD; bf16* H = (bf16*)(F.ws + WS_H); float* DT = (float*)(F.ws + WS_DT);
    const int lane = F.lane;
    f32x4 a1[4], s1[4];
#pragma unroll
    for (int j = 0; j < 4; ++j) { const f32x4 w = *(const f32x4*)(nw + 256 * j + 4 * lane), sc = *(const f32x4*)(mod + sc_off + 256 * j + 4 * lane); a1[j] = w * (sc + 1.0f); s1[j] = *(const f32x4*)(mod + sh_off + 256 * j + 4 * lane); }
    for (int r = 0; r < nrows; ++r) {
        const GAS f32x4* xr = (const GAS f32x4*)(xrows + (size_t)r * DM) + lane;
        f32x4 v[4]; float ss = 0.f;
#pragma unroll
        for (int j = 0; j < 4; ++j) { v[j] = xr[64 * j]; ss += (v[j].x * v[j].x + v[j].y * v[j].y) + (v[j].z * v[j].z + v[j].w * v[j].w); }
        const float rs = 1.0f / sqrtf(wave_sum(ss) * (1.f / DM) + EPS);
#pragma unroll
        for (int j = 0; j < 4; ++j) v[j] = v[j] * rs * a1[j] + s1[j];
        GAS unsigned long long* o8 = (GAS unsigned long long*)(H + (size_t)(grow0 + r) * DM) + lane;
#pragma unroll
        for (int j = 0; j < 4; ++j) o8[64 * j] = (unsigned long long)pk2(v[j].x, v[j].y) | ((unsigned long long)pk2(v[j].z, v[j].w) << 32);
        if constexpr (WITH_DT) {
            float acc[16];
#pragma unroll
            for (int c = 0; c < 16; ++c) acc[c] = 0.f;
#pragma unroll
            for (int j = 0; j < 4; ++j)
#pragma unroll
                for (int i = 0; i < 4; ++i) { const float hv = v[j][i]; const LAS f32x4* wr = (const LAS f32x4*)(wdt + (i * 256 + j * 64 + lane) * 20);
#pragma unroll
                    for (int q = 0; q < 4; ++q) { const f32x4 w = wr[q]; acc[4 * q + 0] += hv * w.x; acc[4 * q + 1] += hv * w.y; acc[4 * q + 2] += hv * w.z; acc[4 * q + 3] += hv * w.w; }
                    if (i & 1) asm volatile("" ::: "memory"); }
#pragma unroll
            for (int c = 0; c < 8; ++c) { const bool hi = lane & 1; const float keep = hi ? acc[c + 8] : acc[c], send = hi ? acc[c] : acc[c + 8]; acc[c] = keep + __shfl_xor(send, 1); }
#pragma unroll
            for (int c = 0; c < 4; ++c) { const bool hi = lane & 2; const float keep = hi ? acc[c + 4] : acc[c], send = hi ? acc[c] : acc[c + 4]; acc[c] = keep + __shfl_xor(send, 2); }
#pragma unroll
            for (int c = 0; c < 2; ++c) { const bool hi = lane & 4; const float keep = hi ? acc[c + 2] : acc[c], send = hi ? acc[c] : acc[c + 2]; acc[c] = keep + __shfl_xor(send, 4); }
            { const bool hi = lane & 8; const float keep = hi ? acc[1] : acc[0], send = hi ? acc[0] : acc[1]; acc[0] = keep + __shfl_xor(send, 8); }
            float t = acc[0]; t += __shfl_xor(t, 16); t += __shfl_xor(t, 32);
            if (lane < 16) { const int ch = 8 * (lane & 1) + 4 * ((lane >> 1) & 1) + 2 * ((lane >> 2) & 1) + ((lane >> 3) & 1); DT[(size_t)(grow0 + r) * 16 + ch] = t; }
        }
    }
}
template <bool FIRST>
__device__ __forceinline__ void p_norm(Frame& F) {
    LAS float* wdt = (LAS float*)(F.lds + RING_OFF);
    if constexpr (FIRST) {
        for (int k = F.tid; k < DM; k += NWAVES * 64) { const f32x4* src = (const f32x4*)(F.in[IN_WIN] + (size_t)k * LDWIN + NPROJ);
            LAS f32x4* dst = (LAS f32x4*)(wdt + ((k & 3) * 256 + (k >> 8) * 64 + ((k >> 2) & 63)) * 20);
            dst[0] = src[0]; dst[1] = src[1]; dst[2] = src[2]; dst[3] = src[3]; }
        __syncthreads();
    }
    const int gw = F.vcu * NWAVES + F.wave;
    const float* nw = F.in[FIRST ? IN_NW1 : IN_NW2]; const int sc_off = FIRST ? DM : 4 * DM, sh_off = FIRST ? 0 : 3 * DM;
    for (int w = gw; w < MP / 32; w += F.G * NWAVES) {
        const float* src = FIRST ? F.in[IN_XP] + (size_t)w * 32 * DM : F.out + O_Y + (size_t)w * 32 * DM;
        norm_rows<FIRST>(F, src, 32, w * 32, w >> 7, nw, sc_off, sh_off, wdt); }
    for (int w = gw; w < MS; w += F.G * NWAVES) {
        const float* src = FIRST ? F.in[IN_XS] + (size_t)w * DM : F.out + O_Y + (size_t)(MP + w) * DM;
        norm_rows<FIRST>(F, src, 1, MP + w, NB_P + (w >> 4), nw, sc_off, sh_off, wdt); }
}

template <int W>
__device__ __forceinline__ void pool_item(const bf16* PROJ, bf16* MIX, int row0, int nblk16, bool seq_start, const float* hist  , int c0) {
    float px[16], py[16];
#pragma unroll
    for (int i = 0; i < 16; ++i) { px[i] = 0.f; py[i] = 0.f; }
    if (hist) {
#pragma unroll
        for (int i = 0; i < 15; ++i) { const float2 h = *(const float2*)(hist + (size_t)i * DM + c0); px[i + 1] = h.x; py[i + 1] = h.y; }
    } else if (!seq_start) {
#pragma unroll
        for (int i = 0; i < 16; ++i) { const unsigned w = *(const unsigned*)(PROJ + (size_t)(row0 - 16 + i) * NPROJ + c0); px[i] = bflo(w); py[i] = bfhi(w); }
    }
    for (int blk = 0; blk < nblk16; ++blk) {
        float cx[16], cy[16];
#pragma unroll
        for (int j = 0; j < 16; ++j) { const unsigned w = *(const unsigned*)(PROJ + (size_t)(row0 + 16 * blk + j) * NPROJ + c0); cx[j] = bflo(w); cy[j] = bfhi(w); }
        float sx = 0.f, sy = 0.f;
#pragma unroll
        for (int i = 1; i < W; ++i) { sx += px[16 - i]; sy += py[16 - i]; }
        const bool first = seq_start && blk == 0;
#pragma unroll
        for (int j = 0; j < 16; ++j) {
            sx += cx[j]; sy += cy[j];
            const float inv = (first && j + 1 < W) ? 1.0f / (float)(j + 1) : 1.0f / (float)W;
            const float ox = sx * inv - cx[j], oy = sy * inv - cy[j];
            *(unsigned*)(MIX + (size_t)(row0 + 16 * blk + j) * MIXW + c0) = pk2(ox, oy);
            const int idx = j - (W - 1);
            if (idx < 0) { sx -= px[16 + idx]; sy -= py[16 + idx]; } else { sx -= cx[idx]; sy -= cy[idx]; }
        }
#pragma unroll
        for (int i = 0; i < 16; ++i) { px[i] = cx[i]; py[i] = cy[i]; }
    }
}
__device__ __forceinline__ void p3_pool(Frame& F) {
    const bf16* PROJ = (const bf16*)(F.ws + WS_PROJ); bf16* MIX = (bf16*)(F.ws + WS_MIX);
    const int c0 = 2 * F.tid, g = F.tid >> 7;
    for (int it = blockIdx.x; it < MP / 64 + NB_S; it += F.G) {
        int row0, nb; bool st; const float* hist = nullptr;
        if (it < MP / 64) { row0 = it * 64; nb = 4; st = (row0 & (SEQ - 1)) == 0; }
        else { const int sb = it - MP / 64; row0 = MP + sb * DSEQ; nb = 1; st = false; hist = F.in[IN_CPOOL] + (size_t)sb * 15 * DM; }
        if (g == 0) pool_item<2>(PROJ, MIX, row0, nb, st, hist, c0);
        else if (g == 1) pool_item<4>(PROJ, MIX, row0, nb, st, hist, c0);
        else if (g == 2) pool_item<8>(PROJ, MIX, row0, nb, st, hist, c0);
        else pool_item<16>(PROJ, MIX, row0, nb, st, hist, c0);
    }
}
__device__ __forceinline__ void p3_conv(Frame& F) {
    const bf16* PROJ = (const bf16*)(F.ws + WS_PROJ); bf16* XB = (bf16*)(F.out + O_Y);
    const float* cw = F.in[IN_CONVW]; const float* cb = F.in[IN_CONVB];
    const int gw = F.vcu * NWAVES + F.wave, NGW = F.G * NWAVES;
    constexpr int NQ_P = (MP / 64) * 12, NQ = NQ_P + NB_S * 12;
    for (int q = gw; q < NQ; q += NGW) {
        int row0, nr, strip; bool zero_hist; const float* hist = nullptr;
        if (q < NQ_P) { const int blk = q / 12; strip = q - blk * 12; row0 = blk * 64; nr = 64; zero_hist = (row0 & (SEQ - 1)) == 0; }
        else { const int qq = q - NQ_P, sb = qq / 12; strip = qq - sb * 12; row0 = MP + sb * DSEQ; nr = DSEQ; zero_hist = false; hist = F.in[IN_CCONV] + (size_t)sb * 3 * CONVD; }
        const int c0 = strip * 128 + 2 * F.lane;
        float w0x = cw[c0], w0y = cw[c0 + 1], w1x = cw[CONVD + c0], w1y = cw[CONVD + c0 + 1], w2x = cw[2 * CONVD + c0], w2y = cw[2 * CONVD + c0 + 1], w3x = cw[3 * CONVD + c0], w3y = cw[3 * CONVD + c0 + 1];
        const float bx = cb[c0], by = cb[c0 + 1];
        float x3x = 0.f, x3y = 0.f, x2x = 0.f, x2y = 0.f, x1x = 0.f, x1y = 0.f;
        if (hist) { x3x = hist[c0]; x3y = hist[c0 + 1]; x2x = hist[CONVD + c0]; x2y = hist[CONVD + c0 + 1]; x1x = hist[2 * CONVD + c0]; x1y = hist[2 * CONVD + c0 + 1]; }
        else if (!zero_hist) { const unsigned a = *(const unsigned*)(PROJ + (size_t)(row0 - 3) * NPROJ + 2048 + c0), b = *(const unsigned*)(PROJ + (size_t)(row0 - 2) * NPROJ + 2048 + c0), c = *(const unsigned*)(PROJ + (size_t)(row0 - 1) * NPROJ + 2048 + c0);
            x3x = bflo(a); x3y = bfhi(a); x2x = bflo(b); x2y = bfhi(b); x1x = bflo(c); x1y = bfhi(c); }
#pragma unroll 8
        for (int j = 0; j < nr; ++j) {
            const unsigned w = *(const unsigned*)(PROJ + (size_t)(row0 + j) * NPROJ + 2048 + c0); const float x0x = bflo(w), x0y = bfhi(w);
            const float ox = bx + w0x * x3x + w1x * x2x + w2x * x1x + w3x * x0x, oy = by + w0y * x3y + w1y * x2y + w2y * x1y + w3y * x0y;
            *(unsigned*)(XB + (size_t)(row0 + j) * CONVD + c0) = pk2(silu_f(ox), silu_f(oy));
            x3x = x2x; x3y = x2y; x2x = x1x; x2y = x1y; x1x = x0x; x1y = x0y;
        }
    }
}

__device__ __forceinline__ void p4_ssd(Frame& F) {
    const bf16* XB = (const bf16*)(F.out + O_Y); const bf16* PROJ = (const bf16*)(F.ws + WS_PROJ); bf16* MIX = (bf16*)(F.ws + WS_MIX);
    const float* DT = (const float*)(F.ws + WS_DT); float* SSQ = (float*)(F.ws + WS_SSQ);
    LAS float* Xs = (LAS float*)(F.lds + RING_OFF); LAS float* Bs = Xs + 64 * 64; LAS float* Cs = Bs + 64 * 128; LAS float* Ys = Cs + 64 * 128; LAS float* dts = Ys + 64 * 64; LAS float* as = dts + 64;
    const int tid = F.tid, pg = tid >> 5, ngi = tid & 31;
    for (int it = blockIdx.x; it < NB_P * NH + NB_S * NH; it += F.G) {
        int rowbase, L, h; float* sout; f32x4 st[4];
        if (it < NB_P * NH) { const int b = it >> 4; h = it & 15; rowbase = b * SEQ; L = SEQ; sout = F.out + O_SP + (size_t)it * HD * NST;
#pragma unroll
            for (int i = 0; i < 4; ++i) st[i] = (f32x4){0.f, 0.f, 0.f, 0.f}; }
        else { const int s = it - NB_P * NH, sb = s >> 4; h = s & 15; rowbase = MP + sb * DSEQ; L = DSEQ; sout = F.out + O_SS + (size_t)s * HD * NST;
            const float* sin = F.in[IN_SSM] + (size_t)s * HD * NST;
#pragma unroll
            for (int i = 0; i < 4; ++i) st[i] = *(const f32x4*)(sin + (size_t)(4 * pg + i) * NST + 4 * ngi); }
        const int g = h >> 3; const float Ah = -expf(F.in[IN_ALOG][h]), dtb = F.in[IN_DTB][h], Dh = F.in[IN_DSKIP][h];
        for (int t0 = 0; t0 < L; t0 += 64) {
            const int nt = (L - t0) < 64 ? (L - t0) : 64;
            { const int tt = tid >> 3, p8 = (tid & 7) * 8;
              if (tt < nt) { const v4u w = *(const v4u*)(XB + (size_t)(rowbase + t0 + tt) * CONVD + h * HD + p8); LAS f32x4* d = (LAS f32x4*)(Xs + tt * 64 + p8);
                  d[0] = (f32x4){bflo(w.x), bfhi(w.x), bflo(w.y), bfhi(w.y)}; d[1] = (f32x4){bflo(w.z), bfhi(w.z), bflo(w.w), bfhi(w.w)}; } }
#pragma unroll
            for (int rep = 0; rep < 2; ++rep) { const int tt = (tid >> 4) + 32 * rep, n8 = (tid & 15) * 8;
                if (tt < nt) { const bf16* rp = XB + (size_t)(rowbase + t0 + tt) * CONVD + 1024 + g * NST + n8; const v4u wb = *(const v4u*)rp, wc = *(const v4u*)(rp + 256);
                    LAS f32x4* db = (LAS f32x4*)(Bs + tt * 128 + n8); LAS f32x4* dc = (LAS f32x4*)(Cs + tt * 128 + n8);
                    db[0] = (f32x4){bflo(wb.x), bfhi(wb.x), bflo(wb.y), bfhi(wb.y)}; db[1] = (f32x4){bflo(wb.z), bfhi(wb.z), bflo(wb.w), bfhi(wb.w)};
                    dc[0] = (f32x4){bflo(wc.x), bfhi(wc.x), bflo(wc.y), bfhi(wc.y)}; dc[1] = (f32x4){bflo(wc.z), bfhi(wc.z), bflo(wc.w), bfhi(wc.w)}; } }
            if (tid < nt) { const float r = DT[(size_t)(rowbase + t0 + tid) * 16 + h] + dtb; const float d = fmaxf(r, 0.f) + log1pf(expf(-fabsf(r))); dts[tid] = d; as[tid] = expf(d * Ah); }
            __syncthreads();
            for (int t = 0; t < nt; ++t) {
                const float a = as[t], d = dts[t];
                const f32x4 xv = *(const LAS f32x4*)(Xs + t * 64 + 4 * pg), bv = *(const LAS f32x4*)(Bs + t * 128 + 4 * ngi), cv = *(const LAS f32x4*)(Cs + t * 128 + 4 * ngi);
                float yp[4];
#pragma unroll
                for (int i = 0; i < 4; ++i) { const float xd = xv[i] * d; st[i] = st[i] * a + bv * xd; yp[i] = (st[i].x * cv.x + st[i].y * cv.y) + (st[i].z * cv.z + st[i].w * cv.w); }
                { const bool hi = ngi & 1; const float k0 = hi ? yp[2] : yp[0], s0 = hi ? yp[0] : yp[2], k1 = hi ? yp[3] : yp[1], s1 = hi ? yp[1] : yp[3]; yp[0] = k0 + __shfl_xor(s0, 1); yp[1] = k1 + __shfl_xor(s1, 1); }
                { const bool hi = ngi & 2; const float k0 = hi ? yp[1] : yp[0], s0 = hi ? yp[0] : yp[1]; yp[0] = k0 + __shfl_xor(s0, 2); }
                float y = yp[0]; y += __shfl_xor(y, 4); y += __shfl_xor(y, 8); y += __shfl_xor(y, 16);
                if (ngi < 4) Ys[t * 64 + 4 * pg + 2 * (ngi & 1) + ((ngi >> 1) & 1)] = y;
            }
            __syncthreads();
            { const int tt = tid >> 3, p8 = (tid & 7) * 8;
              if (tt < nt) { const size_t row = (size_t)(rowbase + t0 + tt);
                  const v4u zw = *(const v4u*)(PROJ + row * NPROJ + 1024 + h * HD + p8);
                  const f32x4 y0 = *(const LAS f32x4*)(Ys + tt * 64 + p8), y1 = *(const LAS f32x4*)(Ys + tt * 64 + p8 + 4), x0 = *(const LAS f32x4*)(Xs + tt * 64 + p8), x1 = *(const LAS f32x4*)(Xs + tt * 64 + p8 + 4);
                  const float z[8] = {bflo(zw.x), bfhi(zw.x), bflo(zw.y), bfhi(zw.y), bflo(zw.z), bfhi(zw.z), bflo(zw.w), bfhi(zw.w)};
                  float o[8]; float ss = 0.f;
#pragma unroll
                  for (int i = 0; i < 4; ++i) { o[i] = (y0[i] + Dh * x0[i]) * silu_f(z[i]); o[4 + i] = (y1[i] + Dh * x1[i]) * silu_f(z[4 + i]); }
#pragma unroll
                  for (int i = 0; i < 8; ++i) ss += o[i] * o[i];
                  ss += __shfl_xor(ss, 1); ss += __shfl_xor(ss, 2); ss += __shfl_xor(ss, 4);
                  if ((tid & 7) == 0) SSQ[row * 16 + h] = ss;
                  v4u ow; ow.x = pk2(o[0], o[1]); ow.y = pk2(o[2], o[3]); ow.z = pk2(o[4], o[5]); ow.w = pk2(o[6], o[7]);
                  *(v4u*)(MIX + row * MIXW + 1024 + h * HD + p8) = ow; }
            }
            __syncthreads();
        }
#pragma unroll
        for (int i = 0; i < 4; ++i) *(f32x4*)(sout + (size_t)(4 * pg + i) * NST + 4 * ngi) = st[i];
    }
}
__device__ __forceinline__ void p4b_gnorm(Frame& F) {
    bf16* MIX = (bf16*)(F.ws + WS_MIX); const float* SSQ = (const float*)(F.ws + WS_SSQ);
    const int gw = F.vcu * NWAVES + F.wave, NGW = F.G * NWAVES, lane = F.lane;
    for (int row = gw; row < MT; row += NGW) {
        float s = SSQ[(size_t)row * 16 + (lane & 15)];
        s += __shfl_xor(s, 1); s += __shfl_xor(s, 2); s += __shfl_xor(s, 4);
        const float sg = __shfl(s, (lane >> 5) * 8);
        const float rs = 1.0f / sqrtf(sg * (1.f / 512.f) + EPS);
        v4u* p = (v4u*)(MIX + (size_t)row * MIXW + 1024 + 16 * lane);
#pragma unroll
        for (int q = 0; q < 2; ++q) { v4u w = p[q];
            w.x = pk2(bflo(w.x) * rs, bfhi(w.x) * rs); w.y = pk2(bflo(w.y) * rs, bfhi(w.y) * rs); w.z = pk2(bflo(w.z) * rs, bfhi(w.z) * rs); w.w = pk2(bflo(w.w) * rs, bfhi(w.w) * rs);
            p[q] = w; }
    }
}
__device__ __forceinline__ void p9_final(Frame& F) {
    const float* fw = F.in[IN_FNW]; const int gw = F.vcu * NWAVES + F.wave, NGW = F.G * NWAVES, lane = F.lane;
    f32x4 w[4];
#pragma unroll
    for (int j = 0; j < 4; ++j) w[j] = *(const f32x4*)(fw + 256 * j + 4 * lane);
    for (int row = gw; row < MT; row += NGW) {
        GAS f32x4* xr = (GAS f32x4*)(F.out + O_Y + (size_t)row * DM) + lane;
        f32x4 v[4]; float ss = 0.f;
#pragma unroll
        for (int j = 0; j < 4; ++j) { v[j] = xr[64 * j]; ss += (v[j].x * v[j].x + v[j].y * v[j].y) + (v[j].z * v[j].z + v[j].w * v[j].w); }
        const float rs = 1.0f / sqrtf(wave_sum(ss) * (1.f / DM) + EPS);
#pragma unroll
        for (int j = 0; j < 4; ++j) xr[64 * j] = v[j] * rs * w[j];
    }
}

constexpr int N_PHASES = 11;
struct Args { const float* in[27]; float* out; unsigned char* ws; int ph_lo, ph_hi; };
__global__ void __launch_bounds__(NWAVES * 64, 2) hymba_fwd(Args args) {
    extern __shared__ __attribute__((aligned(16))) unsigned char lds[];
    Frame F;
    F.lds = (LAS unsigned char*)lds;
    F.tid = threadIdx.x; F.lane = F.tid & 63; F.wave = __builtin_amdgcn_readfirstlane(F.tid >> 6);
    F.G = gridDim.x; { const int bx = blockIdx.x; F.vcu = (F.G % 8 == 0) ? (bx % 8) * (F.G / 8) + bx / 8 : bx; }
#pragma unroll
    for (int i = 0; i < 27; ++i) F.in[i] = args.in[i];
    F.out = args.out; F.ws = args.ws;
    const int lo = args.ph_lo, hi = args.ph_hi;
#ifndef PHASE_MASK
#define PHASE_MASK 0x7ff
#endif
#define IN(k) (((PHASE_MASK >> (k)) & 1) && lo <= (k) && (k) < hi)
#define SEAM(k) do { if (IN(k) && IN((k) + 1)) { cg::this_grid().sync(); } } while (0)
    bf16* Hb = (bf16*)(F.ws + WS_H); bf16* PROJ = (bf16*)(F.ws + WS_PROJ); bf16* MIX = (bf16*)(F.ws + WS_MIX); bf16* HMID = (bf16*)(F.ws + WS_HMID);
    const float* mod = (const float*)(F.ws + WS_MOD);

    if (IN(0)) { p0_mod(F); p0_weights(F); } SEAM(0);
    if (IN(1)) { p_norm<true>(F); } SEAM(1);
    if (IN(2)) {
        pg8::Gemm g{Hb, (const bf16*)(F.ws + WS_WIN), MT, NPROJ, DM}; pg8::StaticOrder S; S.init(MT, NPROJ, F.G, (int)blockIdx.x);
        pg8::EpiProj E{PROJ, F.out, O_PP, O_CP, O_PS, O_CS};
        pg8::gemm_phase<pg8::EpiProj, pg8::StaticOrder, true, true>(F.lds + RING_OFF, g, S, E);
    } SEAM(2);
    if (IN(3)) { p3_pool(F); p3_conv(F); } SEAM(3);
    if (IN(4)) { p4_ssd(F); } SEAM(4);
    if (IN(5)) { p4b_gnorm(F); } SEAM(5);
    if (IN(6)) {
        pg8::Gemm g{MIX, (const bf16*)(F.ws + WS_WOUT), MT, DM, MIXW}; pg8::StaticOrder S; S.init(MT, DM, F.G, (int)blockIdx.x);
        pg8::EpiRes E{F.in[IN_XP], F.in[IN_XS], F.out + O_Y, (const float*)(F.ws + WS_BIASA), mod + 2 * DM};
        pg8::gemm_phase<pg8::EpiRes, pg8::StaticOrder, true, true>(F.lds + RING_OFF, g, S, E);
    } SEAM(6);
    if (IN(7)) { p_norm<false>(F); } SEAM(7);
    if (IN(8)) {
        pg8::Gemm g{Hb, (const bf16*)(F.ws + WS_W1), MT, DFF, DM}; pg8::StaticOrder S; S.init(MT, DFF, F.G, (int)blockIdx.x);
        pg8::EpiRelu2 E{HMID, F.in[IN_B1]};
        pg8::gemm_phase<pg8::EpiRelu2, pg8::StaticOrder, true, true>(F.lds + RING_OFF, g, S, E);
    } SEAM(8);
    if (IN(9)) {
        pg8::Gemm g{HMID, (const bf16*)(F.ws + WS_W2), MT, DM, DFF}; pg8::StaticOrder S; S.init(MT, DM, F.G, (int)blockIdx.x);
        pg8::EpiRes E{F.out + O_Y, F.out + O_Y + (size_t)MP * DM, F.out + O_Y, F.in[IN_B2], mod + 5 * DM};
        pg8::gemm_phase<pg8::EpiRes, pg8::StaticOrder, true, true>(F.lds + RING_OFF, g, S, E);
    } SEAM(9);
    if (IN(10)) { p9_final(F); }
#undef IN
#undef SEAM
}

#ifndef MK_ONE_LAUNCH
#define MK_ONE_LAUNCH 1
#endif
extern "C" void kernel_launch(void* const* d_in, const int* in_sizes, int n_in, void* d_out, int out_size, void* d_ws, size_t ws_size, hipStream_t stream) {
    static int grid = 0;
    if (grid == 0) {
        if (n_in != 27 || in_sizes[0] != MP * DM || (size_t)out_size != O_END || ws_size < WS_END) {
            fprintf(stderr, "kernel_launch: shape mismatch: n_in %d in0 %d out %d ws %zu (need %zu)\n", n_in, n_in > 0 ? in_sizes[0] : -1, out_size, ws_size, (size_t)WS_END); grid = -1; return; }
        int dev = 0, cus = 0, per_cu = 0;
        if (hipGetDevice(&dev) != hipSuccess || hipDeviceGetAttribute(&cus, hipDeviceAttributeMultiprocessorCount, dev) != hipSuccess) { grid = -1; return; }
        if (hipFuncSetAttribute((const void*)hymba_fwd, hipFuncAttributeMaxDynamicSharedMemorySize, LDS_BYTES) != hipSuccess) { fprintf(stderr, "kernel_launch: hipFuncSetAttribute failed\n"); grid = -1; return; }
        if (hipOccupancyMaxActiveBlocksPerMultiprocessor(&per_cu, (const void*)hymba_fwd, NWAVES * 64, LDS_BYTES) != hipSuccess || per_cu < 1) { fprintf(stderr, "kernel_launch: occupancy query says %d blocks per CU\n", per_cu); per_cu = 1; }
        (void)hipGetLastError();
        grid = cus;
        if (grid > cus * per_cu) grid = cus * per_cu;
    }
    if (grid < 0) return;
    Args a{};
    for (int i = 0; i < 27; ++i) a.in[i] = (const float*)d_in[i];
    a.out = (float*)d_out; a.ws = (unsigned char*)d_ws;
#if MK_ONE_LAUNCH
    a.ph_lo = 0; a.ph_hi = N_PHASES;
    void* kargs[] = {&a};
    hipError_t e = hipLaunchCooperativeKernel((const void*)hymba_fwd, dim3(grid), dim3(NWAVES * 64), kargs, LDS_BYTES, stream);
    if (e != hipSuccess) fprintf(stderr, "kernel_launch: cooperative launch failed: %s (grid %d)\n", hipGetErrorString(e), grid);
#else
    for (int p = 0; p < N_PHASES; ++p) { a.ph_lo = p; a.ph_hi = p + 1;
        hipLaunchKernelGGL(hymba_fwd, dim3(grid), dim3(NWAVES * 64), LDS_BYTES, stream, a);
        const hipError_t le = hipPeekAtLastError(); if (le != hipSuccess) { fprintf(stderr, "kernel_launch: launch %d failed: %s\n", p, hipGetErrorName(le)); break; } }
#endif
}
```

```cpp
#include <hip/hip_runtime.h>
#include <hip/hip_cooperative_groups.h>
#include <cstdio>
#include <cstdint>
namespace cg = cooperative_groups;

constexpr int DM = 1024, NB_P = 16, SEQ = 4096, NB_S = 32, DSEQ = 16;
constexpr int MP = NB_P * SEQ, MS = NB_S * DSEQ, MT = MP + MS, NBT = NB_P + NB_S;
constexpr int NPROJ = 3584, LDWIN = 3600, DFF = 4096, MIXW = 2048, CONVD = 1536, NH = 16, HD = 64, NST = 128, NMOD = 6 * DM;
constexpr float EPS = 1e-6f;
constexpr size_t O_Y = 0, O_PP = (size_t)MT * DM, O_CP = O_PP + (size_t)NB_P * 15 * DM, O_SP = O_CP + (size_t)NB_P * 3 * CONVD,
                 O_PS = O_SP + (size_t)NB_P * NH * HD * NST, O_CS = O_PS + (size_t)NB_S * 15 * DM, O_SS = O_CS + (size_t)NB_S * 3 * CONVD,
                 O_END = O_SS + (size_t)NB_S * NH * HD * NST;
namespace pg8 {
#define PG8_LAS __attribute__((address_space(3)))
typedef unsigned short bf16_t;
typedef short bf16x8 __attribute__((ext_vector_type(8)));
typedef float f32x4 __attribute__((ext_vector_type(4)));
typedef unsigned u32x4 __attribute__((ext_vector_type(4)));
constexpr int BM = 256, BK = 64, HALF = 128, HTB = HALF * BK * 2  , STAGE_BYTES = 8 * HTB, NXCD = 8, WGM = 8;

__host__ __device__ __forceinline__ int lds_byte(int r, int c) { const int st = (r >> 4) * 2 + (c >> 5), rr = r & 15, cc = c & 31, ob = rr * 64 + cc * 2; return st * 1024 + (ob ^ (((ob >> 9) & 1) << 5)); }
__host__ __device__ __forceinline__ void stage_rc(int b, int& R, int& C) { const int st = b / 1024, sb = b % 1024, swz = sb ^ (((sb >> 9) & 1) << 5); R = (st >> 1) * 16 + swz / 64; C = (st & 1) * 32 + (swz % 64) / 2; }
__host__ __device__ __forceinline__ int perm32(int rho) { const int n = rho >> 4, i = rho & 15; return 8 * (i >> 2) + 4 * n + (i & 3); }

struct Unit { int pm, pn; };
struct Gemm { const bf16_t* A; const bf16_t* Bt; int M, N, K; };

struct StaticOrder {
    int nM, nN, nwg, G, c;
    __host__ __device__ void init(int M, int N, int G_, int c_) { nM = M / BM; nN = N / BM; nwg = nM * nN; G = G_; c = c_; }
    __host__ __device__ bool next(int i, Unit& u) const {
        const long L = (long)i * G + c; if (L >= nwg) return false;
        int wgid = (int)L; { const int q = nwg / NXCD, r = nwg % NXCD, xcd = wgid % NXCD, off = wgid / NXCD; wgid = (xcd < r ? xcd * (q + 1) : r * (q + 1) + (xcd - r) * q) + off; }
        const int nig = WGM * nN, gid = wgid / nig, fm = gid * WGM, gsz = (nM - fm) < WGM ? (nM - fm) : WGM;
        u.pm = fm + ((wgid % nig) % gsz); u.pn = (wgid % nig) / gsz; return true;
    }
    __device__ __forceinline__ void a_ready(const Unit&) const {}
    __device__ __forceinline__ void done(const Unit&) const {}
};
__device__ __forceinline__ unsigned cvt_pk_bf16(float lo, float hi) { unsigned r; asm volatile("v_cvt_pk_bf16_f32 %0, %1, %2" : "=v"(r) : "v"(lo), "v"(hi)); return r; }
typedef unsigned u32x2 __attribute__((ext_vector_type(2)));
struct EpiProj {
    static constexpr bool PERM = true, AFTER_DRAIN = false;
    bf16_t* O; float* out;
    size_t o_pp, o_cp, o_ps, o_cs;
    __device__ __forceinline__ void operator()(const f32x4 (&acc)[2][2][4][2], const Unit& u, int wr, int wc, int fr, int fq) const {
        const int row0 = u.pm * BM + wr * 64 + fr, col0 = u.pn * BM + wc * 32 + 8 * fq;
#pragma unroll
        for (int ai = 0; ai < 2; ++ai)
#pragma unroll
            for (int m = 0; m < 4; ++m) { bf16_t* rowp = O + (size_t)(row0 + ai * HALF + m * 16) * 3584 + col0;
#pragma unroll
                for (int bj = 0; bj < 2; ++bj) { const f32x4 v0 = acc[ai][bj][m][0], v1 = acc[ai][bj][m][1];
                    u32x4 w; w.x = cvt_pk_bf16(v0[0], v0[1]); w.y = cvt_pk_bf16(v0[2], v0[3]); w.z = cvt_pk_bf16(v1[0], v1[1]); w.w = cvt_pk_bf16(v1[2], v1[3]);
                    *(u32x4*)(rowp + bj * HALF) = w; } }
        const bool is_u = u.pn < 4, is_c = u.pn >= 8;
        if (!(is_u || is_c)) return;
        if (u.pm < 256) {
            if ((u.pm & 15) != 15 || wr != 1) return;
            const int b = u.pm >> 4, lr = 240 + fr;
            if (is_u) { if (fr >= 1) { float* dst = out + o_pp + ((size_t)(b * 15 + (fr - 1)) * 1024 + col0);
#pragma unroll
                    for (int bj = 0; bj < 2; ++bj) { *(f32x4*)(dst + bj * HALF) = acc[1][bj][3][0]; *(f32x4*)(dst + bj * HALF + 4) = acc[1][bj][3][1]; } } }
            else { if (fr >= 13) { float* dst = out + o_cp + ((size_t)(b * 3 + (fr - 13)) * 1536 + (col0 - 2048));
#pragma unroll
                    for (int bj = 0; bj < 2; ++bj) { *(f32x4*)(dst + bj * HALF) = acc[1][bj][3][0]; *(f32x4*)(dst + bj * HALF + 4) = acc[1][bj][3][1]; } } }
            (void)lr;
        } else {
#pragma unroll
            for (int ai = 0; ai < 2; ++ai)
#pragma unroll
                for (int m = 0; m < 4; ++m) { const int sb = (u.pm - 256) * 16 + 8 * ai + 4 * wr + m;
                    if (is_u) { if (fr >= 1) { float* dst = out + o_ps + ((size_t)(sb * 15 + (fr - 1)) * 1024 + col0);
#pragma unroll
                            for (int bj = 0; bj < 2; ++bj) { *(f32x4*)(dst + bj * HALF) = acc[ai][bj][m][0]; *(f32x4*)(dst + bj * HALF + 4) = acc[ai][bj][m][1]; } } }
                    else { if (fr >= 13) { float* dst = out + o_cs + ((size_t)(sb * 3 + (fr - 13)) * 1536 + (col0 - 2048));
#pragma unroll
                            for (int bj = 0; bj < 2; ++bj) { *(f32x4*)(dst + bj * HALF) = acc[ai][bj][m][0]; *(f32x4*)(dst + bj * HALF + 4) = acc[ai][bj][m][1]; } } } }
        }
    }
};
struct EpiRelu2 {
    static constexpr bool PERM = true, AFTER_DRAIN = false;
    bf16_t* O; const float* bias;
    __device__ __forceinline__ void operator()(const f32x4 (&acc)[2][2][4][2], const Unit& u, int wr, int wc, int fr, int fq) const {
        const int row0 = u.pm * BM + wr * 64 + fr, col0 = u.pn * BM + wc * 32 + 8 * fq;
        f32x4 bv[2][2];
#pragma unroll
        for (int bj = 0; bj < 2; ++bj)
#pragma unroll
            for (int n = 0; n < 2; ++n) bv[bj][n] = *(const f32x4*)(bias + col0 + bj * HALF + 4 * n);
#pragma unroll
        for (int ai = 0; ai < 2; ++ai)
#pragma unroll
            for (int m = 0; m < 4; ++m) { bf16_t* rowp = O + (size_t)(row0 + ai * HALF + m * 16) * 4096 + col0;
#pragma unroll
                for (int bj = 0; bj < 2; ++bj) { f32x4 v0 = acc[ai][bj][m][0] + bv[bj][0], v1 = acc[ai][bj][m][1] + bv[bj][1];
#pragma unroll
                    for (int j = 0; j < 4; ++j) { const float a = fmaxf(v0[j], 0.f), b = fmaxf(v1[j], 0.f); v0[j] = a * a; v1[j] = b * b; }
                    u32x4 w; w.x = cvt_pk_bf16(v0[0], v0[1]); w.y = cvt_pk_bf16(v0[2], v0[3]); w.z = cvt_pk_bf16(v1[0], v1[1]); w.w = cvt_pk_bf16(v1[2], v1[3]);
                    *(u32x4*)(rowp + bj * HALF) = w; } }
    }
};
struct EpiRes {
    static constexpr bool PERM = false, AFTER_DRAIN = false;
    const float* baseP; const float* baseS;
    float* out;
    const float* bias;
    const float* gate;
    __device__ __forceinline__ void operator()(const f32x4 (&acc)[2][2][4][2], const Unit& u, int wr, int wc, int fr, int fq) const {
        const bool smp = u.pm >= 256;
        const float* bp = smp ? baseS + (size_t)(u.pm - 256) * BM * 1024 : baseP + (size_t)u.pm * BM * 1024;
        float* op = out + (size_t)u.pm * BM * 1024;
        const int col0 = u.pn * BM + wc * 32 + 4 * fq;
        f32x4 bv[2][2];
#pragma unroll
        for (int bj = 0; bj < 2; ++bj)
#pragma unroll
            for (int n = 0; n < 2; ++n) bv[bj][n] = *(const f32x4*)(bias + col0 + bj * HALF + n * 16);
#pragma unroll
        for (int ai = 0; ai < 2; ++ai)
#pragma unroll
            for (int m = 0; m < 4; ++m) { const int lr = ai * HALF + wr * 64 + m * 16 + fr;
                const int b = smp ? 16 + (u.pm - 256) * 16 + (lr >> 4) : (u.pm >> 4);
                const float* gp = gate + (size_t)b * 6144 + col0; const size_t off = (size_t)lr * 1024 + col0;
#pragma unroll
                for (int bj = 0; bj < 2; ++bj)
#pragma unroll
                    for (int n = 0; n < 2; ++n) { const f32x4 g = *(const f32x4*)(gp + bj * HALF + n * 16), x = *(const f32x4*)(bp + off + bj * HALF + n * 16);
                        *(f32x4*)(op + off + bj * HALF + n * 16) = x + g * (acc[ai][bj][m][n] + bv[bj][n]); }
                asm volatile("" ::: "memory"); }
    }
};

template <class Epi, class Sched, bool ALIGN_EPI = false, bool SP2 = false>
__device__ __forceinline__ void gemm_phase(PG8_LAS unsigned char* lds, const Gemm g, const Sched& S, const Epi& E) {
    const int tid = threadIdx.x, wid = __builtin_amdgcn_readfirstlane(tid >> 6), lane = tid & 63, wr = wid >> 2, wc = wid & 3, fr = lane & 15, fq = lane >> 4;
    const int K = g.K, nt = K / BK;
    unsigned voffA[2], voffB[2];
#pragma unroll
    for (int i = 0; i < 2; ++i) { int R, C; stage_rc(tid * 16 + i * 8192, R, C); const int Rb = Epi::PERM ? ((R & ~31) + perm32(R & 31)) : R;
        voffA[i] = (unsigned)(R * K + C) * 2u; voffB[i] = (unsigned)(Rb * K + C) * 2u; }
    const size_t kstep = (size_t)(BK * 2);
    const size_t hstep = (size_t)HALF * K * 2;
    const size_t tstep = 2 * hstep;
    const unsigned ldsw = (unsigned)wid * 1024u;
    const int aoff = lds_byte(wr * 64 + fr, fq * 8), boff = lds_byte(wc * 32 + fr, fq * 8);
#define PG8_SA(b, h) (((b) * 2 + (h)) * HTB)
#define PG8_SB(b, h) ((4 + (b) * 2 + (h)) * HTB)
#define PG8_STAGE(bufoff, gbase, voff) do { _Pragma("unroll") for (int _i = 0; _i < 2; ++_i) \
        __builtin_amdgcn_global_load_lds((const unsigned*)((const char*)(gbase) + (voff)[_i]), (PG8_LAS unsigned*)(lds + (bufoff) + ldsw + _i * 8192), 16, 0, 0); } while (0)
#define PG8_LDA(dst, b, h) do { _Pragma("unroll") for (int m = 0; m < 4; ++m) _Pragma("unroll") for (int k = 0; k < 2; ++k) dst[m][k] = *(const PG8_LAS bf16x8*)(lds + PG8_SA(b, h) + aoff + m * 2048 + k * 1024); } while (0)
#define PG8_LDB(dst, b, h) do { _Pragma("unroll") for (int n = 0; n < 2; ++n) _Pragma("unroll") for (int k = 0; k < 2; ++k) dst[n][k] = *(const PG8_LAS bf16x8*)(lds + PG8_SB(b, h) + boff + n * 2048 + k * 1024); } while (0)
#define PG8_MMA(ai, bj, At, Bt) do { __builtin_amdgcn_s_setprio(1); _Pragma("unroll") for (int m = 0; m < 4; ++m) _Pragma("unroll") for (int n = 0; n < 2; ++n) _Pragma("unroll") for (int k = 0; k < 2; ++k) \
        acc[ai][bj][m][n] = __builtin_amdgcn_mfma_f32_16x16x32_bf16(Bt[n][k], At[m][k], acc[ai][bj][m][n], 0, 0, 0); __builtin_amdgcn_s_setprio(0); } while (0)
#define PG8_WAIT_V(n) asm volatile("s_waitcnt vmcnt(" #n ")" ::: "memory")
#define PG8_WAIT_L(n) asm volatile("s_waitcnt lgkmcnt(" #n ")" ::: "memory")
#define PG8_BAR __builtin_amdgcn_s_barrier()
#define PG8_SCHED __builtin_amdgcn_sched_barrier(0)
    Unit cur, nxt; int ui = 0;
    if (!S.next(0, cur)) return;
    f32x4 acc[2][2][4][2];
#pragma unroll
    for (int a = 0; a < 2; ++a)
#pragma unroll
        for (int b = 0; b < 2; ++b)
#pragma unroll
            for (int m = 0; m < 4; ++m)
#pragma unroll
                for (int n = 0; n < 2; ++n) acc[a][b][m][n] = (f32x4){0.f, 0.f, 0.f, 0.f};
    bf16x8 At[4][2], B0[2][2], B1[2][2];
    const char* cA = (const char*)g.A + (size_t)cur.pm * tstep; const char* cB = (const char*)g.Bt + (size_t)cur.pn * tstep;
    S.a_ready(cur);
    if constexpr (SP2) {
        PG8_STAGE(PG8_SB(0, 0), cB, voffB); PG8_STAGE(PG8_SB(0, 1), cB + hstep, voffB); PG8_STAGE(PG8_SA(0, 0), cA, voffA); PG8_STAGE(PG8_SA(0, 1), cA + hstep, voffA);
        if (wr == 1) PG8_BAR;
        PG8_WAIT_V(2); PG8_BAR;
        PG8_STAGE(PG8_SB(1, 0), cB + kstep, voffB); PG8_STAGE(PG8_SA(1, 0), cA + kstep, voffA); PG8_STAGE(PG8_SB(1, 1), cB + hstep + kstep, voffB);
        PG8_WAIT_V(6); PG8_BAR;
    } else {
        PG8_STAGE(PG8_SB(0, 0), cB, voffB); PG8_STAGE(PG8_SA(0, 0), cA, voffA); PG8_STAGE(PG8_SB(0, 1), cB + hstep, voffB); PG8_STAGE(PG8_SA(0, 1), cA + hstep, voffA);
        if (wr == 1) PG8_BAR;
        PG8_WAIT_V(4); PG8_BAR;
        PG8_STAGE(PG8_SB(1, 0), cB + kstep, voffB); PG8_STAGE(PG8_SA(1, 0), cA + kstep, voffA); PG8_STAGE(PG8_SB(1, 1), cB + hstep + kstep, voffB);
        PG8_WAIT_V(6); PG8_BAR;
    }
    for (;;) {
        const bool has_next = S.next(ui + 1, nxt);
        const char* nA = has_next ? (const char*)g.A + (size_t)nxt.pm * tstep : cA; const char* nB = has_next ? (const char*)g.Bt + (size_t)nxt.pn * tstep : cB;
        for (int t = 0; t < nt; t += 2) {
            const bool last = (t == nt - 2);
            const char* a1 = cA + (size_t)(t + 1) * kstep;
            const char* a2 = last ? nA : cA + (size_t)(t + 2) * kstep; const char* b2 = last ? nB : cB + (size_t)(t + 2) * kstep;
            const char* a3 = a2 + kstep; const char* b3 = b2 + kstep;
            if (last && has_next) S.a_ready(nxt);
            if constexpr (SP2) {
            PG8_LDB(B0, 0, 0); PG8_LDB(B1, 0, 1); PG8_SCHED; PG8_LDA(At, 0, 0); PG8_STAGE(PG8_SA(1, 1), a1 + hstep, voffA);
            PG8_WAIT_V(8); PG8_WAIT_L(0); PG8_BAR; PG8_MMA(0, 0, At, B0); PG8_MMA(0, 1, At, B1); PG8_BAR; PG8_SCHED;
            PG8_LDA(At, 0, 1); PG8_STAGE(PG8_SB(0, 0), b2, voffB); PG8_STAGE(PG8_SB(0, 1), b2 + hstep, voffB); PG8_STAGE(PG8_SA(0, 0), a2, voffA);
            PG8_WAIT_V(8); PG8_WAIT_L(0); PG8_BAR; PG8_MMA(1, 0, At, B0); PG8_MMA(1, 1, At, B1); PG8_BAR; PG8_SCHED;
            PG8_LDB(B0, 1, 0); PG8_LDB(B1, 1, 1); PG8_SCHED; PG8_LDA(At, 1, 0); PG8_STAGE(PG8_SA(0, 1), a2 + hstep, voffA);
            PG8_WAIT_V(8); PG8_WAIT_L(0); PG8_BAR; PG8_MMA(0, 0, At, B0); PG8_MMA(0, 1, At, B1); PG8_BAR; PG8_SCHED;
            PG8_LDA(At, 1, 1); PG8_STAGE(PG8_SB(1, 0), b3, voffB); PG8_STAGE(PG8_SB(1, 1), b3 + hstep, voffB); PG8_STAGE(PG8_SA(1, 0), a3, voffA);
            PG8_WAIT_V(8); PG8_WAIT_L(0); PG8_BAR; PG8_MMA(1, 0, At, B0); PG8_MMA(1, 1, At, B1); PG8_BAR; PG8_SCHED;
            } else {
            PG8_LDB(B0, 0, 0); PG8_SCHED; PG8_LDA(At, 0, 0); PG8_STAGE(PG8_SA(1, 1), a1 + hstep, voffA);
            PG8_WAIT_L(8); PG8_BAR; PG8_WAIT_L(0); PG8_MMA(0, 0, At, B0); PG8_BAR; PG8_SCHED;
            PG8_LDB(B1, 0, 1); PG8_STAGE(PG8_SB(0, 0), b2, voffB);
            PG8_BAR; PG8_WAIT_L(0); PG8_MMA(0, 1, At, B1); PG8_BAR;
            PG8_LDA(At, 0, 1); PG8_STAGE(PG8_SA(0, 0), a2, voffA);
            PG8_BAR; PG8_WAIT_L(0); PG8_MMA(1, 0, At, B0); PG8_BAR; PG8_SCHED;
            PG8_STAGE(PG8_SB(0, 1), b2 + hstep, voffB);
            PG8_WAIT_V(6); PG8_BAR; PG8_MMA(1, 1, At, B1); PG8_BAR;
            PG8_LDB(B0, 1, 0); PG8_SCHED; PG8_LDA(At, 1, 0); PG8_STAGE(PG8_SA(0, 1), a2 + hstep, voffA);
            PG8_WAIT_L(8); PG8_BAR; PG8_WAIT_L(0); PG8_MMA(0, 0, At, B0); PG8_BAR; PG8_SCHED;
            PG8_LDB(B1, 1, 1); PG8_STAGE(PG8_SB(1, 0), b3, voffB);
            PG8_BAR; PG8_WAIT_L(0); PG8_MMA(0, 1, At, B1); PG8_BAR;
            PG8_LDA(At, 1, 1); PG8_STAGE(PG8_SA(1, 0), a3, voffA);
            PG8_BAR; PG8_WAIT_L(0); PG8_MMA(1, 0, At, B0); PG8_BAR; PG8_SCHED;
            PG8_STAGE(PG8_SB(1, 1), b3 + hstep, voffB);
            PG8_WAIT_V(6); PG8_BAR; PG8_MMA(1, 1, At, B1); PG8_BAR;
            }
        }
        if constexpr (ALIGN_EPI) { if (wr == 0) PG8_BAR; }
        if constexpr (!Epi::AFTER_DRAIN) { E(acc, cur, wr, wc, fr, fq); S.done(cur); }
        if (!has_next) break;
#pragma unroll
        for (int a = 0; a < 2; ++a)
#pragma unroll
            for (int b = 0; b < 2; ++b)
#pragma unroll
                for (int m = 0; m < 4; ++m)
#pragma unroll
                    for (int n = 0; n < 2; ++n) acc[a][b][m][n] = (f32x4){0.f, 0.f, 0.f, 0.f};
        cur = nxt; cA = nA; cB = nB; ++ui;
        if constexpr (ALIGN_EPI) { if (wr == 1) PG8_BAR; }
    }
    PG8_WAIT_V(0);
    if constexpr (!ALIGN_EPI) { if (wr == 0) PG8_BAR; }
    PG8_BAR;
    if constexpr (Epi::AFTER_DRAIN) { E.fused(acc, cur, wr, wc, fr, fq, lds, wid, lane); S.done(cur); }
#undef PG8_SA
#undef PG8_SB
#undef PG8_STAGE
#undef PG8_LDA
#undef PG8_LDB
#undef PG8_MMA
#undef PG8_WAIT_V
#undef PG8_WAIT_L
#undef PG8_BAR
#undef PG8_SCHED
}
}
constexpr size_t MiB = 1u << 20;
constexpr size_t WS_CTL = 0, CTL_ZERO_BYTES = 1 * MiB;
constexpr size_t WS_MOD = 1 * MiB;
constexpr size_t WS_BIASA = 2 * MiB + 512 * 1024;
constexpr size_t WS_WIN = 3 * MiB, WS_WOUT = 10 * MiB, WS_W1 = 14 * MiB, WS_W2 = 22 * MiB;
constexpr size_t WS_H = 32 * MiB;
constexpr size_t WS_PROJ = 161 * MiB;
constexpr size_t WS_DT = 613 * MiB;
constexpr size_t WS_MIX = 618 * MiB;
constexpr size_t WS_SSQ = 876 * MiB;
constexpr size_t WS_HMID = 161 * MiB;
constexpr size_t WS_END = 882 * MiB;
static_assert(WS_H + (size_t)MT * DM * 2 <= WS_PROJ && WS_PROJ + (size_t)MT * NPROJ * 2 <= WS_DT && WS_DT + (size_t)MT * 16 * 4 <= WS_MIX && WS_MIX + (size_t)MT * MIXW * 2 <= WS_SSQ
              && WS_SSQ + (size_t)MT * 16 * 4 <= WS_END && WS_HMID + (size_t)MT * DFF * 2 <= WS_SSQ && WS_MOD + (size_t)NBT * NMOD * 4 <= WS_BIASA && WS_W2 + (size_t)DM * DFF * 2 <= WS_H, "d_ws map");

constexpr int NWAVES = 8;
constexpr int RING_OFF = 0, RING_BYTES = 131072;
constexpr int LDS_BYTES = 147456;

#define GAS __attribute__((address_space(1)))
#define LAS __attribute__((address_space(3)))
typedef unsigned short bf16;
typedef unsigned v4u __attribute__((ext_vector_type(4)));
typedef unsigned v2u __attribute__((ext_vector_type(2)));
typedef float f32x4 __attribute__((ext_vector_type(4)));
#define LDS_WAIT() asm volatile("s_waitcnt lgkmcnt(0)" ::: "memory")
__device__ __forceinline__ unsigned f2bf(float f) { unsigned u = __builtin_bit_cast(unsigned, f); return (u + 0x7fffu + ((u >> 16) & 1u)) >> 16; }
__device__ __forceinline__ unsigned pk2(float lo, float hi) { return f2bf(lo) | (f2bf(hi) << 16); }
__device__ __forceinline__ float bflo(unsigned w) { return __builtin_bit_cast(float, w << 16); }
__device__ __forceinline__ float bfhi(unsigned w) { return __builtin_bit_cast(float, w & 0xffff0000u); }
__device__ __forceinline__ float wave_sum(float v) {
#pragma unroll
    for (int o = 1; o < 64; o <<= 1) v += __shfl_xor(v, o);
    return v;
}
__device__ __forceinline__ float silu_f(float x) { return x / (1.f + __expf(-x)); }

struct Frame {
    LAS unsigned char* lds;
    int tid, lane, wave, vcu, G;
    const float* in[27]; float* out; unsigned char* ws;
};
#define IN_XP 0
#define IN_XS 1
#define IN_CPOOL 2
#define IN_CCONV 3
#define IN_SSM 4
#define IN_CP 5
#define IN_CS 6
#define IN_NW1 7
#define IN_NW2 8
#define IN_WADA 9
#define IN_BADA 10
#define IN_WIN 11
#define IN_POOLW 12
#define IN_POOLB 13
#define IN_POOLS 14
#define IN_CONVW 15
#define IN_CONVB 16
#define IN_DTB 17
#define IN_ALOG 18
#define IN_DSKIP 19
#define IN_SNW 20
#define IN_WOUT 21
#define IN_W1 22
#define IN_B1 23
#define IN_W2 24
#define IN_B2 25
#define IN_FNW 26

__device__ __forceinline__ void p0_mod(Frame& F) {
    const float* w_ada = F.in[IN_WADA]; const float* b_ada = F.in[IN_BADA]; float* mod = (float*)(F.ws + WS_MOD);
    LAS float* red = (LAS float*)(F.lds + RING_OFF);
    const int lane = F.lane, li = lane & 15, kq = lane >> 4;
    for (int ct = blockIdx.x; ct < NMOD / 16; ct += F.G) {
        f32x4 acc[3];
#pragma unroll
        for (int mt = 0; mt < 3; ++mt) acc[mt] = (f32x4){0.f, 0.f, 0.f, 0.f};
        const int k0 = F.wave * 128, col = ct * 16 + li;
        const float* cp[3]; cp[0] = F.in[IN_CP] + (size_t)li * DM; cp[1] = F.in[IN_CS] + (size_t)li * DM; cp[2] = F.in[IN_CS] + (size_t)(16 + li) * DM;
#pragma unroll 8
        for (int s = 0; s < 32; ++s) { const int k = k0 + 4 * s + kq; const float bval = w_ada[(size_t)k * NMOD + col];
#pragma unroll
            for (int mt = 0; mt < 3; ++mt) { const float a = silu_f(cp[mt][k]); acc[mt] = __builtin_amdgcn_mfma_f32_16x16x4f32(a, bval, acc[mt], 0, 0, 0); } }
#pragma unroll
        for (int mt = 0; mt < 3; ++mt)
#pragma unroll
            for (int r = 0; r < 4; ++r) red[((F.wave * 3 + mt) * 4 + r) * 64 + lane] = acc[mt][r];
        __syncthreads();
        for (int e = F.tid; e < 768; e += NWAVES * 64) { const int mt = e >> 8, r = (e >> 6) & 3, ln = e & 63; float s = 0.f;
#pragma unroll
            for (int w = 0; w < 8; ++w) s += red[((w * 3 + mt) * 4 + r) * 64 + ln];
            const int batch = 16 * mt + 4 * (ln >> 4) + r, c = ct * 16 + (ln & 15);
            mod[(size_t)batch * NMOD + c] = s + b_ada[c]; }
        __syncthreads();
    }
}
__device__ __forceinline__ void p0_transpose_item(const float* W, int ldw, int nblk, bf16* WT, int ldt, int kofs, const float* kscale, LAS float* scr, int item, int lane) {
    const int kb = item / nblk, nb = item % nblk, k0 = 64 * kb, n0 = 32 * nb;
#pragma unroll 8
    for (int i = 0; i < 32; ++i) { const int kk = 2 * i + (lane >> 5); float v = W[(size_t)(k0 + kk) * ldw + n0 + (lane & 31)]; if (kscale) v *= kscale[k0 + kk]; scr[kk * 33 + (lane & 31)] = v; }
    LDS_WAIT(); asm volatile("" ::: "memory");
    const int c = lane & 7;
#pragma unroll
    for (int j = 0; j < 4; ++j) { const int n = (lane >> 3) + 8 * j; const LAS float* s = scr + (8 * c) * 33 + n;
        v4u o; o.x = pk2(s[0 * 33], s[1 * 33]); o.y = pk2(s[2 * 33], s[3 * 33]); o.z = pk2(s[4 * 33], s[5 * 33]); o.w = pk2(s[6 * 33], s[7 * 33]);
        *(GAS v4u*)(WT + (size_t)(n0 + n) * ldt + kofs + k0 + 8 * c) = o; }
    LDS_WAIT(); asm volatile("" ::: "memory");
}
__device__ __forceinline__ void p0_weights(Frame& F) {
    LAS float* scr = (LAS float*)(F.lds + RING_OFF + 32768 + F.wave * 12288);
    const int gw = F.vcu * NWAVES + F.wave, NGW = F.G * NWAVES;
    bf16* Win_t = (bf16*)(F.ws + WS_WIN); bf16* Wout_t = (bf16*)(F.ws + WS_WOUT); bf16* W1_t = (bf16*)(F.ws + WS_W1); bf16* W2_t = (bf16*)(F.ws + WS_W2);
    constexpr int I_IN = (DM / 64) * (NPROJ / 32), I_OB = (DM / 64) * (DM / 32), I_1 = (DM / 64) * (DFF / 32), I_2 = (DFF / 64) * (DM / 32);
    constexpr int NITEMS = I_IN + I_OB + I_1 + I_2;
    for (int it = gw; it < NITEMS; it += NGW) {
        int r = it;
        if (r < I_IN) { p0_transpose_item(F.in[IN_WIN], LDWIN, NPROJ / 32, Win_t, DM, 0, nullptr, scr, r, F.lane); continue; } r -= I_IN;
        if (r < I_OB) { p0_transpose_item(F.in[IN_WOUT] + (size_t)DM * DM, DM, DM / 32, Wout_t, MIXW, DM, F.in[IN_SNW], scr, r, F.lane); continue; } r -= I_OB;
        if (r < I_1) { p0_transpose_item(F.in[IN_W1], DFF, DFF / 32, W1_t, DM, 0, nullptr, scr, r, F.lane); continue; } r -= I_1;
        p0_transpose_item(F.in[IN_W2], DM, DM / 32, W2_t, DFF, 0, nullptr, scr, r, F.lane);
    }
    const float* pw = F.in[IN_POOLW]; const float* ps = F.in[IN_POOLS]; const float* wo = F.in[IN_WOUT];
    const int li = F.lane & 15, kq = F.lane >> 4;
    for (int t = gw; t < 64 * 64; t += NGW) { const int it = t >> 6, nt = t & 63, g = it >> 4;
        f32x4 acc = (f32x4){0.f, 0.f, 0.f, 0.f};
        const float* arow = pw + ((size_t)(16 * it + li)) * 256;
#pragma unroll 8
        for (int s = 0; s < 64; ++s) { const int d = 4 * s + kq; const float a = arow[d] * ps[256 * g + d]; const float b = wo[(size_t)(256 * g + d) * DM + nt * 16 + li];
            acc = __builtin_amdgcn_mfma_f32_16x16x4f32(a, b, acc, 0, 0, 0); }
        v2u o; o.x = pk2(acc[0], acc[1]); o.y = pk2(acc[2], acc[3]);
        *(GAS v2u*)(Wout_t + (size_t)(nt * 16 + li) * MIXW + 16 * it + 4 * kq) = o; }
    if (blockIdx.x < 16) { const float* pb = F.in[IN_POOLB]; LAS float* red = (LAS float*)(F.lds + RING_OFF);
        const int n = blockIdx.x * 64 + F.lane; float s = 0.f;
        for (int k = F.wave * 128; k < F.wave * 128 + 128; ++k) s += pb[k] * ps[k] * wo[(size_t)k * DM + n];
        __syncthreads(); red[F.wave * 64 + F.lane] = s; __syncthreads();
        if (F.wave == 0) { float t = 0.f;
#pragma unroll
            for (int w = 0; w < 8; ++w) t += red[w * 64 + F.lane];
            ((float*)(F.ws + WS_BIASA))[n] = t; }
        __syncthreads(); }
}

template <bool WITH_DT>
__device__ __forceinline__ void norm_rows(Frame& F, const float* xrows  , int nrows, int grow0  , int batch, const float* nw, int sc_off, int sh_off, LAS float* wdt) {
    const float* mod = (const float*)(F.ws + WS_MOD) + (size_t)batch * NMOD; bf16* H = (bf16*)(F.ws + WS_H); float* DT = (float*)(F.ws + WS_DT);
    const int lane = F.lane;
    f32x4 a1[4], s1[4];
#pragma unroll
    for (int j = 0; j < 4; ++j) { const f32x4 w = *(const f32x4*)(nw + 256 * j + 4 * lane), sc = *(const f32x4*)(mod + sc_off + 256 * j + 4 * lane); a1[j] = w * (sc + 1.0f); s1[j] = *(const f32x4*)(mod + sh_off + 256 * j + 4 * lane); }
    for (int r = 0; r < nrows; ++r) {
        const GAS f32x4* xr = (const GAS f32x4*)(xrows + (size_t)r * DM) + lane;
        f32x4 v[4]; float ss = 0.f;
#pragma unroll
        for (int j = 0; j < 4; ++j) { v[j] = xr[64 * j]; ss += (v[j].x * v[j].x + v[j].y * v[j].y) + (v[j].z * v[j].z + v[j].w * v[j].w); }
        const float rs = 1.0f / sqrtf(wave_sum(ss) * (1.f / DM) + EPS);
#pragma unroll
        for (int j = 0; j < 4; ++j) v[j] = v[j] * rs * a1[j] + s1[j];
        GAS unsigned long long* o8 = (GAS unsigned long long*)(H + (size_t)(grow0 + r) * DM) + lane;
#pragma unroll
        for (int j = 0; j < 4; ++j) o8[64 * j] = (unsigned long long)pk2(v[j].x, v[j].y) | ((unsigned long long)pk2(v[j].z, v[j].w) << 32);
        if constexpr (WITH_DT) {
            float acc[16];
#pragma unroll
            for (int c = 0; c < 16; ++c) acc[c] = 0.f;
#pragma unroll
            for (int j = 0; j < 4; ++j)
#pragma unroll
                for (int i = 0; i < 4; ++i) { const float hv = v[j][i]; const LAS f32x4* wr = (const LAS f32x4*)(wdt + (i * 256 + j * 64 + lane) * 20);
#pragma unroll
                    for (int q = 0; q < 4; ++q) { const f32x4 w = wr[q]; acc[4 * q + 0] += hv * w.x; acc[4 * q + 1] += hv * w.y; acc[4 * q + 2] += hv * w.z; acc[4 * q + 3] += hv * w.w; }
                    if (i & 1) asm volatile("" ::: "memory"); }
#pragma unroll
            for (int c = 0; c < 8; ++c) { const bool hi = lane & 1; const float keep = hi ? acc[c + 8] : acc[c], send = hi ? acc[c] : acc[c + 8]; acc[c] = keep + __shfl_xor(send, 1); }
#pragma unroll
            for (int c = 0; c < 4; ++c) { const bool hi = lane & 2; const float keep = hi ? acc[c + 4] : acc[c], send = hi ? acc[c] : acc[c + 4]; acc[c] = keep + __shfl_xor(send, 2); }
#pragma unroll
            for (int c = 0; c < 2; ++c) { const bool hi = lane & 4; const float keep = hi ? acc[c + 2] : acc[c], send = hi ? acc[c] : acc[c + 2]; acc[c] = keep + __shfl_xor(send, 4); }
            { const bool hi = lane & 8; const float keep = hi ? acc[1] : acc[0], send = hi ? acc[0] : acc[1]; acc[0] = keep + __shfl_xor(send, 8); }
            float t = acc[0]; t += __shfl_xor(t, 16); t += __shfl_xor(t, 32);
            if (lane < 16) { const int ch = 8 * (lane & 1) + 4 * ((lane >> 1) & 1) + 2 * ((lane >> 2) & 1) + ((lane >> 3) & 1); DT[(size_t)(grow0 + r) * 16 + ch] = t; }
        }
    }
}
template <bool FIRST>
__device__ __forceinline__ void p_norm(Frame& F) {
    LAS float* wdt = (LAS float*)(F.lds + RING_OFF);
    if constexpr (FIRST) {
        for (int k = F.tid; k < DM; k += NWAVES * 64) { const f32x4* src = (const f32x4*)(F.in[IN_WIN] + (size_t)k * LDWIN + NPROJ);
            LAS f32x4* dst = (LAS f32x4*)(wdt + ((k & 3) * 256 + (k >> 8) * 64 + ((k >> 2) & 63)) * 20);
            dst[0] = src[0]; dst[1] = src[1]; dst[2] = src[2]; dst[3] = src[3]; }
        __syncthreads();
    }
    const int gw = F.vcu * NWAVES + F.wave;
    const float* nw = F.in[FIRST ? IN_NW1 : IN_NW2]; const int sc_off = FIRST ? DM : 4 * DM, sh_off = FIRST ? 0 : 3 * DM;
    for (int w = gw; w < MP / 32; w += F.G * NWAVES) {
        const float* src = FIRST ? F.in[IN_XP] + (size_t)w * 32 * DM : F.out + O_Y + (size_t)w * 32 * DM;
        norm_rows<FIRST>(F, src, 32, w * 32, w >> 7, nw, sc_off, sh_off, wdt); }
    for (int w = gw; w < MS; w += F.G * NWAVES) {
        const float* src = FIRST ? F.in[IN_XS] + (size_t)w * DM : F.out + O_Y + (size_t)(MP + w) * DM;
        norm_rows<FIRST>(F, src, 1, MP + w, NB_P + (w >> 4), nw, sc_off, sh_off, wdt); }
}

template <int W>
__device__ __forceinline__ void pool_item(const bf16* PROJ, bf16* MIX, int row0, int nblk16, bool seq_start, const float* hist  , int c0) {
    float px[16], py[16];
#pragma unroll
    for (int i = 0; i < 16; ++i) { px[i] = 0.f; py[i] = 0.f; }
    if (hist) {
#pragma unroll
        for (int i = 0; i < 15; ++i) { const float2 h = *(const float2*)(hist + (size_t)i * DM + c0); px[i + 1] = h.x; py[i + 1] = h.y; }
    } else if (!seq_start) {
#pragma unroll
        for (int i = 0; i < 16; ++i) { const unsigned w = *(const unsigned*)(PROJ + (size_t)(row0 - 16 + i) * NPROJ + c0); px[i] = bflo(w); py[i] = bfhi(w); }
    }
    for (int blk = 0; blk < nblk16; ++blk) {
        float cx[16], cy[16];
#pragma unroll
        for (int j = 0; j < 16; ++j) { const unsigned w = *(const unsigned*)(PROJ + (size_t)(row0 + 16 * blk + j) * NPROJ + c0); cx[j] = bflo(w); cy[j] = bfhi(w); }
        float sx = 0.f, sy = 0.f;
#pragma unroll
        for (int i = 1; i < W; ++i) { sx += px[16 - i]; sy += py[16 - i]; }
        const bool first = seq_start && blk == 0;
#pragma unroll
        for (int j = 0; j < 16; ++j) {
            sx += cx[j]; sy += cy[j];
            const float inv = (first && j + 1 < W) ? 1.0f / (float)(j + 1) : 1.0f / (float)W;
            const float ox = sx * inv - cx[j], oy = sy * inv - cy[j];
            *(unsigned*)(MIX + (size_t)(row0 + 16 * blk + j) * MIXW + c0) = pk2(ox, oy);
            const int idx = j - (W - 1);
            if (idx < 0) { sx -= px[16 + idx]; sy -= py[16 + idx]; } else { sx -= cx[idx]; sy -= cy[idx]; }
        }
#pragma unroll
        for (int i = 0; i < 16; ++i) { px[i] = cx[i]; py[i] = cy[i]; }
    }
}
__device__ __forceinline__ void p3_pool(Frame& F) {
    const bf16* PROJ = (const bf16*)(F.ws + WS_PROJ); bf16* MIX = (bf16*)(F.ws + WS_MIX);
    const int c0 = 2 * F.tid, g = F.tid >> 7;
    for (int it = blockIdx.x; it < MP / 64 + NB_S; it += F.G) {
        int row0, nb; bool st; const float* hist = nullptr;
        if (it < MP / 64) { row0 = it * 64; nb = 4; st = (row0 & (SEQ - 1)) == 0; }
        else { const int sb = it - MP / 64; row0 = MP + sb * DSEQ; nb = 1; st = false; hist = F.in[IN_CPOOL] + (size_t)sb * 15 * DM; }
        if (g == 0) pool_item<2>(PROJ, MIX, row0, nb, st, hist, c0);
        else if (g == 1) pool_item<4>(PROJ, MIX, row0, nb, st, hist, c0);
        else if (g == 2) pool_item<8>(PROJ, MIX, row0, nb, st, hist, c0);
        else pool_item<16>(PROJ, MIX, row0, nb, st, hist, c0);
    }
}
__device__ __forceinline__ void p3_conv(Frame& F) {
    const bf16* PROJ = (const bf16*)(F.ws + WS_PROJ); bf16* XB = (bf16*)(F.out + O_Y);
    const float* cw = F.in[IN_CONVW]; const float* cb = F.in[IN_CONVB];
    const int gw = F.vcu * NWAVES + F.wave, NGW = F.G * NWAVES;
    constexpr int NQ_P = (MP / 64) * 12, NQ = NQ_P + NB_S * 12;
    for (int q = gw; q < NQ; q += NGW) {
        int row0, nr, strip; bool zero_hist; const float* hist = nullptr;
        if (q < NQ_P) { const int blk = q / 12; strip = q - blk * 12; row0 = blk * 64; nr = 64; zero_hist = (row0 & (SEQ - 1)) == 0; }
        else { const int qq = q - NQ_P, sb = qq / 12; strip = qq - sb * 12; row0 = MP + sb * DSEQ; nr = DSEQ; zero_hist = false; hist = F.in[IN_CCONV] + (size_t)sb * 3 * CONVD; }
        const int c0 = strip * 128 + 2 * F.lane;
        float w0x = cw[c0], w0y = cw[c0 + 1], w1x = cw[CONVD + c0], w1y = cw[CONVD + c0 + 1], w2x = cw[2 * CONVD + c0], w2y = cw[2 * CONVD + c0 + 1], w3x = cw[3 * CONVD + c0], w3y = cw[3 * CONVD + c0 + 1];
        const float bx = cb[c0], by = cb[c0 + 1];
        float x3x = 0.f, x3y = 0.f, x2x = 0.f, x2y = 0.f, x1x = 0.f, x1y = 0.f;
        if (hist) { x3x = hist[c0]; x3y = hist[c0 + 1]; x2x = hist[CONVD + c0]; x2y = hist[CONVD + c0 + 1]; x1x = hist[2 * CONVD + c0]; x1y = hist[2 * CONVD + c0 + 1]; }
        else if (!zero_hist) { const unsigned a = *(const unsigned*)(PROJ + (size_t)(row0 - 3) * NPROJ + 2048 + c0), b = *(const unsigned*)(PROJ + (size_t)(row0 - 2) * NPROJ + 2048 + c0), c = *(const unsigned*)(PROJ + (size_t)(row0 - 1) * NPROJ + 2048 + c0);
            x3x = bflo(a); x3y = bfhi(a); x2x = bflo(b); x2y = bfhi(b); x1x = bflo(c); x1y = bfhi(c); }
#pragma unroll 8
        for (int j = 0; j < nr; ++j) {
            const unsigned w = *(const unsigned*)(PROJ + (size_t)(row0 + j) * NPROJ + 2048 + c0); const float x0x = bflo(w), x0y = bfhi(w);
            const float ox = bx + w0x * x3x + w1x * x2x + w2x * x1x + w3x * x0x, oy = by + w0y * x3y + w1y * x2y + w2y * x1y + w3y * x0y;
            *(unsigned*)(XB + (size_t)(row0 + j) * CONVD + c0) = pk2(silu_f(ox), silu_f(oy));
            x3x = x2x; x3y = x2y; x2x = x1x; x2y = x1y; x1x = x0x; x1y = x0y;
        }
    }
}

typedef short bf16x8 __attribute__((ext_vector_type(8)));
typedef short s16x4 __attribute__((ext_vector_type(4)));
__device__ __forceinline__ unsigned offb(unsigned row, unsigned ch) { return 256u * row + 16u * (ch ^ (((row & 3u) << 2) | ((row >> 2) & 3u))); }
__device__ __forceinline__ bf16x8 frag_row(LAS unsigned char* img, int lane, int rb, int s) { return *(const LAS bf16x8*)(img + offb((unsigned)((lane & 15) + 16 * rb), (unsigned)(4 * s + (lane >> 4)))); }
__device__ __forceinline__ bf16x8 frag_tr(LAS unsigned char* img, int lane, int c, int ks) {
    const unsigned g = (unsigned)lane >> 4, q = ((unsigned)lane & 15u) >> 2, p = (unsigned)lane & 3u;
    const s16x4 t0 = __builtin_amdgcn_ds_read_tr16_b64_v4i16((LAS s16x4*)(img + offb(32u * ks + 8u * g + q, 2u * c + (p >> 1)) + 8u * (p & 1u)));
    const s16x4 t1 = __builtin_amdgcn_ds_read_tr16_b64_v4i16((LAS s16x4*)(img + offb(32u * ks + 8u * g + 4u + q, 2u * c + (p >> 1)) + 8u * (p & 1u)));
    return (bf16x8){t0[0], t0[1], t0[2], t0[3], t1[0], t1[1], t1[2], t1[3]};
}
#define MFMA16(a, b, c) __builtin_amdgcn_mfma_f32_16x16x32_bf16((a), (b), (c), 0, 0, 0)
__device__ __forceinline__ void p4_ssd(Frame& F) {
    const bf16* XB = (const bf16*)(F.out + O_Y); const bf16* PROJ = (const bf16*)(F.ws + WS_PROJ); bf16* MIX = (bf16*)(F.ws + WS_MIX);
    const float* DT = (const float*)(F.ws + WS_DT); float* SSQ = (float*)(F.ws + WS_SSQ);
    LAS unsigned char* Bs = F.lds + RING_OFF; LAS unsigned char* Cs = Bs + 16384; LAS unsigned char* Hs = Bs + 32768; LAS unsigned char* Xs = Bs + 49152; LAS unsigned char* Xd = Bs + 65536; LAS unsigned char* Ms = Bs + 81920;
    LAS float* Ys = (LAS float*)(Bs + 98304);
    LAS float* accs = Ys + 64 * 68; LAS float* dts = accs + 64;
    const int tid = F.tid, lane = F.lane, w = F.wave, l15 = lane & 15, l4 = lane >> 4;
    const int xj = tid >> 3, xch = tid & 7;
    for (int it = blockIdx.x; it < NB_P * NH + NB_S * NH; it += F.G) {
        int rowbase, L, h; float* sout; f32x4 st[4];
        if (it < NB_P * NH) { const int b = it >> 4; h = it & 15; rowbase = b * SEQ; L = SEQ; sout = F.out + O_SP + (size_t)it * HD * NST;
#pragma unroll
            for (int pt = 0; pt < 4; ++pt) st[pt] = (f32x4){0.f, 0.f, 0.f, 0.f}; }
        else { const int s = it - NB_P * NH, sb = s >> 4; h = s & 15; rowbase = MP + sb * DSEQ; L = DSEQ; sout = F.out + O_SS + (size_t)s * HD * NST;
            const float* sin = F.in[IN_SSM] + (size_t)s * HD * NST;
#pragma unroll
            for (int pt = 0; pt < 4; ++pt) st[pt] = *(const f32x4*)(sin + (size_t)(16 * pt + l15) * NST + 16 * w + 4 * l4); }
        const int g = h >> 3; const float Ah = -expf(F.in[IN_ALOG][h]), dtb = F.in[IN_DTB][h], Dh = F.in[IN_DSKIP][h];
        v4u xw, bw[2], cw[2]; float dtr = 0.f;
        { const int nt0 = L < 64 ? L : 64;
          xw = (v4u){0u, 0u, 0u, 0u}; if (xj < nt0) xw = *(const v4u*)(XB + (size_t)(rowbase + xj) * CONVD + h * HD + 8 * xch);
#pragma unroll
          for (int rep = 0; rep < 2; ++rep) { const int tt = (tid >> 4) + 32 * rep; bw[rep] = (v4u){0u, 0u, 0u, 0u}; cw[rep] = (v4u){0u, 0u, 0u, 0u};
              if (tt < nt0) { const bf16* rp = XB + (size_t)(rowbase + tt) * CONVD + 1024 + g * NST + 8 * (tid & 15); bw[rep] = *(const v4u*)rp; cw[rep] = *(const v4u*)(rp + 256); } }
          if (w == 0 && lane < nt0) dtr = DT[(size_t)(rowbase + lane) * 16 + h]; }
        for (int t0 = 0; t0 < L; t0 += 64) {
            const int nt = (L - t0) < 64 ? (L - t0) : 64;
            if (w == 0) { float d = 0.f; if (lane < nt) { const float r = dtr + dtb; d = fmaxf(r, 0.f) + log1pf(expf(-fabsf(r))); }
                float c = d * Ah;
#pragma unroll
                for (int o = 1; o < 64; o <<= 1) { const float v = __shfl_up(c, o); if (lane >= o) c += v; }
                accs[lane] = c; dts[lane] = d; }
#pragma unroll
            for (int pt = 0; pt < 4; ++pt) { v2u o; o.x = pk2(st[pt].x, st[pt].y); o.y = pk2(st[pt].z, st[pt].w);
                *(LAS v2u*)(Hs + offb((unsigned)(16 * pt + l15), (unsigned)(2 * w + (lane >> 5))) + 8u * (l4 & 1)) = o; }
            __syncthreads();
            const float acs63 = accs[63];
#pragma unroll
            for (int rep = 0; rep < 2; ++rep) { const unsigned tt = (unsigned)(tid >> 4) + 32u * rep, ch = (unsigned)tid & 15u;
                *(LAS v4u*)(Bs + offb(tt, ch)) = bw[rep]; *(LAS v4u*)(Cs + offb(tt, ch)) = cw[rep]; }
            const v4u xkeep = xw;
            { const float d = dts[xj], dec = __expf(acs63 - accs[xj]);
              const float x0 = bflo(xw.x) * d, x1 = bfhi(xw.x) * d, x2 = bflo(xw.y) * d, x3 = bfhi(xw.y) * d, x4 = bflo(xw.z) * d, x5 = bfhi(xw.z) * d, x6 = bflo(xw.w) * d, x7 = bfhi(xw.w) * d;
              v4u a; a.x = pk2(x0, x1); a.y = pk2(x2, x3); a.z = pk2(x4, x5); a.w = pk2(x6, x7);
              v4u b; b.x = pk2(x0 * dec, x1 * dec); b.y = pk2(x2 * dec, x3 * dec); b.z = pk2(x4 * dec, x5 * dec); b.w = pk2(x6 * dec, x7 * dec);
              *(LAS v4u*)(Xs + offb((unsigned)xj, (unsigned)xch)) = a; *(LAS v4u*)(Xd + offb((unsigned)xj, (unsigned)xch)) = b; }
            v4u zw = (v4u){0u, 0u, 0u, 0u}; if (xj < nt) zw = *(const v4u*)(PROJ + (size_t)(rowbase + t0 + xj) * NPROJ + 1024 + h * HD + 8 * xch);
            if (t0 + 64 < L) { const int r1 = rowbase + t0 + 64;
                xw = *(const v4u*)(XB + (size_t)(r1 + xj) * CONVD + h * HD + 8 * xch);
#pragma unroll
                for (int rep = 0; rep < 2; ++rep) { const int tt = (tid >> 4) + 32 * rep; const bf16* rp = XB + (size_t)(r1 + tt) * CONVD + 1024 + g * NST + 8 * (tid & 15); bw[rep] = *(const v4u*)rp; cw[rep] = *(const v4u*)(rp + 256); }
                if (w == 0) dtr = DT[(size_t)(r1 + lane) * 16 + h]; }
            __syncthreads();
            { const int itile = w >> 1, jt0 = 2 * (w & 1);
              f32x4 g0 = (f32x4){0.f, 0.f, 0.f, 0.f}, g1 = g0;
#pragma unroll
              for (int ks = 0; ks < 4; ++ks) { const bf16x8 bC = frag_row(Cs, lane, itile, ks), a0 = frag_row(Bs, lane, jt0, ks), a1 = frag_row(Bs, lane, jt0 + 1, ks);
                  g0 = MFMA16(a0, bC, g0); g1 = MFMA16(a1, bC, g1); }
              const int i = 16 * itile + l15; const float ai = accs[i];
#pragma unroll
              for (int jj = 0; jj < 2; ++jj) { const int j0 = 16 * (jt0 + jj) + 4 * l4; const f32x4 aj = *(const LAS f32x4*)(accs + j0); const f32x4 gv = jj ? g1 : g0;
                  float m[4];
#pragma unroll
                  for (int r = 0; r < 4; ++r) m[r] = (j0 + r <= i) ? gv[r] * __expf(ai - aj[r]) : 0.f;
                  v2u o; o.x = pk2(m[0], m[1]); o.y = pk2(m[2], m[3]);
                  *(LAS v2u*)(Ms + offb((unsigned)i, (unsigned)(2 * (jt0 + jj) + (lane >> 5))) + 8u * (l4 & 1)) = o; } }
            __syncthreads();
            { const int itile = w >> 1, pt0 = 2 * (w & 1);
              f32x4 yd0 = (f32x4){0.f, 0.f, 0.f, 0.f}, yd1 = yd0, yo0 = yd0, yo1 = yd0;
#pragma unroll
              for (int ks = 0; ks < 2; ++ks) { const bf16x8 aM = frag_row(Ms, lane, itile, ks), b0 = frag_tr(Xs, lane, pt0, ks), b1 = frag_tr(Xs, lane, pt0 + 1, ks);
                  yd0 = MFMA16(aM, b0, yd0); yd1 = MFMA16(aM, b1, yd1); }
#pragma unroll
              for (int ks = 0; ks < 4; ++ks) { const bf16x8 aC = frag_row(Cs, lane, itile, ks), b0 = frag_row(Hs, lane, pt0, ks), b1 = frag_row(Hs, lane, pt0 + 1, ks);
                  yo0 = MFMA16(aC, b0, yo0); yo1 = MFMA16(aC, b1, yo1); }
              const int i0 = 16 * itile + 4 * l4; const f32x4 av = *(const LAS f32x4*)(accs + i0);
#pragma unroll
              for (int r = 0; r < 4; ++r) { const float e = __expf(av[r]);
                  Ys[(i0 + r) * 68 + 16 * pt0 + l15] = yd0[r] + e * yo0[r]; Ys[(i0 + r) * 68 + 16 * (pt0 + 1) + l15] = yd1[r] + e * yo1[r]; } }
            { const float cd = __expf(acs63);
#pragma unroll
              for (int pt = 0; pt < 4; ++pt) st[pt] = st[pt] * cd;
#pragma unroll
              for (int ks = 0; ks < 2; ++ks) { const bf16x8 aB = frag_tr(Bs, lane, w, ks);
#pragma unroll
                  for (int pt = 0; pt < 4; ++pt) { const bf16x8 bX = frag_tr(Xd, lane, pt, ks); st[pt] = MFMA16(aB, bX, st[pt]); } } }
            __syncthreads();
            if (xj < nt) { const size_t row = (size_t)(rowbase + t0 + xj);
                const f32x4 y0 = *(const LAS f32x4*)(Ys + xj * 68 + 8 * xch), y1 = *(const LAS f32x4*)(Ys + xj * 68 + 8 * xch + 4);
                const float xv[8] = {bflo(xkeep.x), bfhi(xkeep.x), bflo(xkeep.y), bfhi(xkeep.y), bflo(xkeep.z), bfhi(xkeep.z), bflo(xkeep.w), bfhi(xkeep.w)};
                const float z[8] = {bflo(zw.x), bfhi(zw.x), bflo(zw.y), bfhi(zw.y), bflo(zw.z), bfhi(zw.z), bflo(zw.w), bfhi(zw.w)};
                float o[8]; float ss = 0.f;
#pragma unroll
                for (int i = 0; i < 4; ++i) { o[i] = (y0[i] + Dh * xv[i]) * silu_f(z[i]); o[4 + i] = (y1[i] + Dh * xv[4 + i]) * silu_f(z[4 + i]); }
#pragma unroll
                for (int i = 0; i < 8; ++i) ss += o[i] * o[i];
                ss += __shfl_xor(ss, 1); ss += __shfl_xor(ss, 2); ss += __shfl_xor(ss, 4);
                if (xch == 0) SSQ[row * 16 + h] = ss;
                v4u ow; ow.x = pk2(o[0], o[1]); ow.y = pk2(o[2], o[3]); ow.z = pk2(o[4], o[5]); ow.w = pk2(o[6], o[7]);
                *(v4u*)(MIX + row * MIXW + 1024 + h * HD + 8 * xch) = ow; }
        }
#pragma unroll
        for (int pt = 0; pt < 4; ++pt) *(f32x4*)(sout + (size_t)(16 * pt + l15) * NST + 16 * w + 4 * l4) = st[pt];
        __syncthreads();
    }
}
__device__ __forceinline__ void p4b_gnorm(Frame& F) {
    bf16* MIX = (bf16*)(F.ws + WS_MIX); const float* SSQ = (const float*)(F.ws + WS_SSQ);
    const int gw = F.vcu * NWAVES + F.wave, NGW = F.G * NWAVES, lane = F.lane;
    for (int row = gw; row < MT; row += NGW) {
        float s = SSQ[(size_t)row * 16 + (lane & 15)];
        s += __shfl_xor(s, 1); s += __shfl_xor(s, 2); s += __shfl_xor(s, 4);
        const float sg = __shfl(s, (lane >> 5) * 8);
        const float rs = 1.0f / sqrtf(sg * (1.f / 512.f) + EPS);
        v4u* p = (v4u*)(MIX + (size_t)row * MIXW + 1024 + 16 * lane);
#pragma unroll
        for (int q = 0; q < 2; ++q) { v4u w = p[q];
            w.x = pk2(bflo(w.x) * rs, bfhi(w.x) * rs); w.y = pk2(bflo(w.y) * rs, bfhi(w.y) * rs); w.z = pk2(bflo(w.z) * rs, bfhi(w.z) * rs); w.w = pk2(bflo(w.w) * rs, bfhi(w.w) * rs);
            p[q] = w; }
    }
}
__device__ __forceinline__ void p9_final(Frame& F) {
    const float* fw = F.in[IN_FNW]; const int gw = F.vcu * NWAVES + F.wave, NGW = F.G * NWAVES, lane = F.lane;
    f32x4 w[4];
#pragma unroll
    for (int j = 0; j < 4; ++j) w[j] = *(const f32x4*)(fw + 256 * j + 4 * lane);
    for (int row = gw; row < MT; row += NGW) {
        GAS f32x4* xr = (GAS f32x4*)(F.out + O_Y + (size_t)row * DM) + lane;
        f32x4 v[4]; float ss = 0.f;
#pragma unroll
        for (int j = 0; j < 4; ++j) { v[j] = xr[64 * j]; ss += (v[j].x * v[j].x + v[j].y * v[j].y) + (v[j].z * v[j].z + v[j].w * v[j].w); }
        const float rs = 1.0f / sqrtf(wave_sum(ss) * (1.f / DM) + EPS);
#pragma unroll
        for (int j = 0; j < 4; ++j) xr[64 * j] = v[j] * rs * w[j];
    }
}

constexpr int N_PHASES = 11;
struct Args { const float* in[27]; float* out; unsigned char* ws; int ph_lo, ph_hi; };
__global__ void __launch_bounds__(NWAVES * 64, 2) hymba_fwd(Args args) {
    extern __shared__ __attribute__((aligned(16))) unsigned char lds[];
    Frame F;
    F.lds = (LAS unsigned char*)lds;
    F.tid = threadIdx.x; F.lane = F.tid & 63; F.wave = __builtin_amdgcn_readfirstlane(F.tid >> 6);
    F.G = gridDim.x; { const int bx = blockIdx.x; F.vcu = (F.G % 8 == 0) ? (bx % 8) * (F.G / 8) + bx / 8 : bx; }
#pragma unroll
    for (int i = 0; i < 27; ++i) F.in[i] = args.in[i];
    F.out = args.out; F.ws = args.ws;
    const int lo = args.ph_lo, hi = args.ph_hi;
#ifndef PHASE_MASK
#define PHASE_MASK 0x7ff
#endif
#define IN(k) (((PHASE_MASK >> (k)) & 1) && lo <= (k) && (k) < hi)
#define SEAM(k) do { if (IN(k) && IN((k) + 1)) { cg::this_grid().sync(); } } while (0)
    bf16* Hb = (bf16*)(F.ws + WS_H); bf16* PROJ = (bf16*)(F.ws + WS_PROJ); bf16* MIX = (bf16*)(F.ws + WS_MIX); bf16* HMID = (bf16*)(F.ws + WS_HMID);
    const float* mod = (const float*)(F.ws + WS_MOD);

    if (IN(0)) { p0_mod(F); p0_weights(F); } SEAM(0);
    if (IN(1)) { p_norm<true>(F); } SEAM(1);
    if (IN(2)) {
        pg8::Gemm g{Hb, (const bf16*)(F.ws + WS_WIN), MT, NPROJ, DM}; pg8::StaticOrder S; S.init(MT, NPROJ, F.G, (int)blockIdx.x);
        pg8::EpiProj E{PROJ, F.out, O_PP, O_CP, O_PS, O_CS};
        pg8::gemm_phase<pg8::EpiProj, pg8::StaticOrder, true, true>(F.lds + RING_OFF, g, S, E);
    } SEAM(2);
    if (IN(3)) { p3_pool(F); p3_conv(F); } SEAM(3);
    if (IN(4)) { p4_ssd(F); } SEAM(4);
    if (IN(5)) { p4b_gnorm(F); } SEAM(5);
    if (IN(6)) {
        pg8::Gemm g{MIX, (const bf16*)(F.ws + WS_WOUT), MT, DM, MIXW}; pg8::StaticOrder S; S.init(MT, DM, F.G, (int)blockIdx.x);
        pg8::EpiRes E{F.in[IN_XP], F.in[IN_XS], F.out + O_Y, (const float*)(F.ws + WS_BIASA), mod + 2 * DM};
        pg8::gemm_phase<pg8::EpiRes, pg8::StaticOrder, true, true>(F.lds + RING_OFF, g, S, E);
    } SEAM(6);
    if (IN(7)) { p_norm<false>(F); } SEAM(7);
    if (IN(8)) {
        pg8::Gemm g{Hb, (const bf16*)(F.ws + WS_W1), MT, DFF, DM}; pg8::StaticOrder S; S.init(MT, DFF, F.G, (int)blockIdx.x);
        pg8::EpiRelu2 E{HMID, F.in[IN_B1]};
        pg8::gemm_phase<pg8::EpiRelu2, pg8::StaticOrder, true, true>(F.lds + RING_OFF, g, S, E);
    } SEAM(8);
    if (IN(9)) {
        pg8::Gemm g{HMID, (const bf16*)(F.ws + WS_W2), MT, DM, DFF}; pg8::StaticOrder S; S.init(MT, DM, F.G, (int)blockIdx.x);
        pg8::EpiRes E{F.out + O_Y, F.out + O_Y + (size_t)MP * DM, F.out + O_Y, F.in[IN_B2], mod + 5 * DM};
        pg8::gemm_phase<pg8::EpiRes, pg8::StaticOrder, true, true>(F.lds + RING_OFF, g, S, E);
    } SEAM(9);
    if (IN(10)) { p9_final(F); }
#undef IN
#undef SEAM
}

#ifndef MK_ONE_LAUNCH
#define MK_ONE_LAUNCH 1
#endif
extern "C" void kernel_launch(void* const* d_in, const int* in_sizes, int n_in, void* d_out, int out_size, void* d_ws, size_t ws_size, hipStream_t stream) {
    static int grid = 0;
    if (grid == 0) {
        if (n_in != 27 || in_sizes[0] != MP * DM || (size_t)out_size != O_END || ws_size < WS_END) {
            fprintf(stderr, "kernel_launch: shape mismatch: n_in %d in0 %d out %d ws %zu (need %zu)\n", n_in, n_in > 0 ? in_sizes[0] : -1, out_size, ws_size, (size_t)WS_END); grid = -1; return; }
        int dev = 0, cus = 0, per_cu = 0;
        if (hipGetDevice(&dev) != hipSuccess || hipDeviceGetAttribute(&cus, hipDeviceAttributeMultiprocessorCount, dev) != hipSuccess) { grid = -1; return; }
        if (hipFuncSetAttribute((const void*)hymba_fwd, hipFuncAttributeMaxDynamicSharedMemorySize, LDS_BYTES) != hipSuccess) { fprintf(stderr, "kernel_launch: hipFuncSetAttribute failed\n"); grid = -1; return; }
        if (hipOccupancyMaxActiveBlocksPerMultiprocessor(&per_cu, (const void*)hymba_fwd, NWAVES * 64, LDS_BYTES) != hipSuccess || per_cu < 1) { fprintf(stderr, "kernel_launch: occupancy query says %d blocks per CU\n", per_cu); per_cu = 1; }
        (void)hipGetLastError();
        grid = cus;
        if (grid > cus * per_cu) grid = cus * per_cu;
    }
    if (grid < 0) return;
    Args a{};
    for (int i = 0; i < 27; ++i) a.in[i] = (const float*)d_in[i];
    a.out = (float*)d_out; a.ws = (unsigned char*)d_ws;
#if MK_ONE_LAUNCH
    a.ph_lo = 0; a.ph_hi = N_PHASES;
    void* kargs[] = {&a};
    hipError_t e = hipLaunchCooperativeKernel((const void*)hymba_fwd, dim3(grid), dim3(NWAVES * 64), kargs, LDS_BYTES, stream);
    if (e != hipSuccess) fprintf(stderr, "kernel_launch: cooperative launch failed: %s (grid %d)\n", hipGetErrorString(e), grid);
#else
    for (int p = 0; p < N_PHASES; ++p) { a.ph_lo = p; a.ph_hi = p + 1;
        hipLaunchKernelGGL(hymba_fwd, dim3(grid), dim3(NWAVES * 64), LDS_BYTES, stream, a);
        const hipError_t le = hipPeekAtLastError(); if (le != hipSuccess) { fprintf(stderr, "kernel_launch: launch %d failed: %s\n", p, hipGetErrorName(le)); break; } }
#endif
}
```

```cpp
#include <hip/hip_runtime.h>
#include <hip/hip_cooperative_groups.h>
#include <cstdio>
#include <cstdint>
namespace cg = cooperative_groups;

constexpr int DM = 1024, NB_P = 16, SEQ = 4096, NB_S = 32, DSEQ = 16;
constexpr int MP = NB_P * SEQ, MS = NB_S * DSEQ, MT = MP + MS, NBT = NB_P + NB_S;
constexpr int NPROJ = 3584, LDWIN = 3600, DFF = 4096, MIXW = 2048, CONVD = 1536, NH = 16, HD = 64, NST = 128, NMOD = 6 * DM;
constexpr float EPS = 1e-6f;
constexpr size_t O_Y = 0, O_PP = (size_t)MT * DM, O_CP = O_PP + (size_t)NB_P * 15 * DM, O_SP = O_CP + (size_t)NB_P * 3 * CONVD,
                 O_PS = O_SP + (size_t)NB_P * NH * HD * NST, O_CS = O_PS + (size_t)NB_S * 15 * DM, O_SS = O_CS + (size_t)NB_S * 3 * CONVD,
                 O_END = O_SS + (size_t)NB_S * NH * HD * NST;
namespace pg8 {
#define PG8_LAS __attribute__((address_space(3)))
typedef unsigned short bf16_t;
typedef short bf16x8 __attribute__((ext_vector_type(8)));
typedef float f32x4 __attribute__((ext_vector_type(4)));
typedef unsigned u32x4 __attribute__((ext_vector_type(4)));
constexpr int BM = 256, BK = 64, HALF = 128, HTB = HALF * BK * 2  , STAGE_BYTES = 8 * HTB, NXCD = 8, WGM = 8;

__host__ __device__ __forceinline__ int lds_byte(int r, int c) { const int st = (r >> 4) * 2 + (c >> 5), rr = r & 15, cc = c & 31, ob = rr * 64 + cc * 2; return st * 1024 + (ob ^ (((ob >> 9) & 1) << 5)); }
__host__ __device__ __forceinline__ void stage_rc(int b, int& R, int& C) { const int st = b / 1024, sb = b % 1024, swz = sb ^ (((sb >> 9) & 1) << 5); R = (st >> 1) * 16 + swz / 64; C = (st & 1) * 32 + (swz % 64) / 2; }
__host__ __device__ __forceinline__ int perm32(int rho) { const int n = rho >> 4, i = rho & 15; return 8 * (i >> 2) + 4 * n + (i & 3); }

struct Unit { int pm, pn; };
struct Gemm { const bf16_t* A; const bf16_t* Bt; int M, N, K; };

struct StaticOrder {
    int nM, nN, nwg, G, c;
    __host__ __device__ void init(int M, int N, int G_, int c_) { nM = M / BM; nN = N / BM; nwg = nM * nN; G = G_; c = c_; }
    __host__ __device__ bool next(int i, Unit& u) const {
        const long L = (long)i * G + c; if (L >= nwg) return false;
        int wgid = (int)L; { const int q = nwg / NXCD, r = nwg % NXCD, xcd = wgid % NXCD, off = wgid / NXCD; wgid = (xcd < r ? xcd * (q + 1) : r * (q + 1) + (xcd - r) * q) + off; }
        const int nig = WGM * nN, gid = wgid / nig, fm = gid * WGM, gsz = (nM - fm) < WGM ? (nM - fm) : WGM;
        u.pm = fm + ((wgid % nig) % gsz); u.pn = (wgid % nig) / gsz; return true;
    }
    __device__ __forceinline__ void a_ready(const Unit&) const {}
    __device__ __forceinline__ void done(const Unit&) const {}
};
__device__ __forceinline__ unsigned cvt_pk_bf16(float lo, float hi) { unsigned r; asm volatile("v_cvt_pk_bf16_f32 %0, %1, %2" : "=v"(r) : "v"(lo), "v"(hi)); return r; }
typedef unsigned u32x2 __attribute__((ext_vector_type(2)));
struct EpiProj {
    static constexpr bool PERM = true, AFTER_DRAIN = false;
    bf16_t* O; float* out;
    size_t o_pp, o_cp, o_ps, o_cs;
    __device__ __forceinline__ void operator()(const f32x4 (&acc)[2][2][4][2], const Unit& u, int wr, int wc, int fr, int fq) const {
        const int row0 = u.pm * BM + wr * 64 + fr, col0 = u.pn * BM + wc * 32 + 8 * fq;
#pragma unroll
        for (int ai = 0; ai < 2; ++ai)
#pragma unroll
            for (int m = 0; m < 4; ++m) { bf16_t* rowp = O + (size_t)(row0 + ai * HALF + m * 16) * 3584 + col0;
#pragma unroll
                for (int bj = 0; bj < 2; ++bj) { const f32x4 v0 = acc[ai][bj][m][0], v1 = acc[ai][bj][m][1];
                    u32x4 w; w.x = cvt_pk_bf16(v0[0], v0[1]); w.y = cvt_pk_bf16(v0[2], v0[3]); w.z = cvt_pk_bf16(v1[0], v1[1]); w.w = cvt_pk_bf16(v1[2], v1[3]);
                    *(u32x4*)(rowp + bj * HALF) = w; } }
        const bool is_u = u.pn < 4, is_c = u.pn >= 8;
        if (!(is_u || is_c)) return;
        if (u.pm < 256) {
            if ((u.pm & 15) != 15 || wr != 1) return;
            const int b = u.pm >> 4, lr = 240 + fr;
            if (is_u) { if (fr >= 1) { float* dst = out + o_pp + ((size_t)(b * 15 + (fr - 1)) * 1024 + col0);
#pragma unroll
                    for (int bj = 0; bj < 2; ++bj) { *(f32x4*)(dst + bj * HALF) = acc[1][bj][3][0]; *(f32x4*)(dst + bj * HALF + 4) = acc[1][bj][3][1]; } } }
            else { if (fr >= 13) { float* dst = out + o_cp + ((size_t)(b * 3 + (fr - 13)) * 1536 + (col0 - 2048));
#pragma unroll
                    for (int bj = 0; bj < 2; ++bj) { *(f32x4*)(dst + bj * HALF) = acc[1][bj][3][0]; *(f32x4*)(dst + bj * HALF + 4) = acc[1][bj][3][1]; } } }
            (void)lr;
        } else {
#pragma unroll
            for (int ai = 0; ai < 2; ++ai)
#pragma unroll
                for (int m = 0; m < 4; ++m) { const int sb = (u.pm - 256) * 16 + 8 * ai + 4 * wr + m;
                    if (is_u) { if (fr >= 1) { float* dst = out + o_ps + ((size_t)(sb * 15 + (fr - 1)) * 1024 + col0);
#pragma unroll
                            for (int bj = 0; bj < 2; ++bj) { *(f32x4*)(dst + bj * HALF) = acc[ai][bj][m][0]; *(f32x4*)(dst + bj * HALF + 4) = acc[ai][bj][m][1]; } } }
                    else { if (fr >= 13) { float* dst = out + o_cs + ((size_t)(sb * 3 + (fr - 13)) * 1536 + (col0 - 2048));
#pragma unroll
                            for (int bj = 0; bj < 2; ++bj) { *(f32x4*)(dst + bj * HALF) = acc[ai][bj][m][0]; *(f32x4*)(dst + bj * HALF + 4) = acc[ai][bj][m][1]; } } } }
        }
    }
};
struct EpiRelu2 {
    static constexpr bool PERM = true, AFTER_DRAIN = false;
    bf16_t* O; const float* bias;
    __device__ __forceinline__ void operator()(const f32x4 (&acc)[2][2][4][2], const Unit& u, int wr, int wc, int fr, int fq) const {
        const int row0 = u.pm * BM + wr * 64 + fr, col0 = u.pn * BM + wc * 32 + 8 * fq;
        f32x4 bv[2][2];
#pragma unroll
        for (int bj = 0; bj < 2; ++bj)
#pragma unroll
            for (int n = 0; n < 2; ++n) bv[bj][n] = *(const f32x4*)(bias + col0 + bj * HALF + 4 * n);
#pragma unroll
        for (int ai = 0; ai < 2; ++ai)
#pragma unroll
            for (int m = 0; m < 4; ++m) { bf16_t* rowp = O + (size_t)(row0 + ai * HALF + m * 16) * 4096 + col0;
#pragma unroll
                for (int bj = 0; bj < 2; ++bj) { f32x4 v0 = acc[ai][bj][m][0] + bv[bj][0], v1 = acc[ai][bj][m][1] + bv[bj][1];
#pragma unroll
                    for (int j = 0; j < 4; ++j) { const float a = fmaxf(v0[j], 0.f), b = fmaxf(v1[j], 0.f); v0[j] = a * a; v1[j] = b * b; }
                    u32x4 w; w.x = cvt_pk_bf16(v0[0], v0[1]); w.y = cvt_pk_bf16(v0[2], v0[3]); w.z = cvt_pk_bf16(v1[0], v1[1]); w.w = cvt_pk_bf16(v1[2], v1[3]);
                    *(u32x4*)(rowp + bj * HALF) = w; } }
    }
};
struct EpiRes {
    static constexpr bool PERM = false, AFTER_DRAIN = false;
    const float* baseP; const float* baseS;
    float* out;
    const float* bias;
    const float* gate;
    __device__ __forceinline__ void operator()(const f32x4 (&acc)[2][2][4][2], const Unit& u, int wr, int wc, int fr, int fq) const {
        const bool smp = u.pm >= 256;
        const float* bp = smp ? baseS + (size_t)(u.pm - 256) * BM * 1024 : baseP + (size_t)u.pm * BM * 1024;
        float* op = out + (size_t)u.pm * BM * 1024;
        const int col0 = u.pn * BM + wc * 32 + 4 * fq;
        f32x4 bv[2][2];
#pragma unroll
        for (int bj = 0; bj < 2; ++bj)
#pragma unroll
            for (int n = 0; n < 2; ++n) bv[bj][n] = *(const f32x4*)(bias + col0 + bj * HALF + n * 16);
#pragma unroll
        for (int ai = 0; ai < 2; ++ai)
#pragma unroll
            for (int m = 0; m < 4; ++m) { const int lr = ai * HALF + wr * 64 + m * 16 + fr;
                const int b = smp ? 16 + (u.pm - 256) * 16 + (lr >> 4) : (u.pm >> 4);
                const float* gp = gate + (size_t)b * 6144 + col0; const size_t off = (size_t)lr * 1024 + col0;
#pragma unroll
                for (int bj = 0; bj < 2; ++bj)
#pragma unroll
                    for (int n = 0; n < 2; ++n) { const f32x4 g = *(const f32x4*)(gp + bj * HALF + n * 16), x = *(const f32x4*)(bp + off + bj * HALF + n * 16);
                        *(f32x4*)(op + off + bj * HALF + n * 16) = x + g * (acc[ai][bj][m][n] + bv[bj][n]); }
                asm volatile("" ::: "memory"); }
    }
};

template <class Epi, class Sched, bool ALIGN_EPI = false, bool SP2 = false>
__device__ __forceinline__ void gemm_phase(PG8_LAS unsigned char* lds, const Gemm g, const Sched& S, const Epi& E) {
    const int tid = threadIdx.x, wid = __builtin_amdgcn_readfirstlane(tid >> 6), lane = tid & 63, wr = wid >> 2, wc = wid & 3, fr = lane & 15, fq = lane >> 4;
    const int K = g.K, nt = K / BK;
    unsigned voffA[2], voffB[2];
#pragma unroll
    for (int i = 0; i < 2; ++i) { int R, C; stage_rc(tid * 16 + i * 8192, R, C); const int Rb = Epi::PERM ? ((R & ~31) + perm32(R & 31)) : R;
        voffA[i] = (unsigned)(R * K + C) * 2u; voffB[i] = (unsigned)(Rb * K + C) * 2u; }
    const size_t kstep = (size_t)(BK * 2);
    const size_t hstep = (size_t)HALF * K * 2;
    const size_t tstep = 2 * hstep;
    const unsigned ldsw = (unsigned)wid * 1024u;
    const int aoff = lds_byte(wr * 64 + fr, fq * 8), boff = lds_byte(wc * 32 + fr, fq * 8);
#define PG8_SA(b, h) (((b) * 2 + (h)) * HTB)
#define PG8_SB(b, h) ((4 + (b) * 2 + (h)) * HTB)
#define PG8_STAGE(bufoff, gbase, voff) do { _Pragma("unroll") for (int _i = 0; _i < 2; ++_i) \
        __builtin_amdgcn_global_load_lds((const unsigned*)((const char*)(gbase) + (voff)[_i]), (PG8_LAS unsigned*)(lds + (bufoff) + ldsw + _i * 8192), 16, 0, 0); } while (0)
#define PG8_LDA(dst, b, h) do { _Pragma("unroll") for (int m = 0; m < 4; ++m) _Pragma("unroll") for (int k = 0; k < 2; ++k) dst[m][k] = *(const PG8_LAS bf16x8*)(lds + PG8_SA(b, h) + aoff + m * 2048 + k * 1024); } while (0)
#define PG8_LDB(dst, b, h) do { _Pragma("unroll") for (int n = 0; n < 2; ++n) _Pragma("unroll") for (int k = 0; k < 2; ++k) dst[n][k] = *(const PG8_LAS bf16x8*)(lds + PG8_SB(b, h) + boff + n * 2048 + k * 1024); } while (0)
#define PG8_MMA(ai, bj, At, Bt) do { __builtin_amdgcn_s_setprio(1); _Pragma("unroll") for (int m = 0; m < 4; ++m) _Pragma("unroll") for (int n = 0; n < 2; ++n) _Pragma("unroll") for (int k = 0; k < 2; ++k) \
        acc[ai][bj][m][n] = __builtin_amdgcn_mfma_f32_16x16x32_bf16(Bt[n][k], At[m][k], acc[ai][bj][m][n], 0, 0, 0); __builtin_amdgcn_s_setprio(0); } while (0)
#define PG8_WAIT_V(n) asm volatile("s_waitcnt vmcnt(" #n ")" ::: "memory")
#define PG8_WAIT_L(n) asm volatile("s_waitcnt lgkmcnt(" #n ")" ::: "memory")
#define PG8_BAR __builtin_amdgcn_s_barrier()
#define PG8_SCHED __builtin_amdgcn_sched_barrier(0)
    Unit cur, nxt; int ui = 0;
    if (!S.next(0, cur)) return;
    f32x4 acc[2][2][4][2];
#pragma unroll
    for (int a = 0; a < 2; ++a)
#pragma unroll
        for (int b = 0; b < 2; ++b)
#pragma unroll
            for (int m = 0; m < 4; ++m)
#pragma unroll
                for (int n = 0; n < 2; ++n) acc[a][b][m][n] = (f32x4){0.f, 0.f, 0.f, 0.f};
    bf16x8 At[4][2], B0[2][2], B1[2][2];
    const char* cA = (const char*)g.A + (size_t)cur.pm * tstep; const char* cB = (const char*)g.Bt + (size_t)cur.pn * tstep;
    S.a_ready(cur);
    if constexpr (SP2) {
        PG8_STAGE(PG8_SB(0, 0), cB, voffB); PG8_STAGE(PG8_SB(0, 1), cB + hstep, voffB); PG8_STAGE(PG8_SA(0, 0), cA, voffA); PG8_STAGE(PG8_SA(0, 1), cA + hstep, voffA);
        if (wr == 1) PG8_BAR;
        PG8_WAIT_V(2); PG8_BAR;
        PG8_STAGE(PG8_SB(1, 0), cB + kstep, voffB); PG8_STAGE(PG8_SA(1, 0), cA + kstep, voffA); PG8_STAGE(PG8_SB(1, 1), cB + hstep + kstep, voffB);
        PG8_WAIT_V(6); PG8_BAR;
    } else {
        PG8_STAGE(PG8_SB(0, 0), cB, voffB); PG8_STAGE(PG8_SA(0, 0), cA, voffA); PG8_STAGE(PG8_SB(0, 1), cB + hstep, voffB); PG8_STAGE(PG8_SA(0, 1), cA + hstep, voffA);
        if (wr == 1) PG8_BAR;
        PG8_WAIT_V(4); PG8_BAR;
        PG8_STAGE(PG8_SB(1, 0), cB + kstep, voffB); PG8_STAGE(PG8_SA(1, 0), cA + kstep, voffA); PG8_STAGE(PG8_SB(1, 1), cB + hstep + kstep, voffB);
        PG8_WAIT_V(6); PG8_BAR;
    }
    for (;;) {
        const bool has_next = S.next(ui + 1, nxt);
        const char* nA = has_next ? (const char*)g.A + (size_t)nxt.pm * tstep : cA; const char* nB = has_next ? (const char*)g.Bt + (size_t)nxt.pn * tstep : cB;
        for (int t = 0; t < nt; t += 2) {
            const bool last = (t == nt - 2);
            const char* a1 = cA + (size_t)(t + 1) * kstep;
            const char* a2 = last ? nA : cA + (size_t)(t + 2) * kstep; const char* b2 = last ? nB : cB + (size_t)(t + 2) * kstep;
            const char* a3 = a2 + kstep; const char* b3 = b2 + kstep;
            if (last && has_next) S.a_ready(nxt);
            if constexpr (SP2) {
            PG8_LDB(B0, 0, 0); PG8_LDB(B1, 0, 1); PG8_SCHED; PG8_LDA(At, 0, 0); PG8_STAGE(PG8_SA(1, 1), a1 + hstep, voffA);
            PG8_WAIT_V(8); PG8_WAIT_L(0); PG8_BAR; PG8_MMA(0, 0, At, B0); PG8_MMA(0, 1, At, B1); PG8_BAR; PG8_SCHED;
            PG8_LDA(At, 0, 1); PG8_STAGE(PG8_SB(0, 0), b2, voffB); PG8_STAGE(PG8_SB(0, 1), b2 + hstep, voffB); PG8_STAGE(PG8_SA(0, 0), a2, voffA);
            PG8_WAIT_V(8); PG8_WAIT_L(0); PG8_BAR; PG8_MMA(1, 0, At, B0); PG8_MMA(1, 1, At, B1); PG8_BAR; PG8_SCHED;
            PG8_LDB(B0, 1, 0); PG8_LDB(B1, 1, 1); PG8_SCHED; PG8_LDA(At, 1, 0); PG8_STAGE(PG8_SA(0, 1), a2 + hstep, voffA);
            PG8_WAIT_V(8); PG8_WAIT_L(0); PG8_BAR; PG8_MMA(0, 0, At, B0); PG8_MMA(0, 1, At, B1); PG8_BAR; PG8_SCHED;
            PG8_LDA(At, 1, 1); PG8_STAGE(PG8_SB(1, 0), b3, voffB); PG8_STAGE(PG8_SB(1, 1), b3 + hstep, voffB); PG8_STAGE(PG8_SA(1, 0), a3, voffA);
            PG8_WAIT_V(8); PG8_WAIT_L(0); PG8_BAR; PG8_MMA(1, 0, At, B0); PG8_MMA(1, 1, At, B1); PG8_BAR; PG8_SCHED;
            } else {
            PG8_LDB(B0, 0, 0); PG8_SCHED; PG8_LDA(At, 0, 0); PG8_STAGE(PG8_SA(1, 1), a1 + hstep, voffA);
            PG8_WAIT_L(8); PG8_BAR; PG8_WAIT_L(0); PG8_MMA(0, 0, At, B0); PG8_BAR; PG8_SCHED;
            PG8_LDB(B1, 0, 1); PG8_STAGE(PG8_SB(0, 0), b2, voffB);
            PG8_BAR; PG8_WAIT_L(0); PG8_MMA(0, 1, At, B1); PG8_BAR;
            PG8_LDA(At, 0, 1); PG8_STAGE(PG8_SA(0, 0), a2, voffA);
            PG8_BAR; PG8_WAIT_L(0); PG8_MMA(1, 0, At, B0); PG8_BAR; PG8_SCHED;
            PG8_STAGE(PG8_SB(0, 1), b2 + hstep, voffB);
            PG8_WAIT_V(6); PG8_BAR; PG8_MMA(1, 1, At, B1); PG8_BAR;
            PG8_LDB(B0, 1, 0); PG8_SCHED; PG8_LDA(At, 1, 0); PG8_STAGE(PG8_SA(0, 1), a2 + hstep, voffA);
            PG8_WAIT_L(8); PG8_BAR; PG8_WAIT_L(0); PG8_MMA(0, 0, At, B0); PG8_BAR; PG8_SCHED;
            PG8_LDB(B1, 1, 1); PG8_STAGE(PG8_SB(1, 0), b3, voffB);
            PG8_BAR; PG8_WAIT_L(0); PG8_MMA(0, 1, At, B1); PG8_BAR;
            PG8_LDA(At, 1, 1); PG8_STAGE(PG8_SA(1, 0), a3, voffA);
            PG8_BAR; PG8_WAIT_L(0); PG8_MMA(1, 0, At, B0); PG8_BAR; PG8_SCHED;
            PG8_STAGE(PG8_SB(1, 1), b3 + hstep, voffB);
            PG8_WAIT_V(6); PG8_BAR; PG8_MMA(1, 1, At, B1); PG8_BAR;
            }
        }
        if constexpr (ALIGN_EPI) { if (wr == 0) PG8_BAR; }
        if constexpr (!Epi::AFTER_DRAIN) { E(acc, cur, wr, wc, fr, fq); S.done(cur); }
        if (!has_next) break;
#pragma unroll
        for (int a = 0; a < 2; ++a)
#pragma unroll
            for (int b = 0; b < 2; ++b)
#pragma unroll
                for (int m = 0; m < 4; ++m)
#pragma unroll
                    for (int n = 0; n < 2; ++n) acc[a][b][m][n] = (f32x4){0.f, 0.f, 0.f, 0.f};
        cur = nxt; cA = nA; cB = nB; ++ui;
        if constexpr (ALIGN_EPI) { if (wr == 1) PG8_BAR; }
    }
    PG8_WAIT_V(0);
    if constexpr (!ALIGN_EPI) { if (wr == 0) PG8_BAR; }
    PG8_BAR;
    if constexpr (Epi::AFTER_DRAIN) { E.fused(acc, cur, wr, wc, fr, fq, lds, wid, lane); S.done(cur); }
#undef PG8_SA
#undef PG8_SB
#undef PG8_STAGE
#undef PG8_LDA
#undef PG8_LDB
#undef PG8_MMA
#undef PG8_WAIT_V
#undef PG8_WAIT_L
#undef PG8_BAR
#undef PG8_SCHED
}
}
constexpr size_t MiB = 1u << 20;
constexpr size_t WS_CTL = 0, CTL_ZERO_BYTES = 1 * MiB;
constexpr size_t WS_MOD = 1 * MiB;
constexpr size_t WS_BIASA = 2 * MiB + 512 * 1024;
constexpr size_t WS_WIN = 3 * MiB, WS_WOUT = 10 * MiB, WS_W1 = 14 * MiB, WS_W2 = 22 * MiB;
constexpr size_t WS_H = 32 * MiB;
constexpr size_t WS_PROJ = 161 * MiB;
constexpr size_t WS_DT = 613 * MiB;
constexpr size_t WS_MIX = 618 * MiB;
constexpr size_t WS_SSQ = 876 * MiB;
constexpr size_t WS_HMID = 161 * MiB;
constexpr size_t WS_END = 882 * MiB;
static_assert(WS_H + (size_t)MT * DM * 2 <= WS_PROJ && WS_PROJ + (size_t)MT * NPROJ * 2 <= WS_DT && WS_DT + (size_t)MT * 16 * 4 <= WS_MIX && WS_MIX + (size_t)MT * MIXW * 2 <= WS_SSQ
              && WS_SSQ + (size_t)MT * 16 * 4 <= WS_END && WS_HMID + (size_t)MT * DFF * 2 <= WS_SSQ && WS_MOD + (size_t)NBT * NMOD * 4 <= WS_BIASA && WS_W2 + (size_t)DM * DFF * 2 <= WS_H, "d_ws map");

constexpr int NWAVES = 8;
constexpr int RING_OFF = 0, RING_BYTES = 131072;
constexpr int LDS_BYTES = 147456;

#define GAS __attribute__((address_space(1)))
#define LAS __attribute__((address_space(3)))
typedef unsigned short bf16;
typedef unsigned v4u __attribute__((ext_vector_type(4)));
typedef unsigned v2u __attribute__((ext_vector_type(2)));
typedef float f32x4 __attribute__((ext_vector_type(4)));
#define LDS_WAIT() asm volatile("s_waitcnt lgkmcnt(0)" ::: "memory")
__device__ __forceinline__ unsigned f2bf(float f) { unsigned u = __builtin_bit_cast(unsigned, f); return (u + 0x7fffu + ((u >> 16) & 1u)) >> 16; }
__device__ __forceinline__ unsigned pk2(float lo, float hi) { return f2bf(lo) | (f2bf(hi) << 16); }
__device__ __forceinline__ float bflo(unsigned w) { return __builtin_bit_cast(float, w << 16); }
__device__ __forceinline__ float bfhi(unsigned w) { return __builtin_bit_cast(float, w & 0xffff0000u); }
__device__ __forceinline__ float wave_sum(float v) {
#pragma unroll
    for (int o = 1; o < 64; o <<= 1) v += __shfl_xor(v, o);
    return v;
}
__device__ __forceinline__ float silu_f(float x) { return x / (1.f + __expf(-x)); }

typedef GAS unsigned gu32;
typedef GAS unsigned long long gu64;
#define RLX_AGENT __ATOMIC_RELAXED, __HIP_MEMORY_SCOPE_AGENT
constexpr int CW_TMO = 0, CW_CODE = 1, CW_BAR = 4096;
constexpr int LDSCTL_OFF = RING_BYTES, MISC_OFF = LDSCTL_OFF + 320;
#define XB_TMO      128
#define XB_XCNT(j)  (256  + 64 * (j))
#define XB_XSUB(j)  (1280 + 64 * (j))
#define XB_XGEN(j)  (2304 + 64 * (j))
#define XB_TOP      3328
#define XB_TOPGEN   3392
#define XCD_BAR_WORDS 3456
#define XB_SPIN_CAP (1u << 18)

__device__ __forceinline__ unsigned xb_ld(unsigned* p)              { return __hip_atomic_load(p, __ATOMIC_RELAXED, __HIP_MEMORY_SCOPE_AGENT); }
__device__ __forceinline__ unsigned xb_add(unsigned* p, unsigned v) { return __hip_atomic_fetch_add(p, v, __ATOMIC_RELAXED, __HIP_MEMORY_SCOPE_AGENT); }
__device__ __forceinline__ unsigned xb_xcc_id() { return (unsigned)__builtin_amdgcn_s_getreg((3 << 11) | 20) & 0xFu; }
#define XB_SPIN(cond, bar) do { unsigned _sp = 0; while (cond) { __builtin_amdgcn_s_sleep(1); \
    if ((++_sp & 255u) == 0u) { if (xb_ld(&(bar)[XB_TMO])) break; if (_sp > XB_SPIN_CAP) { atomicAdd(&(bar)[XB_TMO], 1u); break; } } } } while (0)

struct XcdBarrier {
    unsigned* bar; unsigned x;
    volatile LAS unsigned* st;
};

__device__ __forceinline__ XcdBarrier xcd_barrier_post(unsigned* bar, volatile LAS unsigned* st) {
    XcdBarrier b; b.bar = bar; b.x = xb_xcc_id(); b.st = st;
    if (threadIdx.x == 0) (void)xb_add(&bar[XB_XCNT(b.x)], 1u);
    return b;
}
__device__ __forceinline__ void xcd_barrier_complete(unsigned* bar, unsigned x, unsigned& nloc, unsigned& nx) {
    const unsigned G = gridDim.x * gridDim.y * gridDim.z;
    unsigned sum, cnt, mine, sp = 0u;
    for (;;) {
        sum = 0u; cnt = 0u; mine = 0u;
#pragma unroll
        for (unsigned j = 0; j < 16; ++j) { const unsigned c = xb_ld(&bar[XB_XCNT(j)]); sum += c; cnt += (c > 0u) ? 1u : 0u; mine = (j == x) ? c : mine; }
        if (sum == G) break;
        __builtin_amdgcn_s_sleep(1);
        if ((++sp & 255u) == 0u) { if (xb_ld(&bar[XB_TMO])) break; if (sp > XB_SPIN_CAP) { atomicAdd(&bar[XB_TMO], 1u); break; } }
    }
    nloc = mine > 0u ? mine : 1u; nx = cnt > 0u ? cnt : 1u;
}

__device__ __forceinline__ void xcd_barrier(const XcdBarrier& b) {
    asm volatile("s_waitcnt vmcnt(0)" ::: "memory");
    __syncthreads();
    if (threadIdx.x == 0) {
        unsigned* bar = b.bar;
        __builtin_amdgcn_s_waitcnt(0);
        unsigned nloc = b.st[0], nx = b.st[1];
        if (nloc == 0u) { xcd_barrier_complete(bar, b.x, nloc, nx); b.st[0] = nloc; b.st[1] = nx; }
        const unsigned old = xb_add(&bar[XB_XSUB(b.x)], 1u);
        const unsigned gen = old / nloc;
        if (old + 1u == (gen + 1u) * nloc) {
            __builtin_amdgcn_fence(__ATOMIC_RELEASE, "agent");
            asm volatile("s_waitcnt vmcnt(0)" ::: "memory");
            const unsigned og = xb_add(&bar[XB_TOP], 1u);
            const unsigned tg = og / nx;
            if (og + 1u == (tg + 1u) * nx) xb_add(&bar[XB_TOPGEN], 1u);
            else XB_SPIN(xb_ld(&bar[XB_TOPGEN]) == tg, bar);
            __builtin_amdgcn_fence(__ATOMIC_ACQUIRE, "agent");
            xb_add(&bar[XB_XGEN(b.x)], 1u);
            asm volatile("s_waitcnt vmcnt(0)" ::: "memory");
        } else {
            XB_SPIN(xb_ld(&bar[XB_XGEN(b.x)]) == gen, bar);
            __builtin_amdgcn_fence(__ATOMIC_ACQUIRE, "agent");
            asm volatile("s_waitcnt vmcnt(0)" ::: "memory");
        }
    }
    __syncthreads();
}

struct Frame {
    LAS unsigned char* lds;
    int tid, lane, wave, vcu, G;
    const float* in[27]; float* out; unsigned char* ws;
};
#define IN_XP 0
#define IN_XS 1
#define IN_CPOOL 2
#define IN_CCONV 3
#define IN_SSM 4
#define IN_CP 5
#define IN_CS 6
#define IN_NW1 7
#define IN_NW2 8
#define IN_WADA 9
#define IN_BADA 10
#define IN_WIN 11
#define IN_POOLW 12
#define IN_POOLB 13
#define IN_POOLS 14
#define IN_CONVW 15
#define IN_CONVB 16
#define IN_DTB 17
#define IN_ALOG 18
#define IN_DSKIP 19
#define IN_SNW 20
#define IN_WOUT 21
#define IN_W1 22
#define IN_B1 23
#define IN_W2 24
#define IN_B2 25
#define IN_FNW 26

__device__ __forceinline__ void p0_mod(Frame& F) {
    const float* w_ada = F.in[IN_WADA]; const float* b_ada = F.in[IN_BADA]; float* mod = (float*)(F.ws + WS_MOD);
    LAS float* red = (LAS float*)(F.lds + RING_OFF);
    const int lane = F.lane, li = lane & 15, kq = lane >> 4;
    for (int ct = blockIdx.x; ct < NMOD / 16; ct += F.G) {
        f32x4 acc[3];
#pragma unroll
        for (int mt = 0; mt < 3; ++mt) acc[mt] = (f32x4){0.f, 0.f, 0.f, 0.f};
        const int k0 = F.wave * 128, col = ct * 16 + li;
        const float* cp[3]; cp[0] = F.in[IN_CP] + (size_t)li * DM; cp[1] = F.in[IN_CS] + (size_t)li * DM; cp[2] = F.in[IN_CS] + (size_t)(16 + li) * DM;
#pragma unroll 8
        for (int s = 0; s < 32; ++s) { const int k = k0 + 4 * s + kq; const float bval = w_ada[(size_t)k * NMOD + col];
#pragma unroll
            for (int mt = 0; mt < 3; ++mt) { const float a = silu_f(cp[mt][k]); acc[mt] = __builtin_amdgcn_mfma_f32_16x16x4f32(a, bval, acc[mt], 0, 0, 0); } }
#pragma unroll
        for (int mt = 0; mt < 3; ++mt)
#pragma unroll
            for (int r = 0; r < 4; ++r) red[((F.wave * 3 + mt) * 4 + r) * 64 + lane] = acc[mt][r];
        __syncthreads();
        for (int e = F.tid; e < 768; e += NWAVES * 64) { const int mt = e >> 8, r = (e >> 6) & 3, ln = e & 63; float s = 0.f;
#pragma unroll
            for (int w = 0; w < 8; ++w) s += red[((w * 3 + mt) * 4 + r) * 64 + ln];
            const int batch = 16 * mt + 4 * (ln >> 4) + r, c = ct * 16 + (ln & 15);
            mod[(size_t)batch * NMOD + c] = s + b_ada[c]; }
        __syncthreads();
    }
}
__device__ __forceinline__ void p0_transpose_item(const float* W, int ldw, int nblk, bf16* WT, int ldt, int kofs, const float* kscale, LAS float* scr, int item, int lane) {
    const int kb = item / nblk, nb = item % nblk, k0 = 64 * kb, n0 = 32 * nb;
#pragma unroll 8
    for (int i = 0; i < 32; ++i) { const int kk = 2 * i + (lane >> 5); float v = W[(size_t)(k0 + kk) * ldw + n0 + (lane & 31)]; if (kscale) v *= kscale[k0 + kk]; scr[kk * 33 + (lane & 31)] = v; }
    LDS_WAIT(); asm volatile("" ::: "memory");
    const int c = lane & 7;
#pragma unroll
    for (int j = 0; j < 4; ++j) { const int n = (lane >> 3) + 8 * j; const LAS float* s = scr + (8 * c) * 33 + n;
        v4u o; o.x = pk2(s[0 * 33], s[1 * 33]); o.y = pk2(s[2 * 33], s[3 * 33]); o.z = pk2(s[4 * 33], s[5 * 33]); o.w = pk2(s[6 * 33], s[7 * 33]);
        *(GAS v4u*)(WT + (size_t)(n0 + n) * ldt + kofs + k0 + 8 * c) = o; }
    LDS_WAIT(); asm volatile("" ::: "memory");
}
__device__ __forceinline__ void p0_weights(Frame& F) {
    LAS float* scr = (LAS float*)(F.lds + RING_OFF + 32768 + F.wave * 12288);
    const int gw = F.vcu * NWAVES + F.wave, NGW = F.G * NWAVES;
    bf16* Win_t = (bf16*)(F.ws + WS_WIN); bf16* Wout_t = (bf16*)(F.ws + WS_WOUT); bf16* W1_t = (bf16*)(F.ws + WS_W1); bf16* W2_t = (bf16*)(F.ws + WS_W2);
    constexpr int I_IN = (DM / 64) * (NPROJ / 32), I_OB = (DM / 64) * (DM / 32), I_1 = (DM / 64) * (DFF / 32), I_2 = (DFF / 64) * (DM / 32);
    constexpr int NITEMS = I_IN + I_OB + I_1 + I_2;
    for (int it = gw; it < NITEMS; it += NGW) {
        int r = it;
        if (r < I_IN) { p0_transpose_item(F.in[IN_WIN], LDWIN, NPROJ / 32, Win_t, DM, 0, nullptr, scr, r, F.lane); continue; } r -= I_IN;
        if (r < I_OB) { p0_transpose_item(F.in[IN_WOUT] + (size_t)DM * DM, DM, DM / 32, Wout_t, MIXW, DM, F.in[IN_SNW], scr, r, F.lane); continue; } r -= I_OB;
        if (r < I_1) { p0_transpose_item(F.in[IN_W1], DFF, DFF / 32, W1_t, DM, 0, nullptr, scr, r, F.lane); continue; } r -= I_1;
        p0_transpose_item(F.in[IN_W2], DM, DM / 32, W2_t, DFF, 0, nullptr, scr, r, F.lane);
    }
    const float* pw = F.in[IN_POOLW]; const float* ps = F.in[IN_POOLS]; const float* wo = F.in[IN_WOUT];
    const int li = F.lane & 15, kq = F.lane >> 4;
    for (int t = gw; t < 64 * 64; t += NGW) { const int it = t >> 6, nt = t & 63, g = it >> 4;
        f32x4 acc = (f32x4){0.f, 0.f, 0.f, 0.f};
        const float* arow = pw + ((size_t)(16 * it + li)) * 256;
#pragma unroll 8
        for (int s = 0; s < 64; ++s) { const int d = 4 * s + kq; const float a = arow[d] * ps[256 * g + d]; const float b = wo[(size_t)(256 * g + d) * DM + nt * 16 + li];
            acc = __builtin_amdgcn_mfma_f32_16x16x4f32(a, b, acc, 0, 0, 0); }
        v2u o; o.x = pk2(acc[0], acc[1]); o.y = pk2(acc[2], acc[3]);
        *(GAS v2u*)(Wout_t + (size_t)(nt * 16 + li) * MIXW + 16 * it + 4 * kq) = o; }
    if (blockIdx.x < 16) { const float* pb = F.in[IN_POOLB]; LAS float* red = (LAS float*)(F.lds + RING_OFF);
        const int n = blockIdx.x * 64 + F.lane; float s = 0.f;
        for (int k = F.wave * 128; k < F.wave * 128 + 128; ++k) s += pb[k] * ps[k] * wo[(size_t)k * DM + n];
        __syncthreads(); red[F.wave * 64 + F.lane] = s; __syncthreads();
        if (F.wave == 0) { float t = 0.f;
#pragma unroll
            for (int w = 0; w < 8; ++w) t += red[w * 64 + F.lane];
            ((float*)(F.ws + WS_BIASA))[n] = t; }
        __syncthreads(); }
}

template <bool WITH_DT>
__device__ __forceinline__ void norm_rows(Frame& F, const float* xrows  , int nrows, int grow0  , int batch, const float* nw, int sc_off, int sh_off, LAS float* wdt) {
    const float* mod = (const float*)(F.ws + WS_MOD) + (size_t)batch * NMOD; bf16* H = (bf16*)(F.ws + WS_H); float* DT = (float*)(F.ws + WS_DT);
    const int lane = F.lane;
    f32x4 a1[4], s1[4];
#pragma unroll
    for (int j = 0; j < 4; ++j) { const f32x4 w = *(const f32x4*)(nw + 256 * j + 4 * lane), sc = *(const f32x4*)(mod + sc_off + 256 * j + 4 * lane); a1[j] = w * (sc + 1.0f); s1[j] = *(const f32x4*)(mod + sh_off + 256 * j + 4 * lane); }
    for (int r = 0; r < nrows; ++r) {
        const GAS f32x4* xr = (const GAS f32x4*)(xrows + (size_t)r * DM) + lane;
        f32x4 v[4]; float ss = 0.f;
#pragma unroll
        for (int j = 0; j < 4; ++j) { v[j] = xr[64 * j]; ss += (v[j].x * v[j].x + v[j].y * v[j].y) + (v[j].z * v[j].z + v[j].w * v[j].w); }
        const float rs = 1.0f / sqrtf(wave_sum(ss) * (1.f / DM) + EPS);
#pragma unroll
        for (int j = 0; j < 4; ++j) v[j] = v[j] * rs * a1[j] + s1[j];
        GAS unsigned long long* o8 = (GAS unsigned long long*)(H + (size_t)(grow0 + r) * DM) + lane;
#pragma unroll
        for (int j = 0; j < 4; ++j) o8[64 * j] = (unsigned long long)pk2(v[j].x, v[j].y) | ((unsigned long long)pk2(v[j].z, v[j].w) << 32);
        if constexpr (WITH_DT) {
            float acc[16];
#pragma unroll
            for (int c = 0; c < 16; ++c) acc[c] = 0.f;
#pragma unroll
            for (int j = 0; j < 4; ++j)
#pragma unroll
                for (int i = 0; i < 4; ++i) { const float hv = v[j][i]; const LAS f32x4* wr = (const LAS f32x4*)(wdt + (i * 256 + j * 64 + lane) * 20);
#pragma unroll
                    for (int q = 0; q < 4; ++q) { const f32x4 w = wr[q]; acc[4 * q + 0] += hv * w.x; acc[4 * q + 1] += hv * w.y; acc[4 * q + 2] += hv * w.z; acc[4 * q + 3] += hv * w.w; }
                    if (i & 1) asm volatile("" ::: "memory"); }
#pragma unroll
            for (int c = 0; c < 8; ++c) { const bool hi = lane & 1; const float keep = hi ? acc[c + 8] : acc[c], send = hi ? acc[c] : acc[c + 8]; acc[c] = keep + __shfl_xor(send, 1); }
#pragma unroll
            for (int c = 0; c < 4; ++c) { const bool hi = lane & 2; const float keep = hi ? acc[c + 4] : acc[c], send = hi ? acc[c] : acc[c + 4]; acc[c] = keep + __shfl_xor(send, 2); }
#pragma unroll
            for (int c = 0; c < 2; ++c) { const bool hi = lane & 4; const float keep = hi ? acc[c + 2] : acc[c], send = hi ? acc[c] : acc[c + 2]; acc[c] = keep + __shfl_xor(send, 4); }
            { const bool hi = lane & 8; const float keep = hi ? acc[1] : acc[0], send = hi ? acc[0] : acc[1]; acc[0] = keep + __shfl_xor(send, 8); }
            float t = acc[0]; t += __shfl_xor(t, 16); t += __shfl_xor(t, 32);
            if (lane < 16) { const int ch = 8 * (lane & 1) + 4 * ((lane >> 1) & 1) + 2 * ((lane >> 2) & 1) + ((lane >> 3) & 1); DT[(size_t)(grow0 + r) * 16 + ch] = t; }
        }
    }
}
template <bool FIRST>
__device__ __forceinline__ void p_norm(Frame& F) {
    LAS float* wdt = (LAS float*)(F.lds + RING_OFF);
    if constexpr (FIRST) {
        for (int k = F.tid; k < DM; k += NWAVES * 64) { const f32x4* src = (const f32x4*)(F.in[IN_WIN] + (size_t)k * LDWIN + NPROJ);
            LAS f32x4* dst = (LAS f32x4*)(wdt + ((k & 3) * 256 + (k >> 8) * 64 + ((k >> 2) & 63)) * 20);
            dst[0] = src[0]; dst[1] = src[1]; dst[2] = src[2]; dst[3] = src[3]; }
        __syncthreads();
    }
    const int gw = F.vcu * NWAVES + F.wave;
    const float* nw = F.in[FIRST ? IN_NW1 : IN_NW2]; const int sc_off = FIRST ? DM : 4 * DM, sh_off = FIRST ? 0 : 3 * DM;
    for (int w = gw; w < MP / 32; w += F.G * NWAVES) {
        const float* src = FIRST ? F.in[IN_XP] + (size_t)w * 32 * DM : F.out + O_Y + (size_t)w * 32 * DM;
        norm_rows<FIRST>(F, src, 32, w * 32, w >> 7, nw, sc_off, sh_off, wdt); }
    for (int w = gw; w < MS; w += F.G * NWAVES) {
        const float* src = FIRST ? F.in[IN_XS] + (size_t)w * DM : F.out + O_Y + (size_t)(MP + w) * DM;
        norm_rows<FIRST>(F, src, 1, MP + w, NB_P + (w >> 4), nw, sc_off, sh_off, wdt); }
}

template <int W>
__device__ __forceinline__ void pool_item(const bf16* PROJ, bf16* MIX, int row0, int nblk16, bool seq_start, const float* hist  , int c0) {
    float px[16], py[16];
#pragma unroll
    for (int i = 0; i < 16; ++i) { px[i] = 0.f; py[i] = 0.f; }
    if (hist) {
#pragma unroll
        for (int i = 0; i < 15; ++i) { const float2 h = *(const float2*)(hist + (size_t)i * DM + c0); px[i + 1] = h.x; py[i + 1] = h.y; }
    } else if (!seq_start) {
#pragma unroll
        for (int i = 0; i < 16; ++i) { const unsigned w = *(const unsigned*)(PROJ + (size_t)(row0 - 16 + i) * NPROJ + c0); px[i] = bflo(w); py[i] = bfhi(w); }
    }
    for (int blk = 0; blk < nblk16; ++blk) {
        float cx[16], cy[16];
#pragma unroll
        for (int j = 0; j < 16; ++j) { const unsigned w = *(const unsigned*)(PROJ + (size_t)(row0 + 16 * blk + j) * NPROJ + c0); cx[j] = bflo(w); cy[j] = bfhi(w); }
        float sx = 0.f, sy = 0.f;
#pragma unroll
        for (int i = 1; i < W; ++i) { sx += px[16 - i]; sy += py[16 - i]; }
        const bool first = seq_start && blk == 0;
#pragma unroll
        for (int j = 0; j < 16; ++j) {
            sx += cx[j]; sy += cy[j];
            const float inv = (first && j + 1 < W) ? 1.0f / (float)(j + 1) : 1.0f / (float)W;
            const float ox = sx * inv - cx[j], oy = sy * inv - cy[j];
            *(unsigned*)(MIX + (size_t)(row0 + 16 * blk + j) * MIXW + c0) = pk2(ox, oy);
            const int idx = j - (W - 1);
            if (idx < 0) { sx -= px[16 + idx]; sy -= py[16 + idx]; } else { sx -= cx[idx]; sy -= cy[idx]; }
        }
#pragma unroll
        for (int i = 0; i < 16; ++i) { px[i] = cx[i]; py[i] = cy[i]; }
    }
}
__device__ __forceinline__ void p3_pool(Frame& F) {
    const bf16* PROJ = (const bf16*)(F.ws + WS_PROJ); bf16* MIX = (bf16*)(F.ws + WS_MIX);
    const int c0 = 2 * F.tid, g = F.tid >> 7;
    for (int it = blockIdx.x; it < MP / 64 + NB_S; it += F.G) {
        int row0, nb; bool st; const float* hist = nullptr;
        if (it < MP / 64) { row0 = it * 64; nb = 4; st = (row0 & (SEQ - 1)) == 0; }
        else { const int sb = it - MP / 64; row0 = MP + sb * DSEQ; nb = 1; st = false; hist = F.in[IN_CPOOL] + (size_t)sb * 15 * DM; }
        if (g == 0) pool_item<2>(PROJ, MIX, row0, nb, st, hist, c0);
        else if (g == 1) pool_item<4>(PROJ, MIX, row0, nb, st, hist, c0);
        else if (g == 2) pool_item<8>(PROJ, MIX, row0, nb, st, hist, c0);
        else pool_item<16>(PROJ, MIX, row0, nb, st, hist, c0);
    }
}
__device__ __forceinline__ void p3_conv(Frame& F) {
    const bf16* PROJ = (const bf16*)(F.ws + WS_PROJ); bf16* XB = (bf16*)(F.out + O_Y);
    const float* cw = F.in[IN_CONVW]; const float* cb = F.in[IN_CONVB];
    const int gw = F.vcu * NWAVES + F.wave, NGW = F.G * NWAVES;
    constexpr int NQ_P = (MP / 64) * 12, NQ = NQ_P + NB_S * 12;
    for (int q = gw; q < NQ; q += NGW) {
        int row0, nr, strip; bool zero_hist; const float* hist = nullptr;
        if (q < NQ_P) { const int blk = q / 12; strip = q - blk * 12; row0 = blk * 64; nr = 64; zero_hist = (row0 & (SEQ - 1)) == 0; }
        else { const int qq = q - NQ_P, sb = qq / 12; strip = qq - sb * 12; row0 = MP + sb * DSEQ; nr = DSEQ; zero_hist = false; hist = F.in[IN_CCONV] + (size_t)sb * 3 * CONVD; }
        const int c0 = strip * 128 + 2 * F.lane;
        float w0x = cw[c0], w0y = cw[c0 + 1], w1x = cw[CONVD + c0], w1y = cw[CONVD + c0 + 1], w2x = cw[2 * CONVD + c0], w2y = cw[2 * CONVD + c0 + 1], w3x = cw[3 * CONVD + c0], w3y = cw[3 * CONVD + c0 + 1];
        const float bx = cb[c0], by = cb[c0 + 1];
        float x3x = 0.f, x3y = 0.f, x2x = 0.f, x2y = 0.f, x1x = 0.f, x1y = 0.f;
        if (hist) { x3x = hist[c0]; x3y = hist[c0 + 1]; x2x = hist[CONVD + c0]; x2y = hist[CONVD + c0 + 1]; x1x = hist[2 * CONVD + c0]; x1y = hist[2 * CONVD + c0 + 1]; }
        else if (!zero_hist) { const unsigned a = *(const unsigned*)(PROJ + (size_t)(row0 - 3) * NPROJ + 2048 + c0), b = *(const unsigned*)(PROJ + (size_t)(row0 - 2) * NPROJ + 2048 + c0), c = *(const unsigned*)(PROJ + (size_t)(row0 - 1) * NPROJ + 2048 + c0);
            x3x = bflo(a); x3y = bfhi(a); x2x = bflo(b); x2y = bfhi(b); x1x = bflo(c); x1y = bfhi(c); }
#pragma unroll 8
        for (int j = 0; j < nr; ++j) {
            const unsigned w = *(const unsigned*)(PROJ + (size_t)(row0 + j) * NPROJ + 2048 + c0); const float x0x = bflo(w), x0y = bfhi(w);
            const float ox = bx + w0x * x3x + w1x * x2x + w2x * x1x + w3x * x0x, oy = by + w0y * x3y + w1y * x2y + w2y * x1y + w3y * x0y;
            *(unsigned*)(XB + (size_t)(row0 + j) * CONVD + c0) = pk2(silu_f(ox), silu_f(oy));
            x3x = x2x; x3y = x2y; x2x = x1x; x2y = x1y; x1x = x0x; x1y = x0y;
        }
    }
}

typedef short bf16x8 __attribute__((ext_vector_type(8)));
typedef short s16x4 __attribute__((ext_vector_type(4)));
__device__ __forceinline__ unsigned offb(unsigned row, unsigned ch) { return 256u * row + 16u * (ch ^ (((row & 3u) << 2) | ((row >> 2) & 3u))); }
__device__ __forceinline__ bf16x8 frag_row(LAS unsigned char* img, int lane, int rb, int s) { return *(const LAS bf16x8*)(img + offb((unsigned)((lane & 15) + 16 * rb), (unsigned)(4 * s + (lane >> 4)))); }
__device__ __forceinline__ bf16x8 frag_tr(LAS unsigned char* img, int lane, int c, int ks) {
    const unsigned g = (unsigned)lane >> 4, q = ((unsigned)lane & 15u) >> 2, p = (unsigned)lane & 3u;
    const s16x4 t0 = __builtin_amdgcn_ds_read_tr16_b64_v4i16((LAS s16x4*)(img + offb(32u * ks + 8u * g + q, 2u * c + (p >> 1)) + 8u * (p & 1u)));
    const s16x4 t1 = __builtin_amdgcn_ds_read_tr16_b64_v4i16((LAS s16x4*)(img + offb(32u * ks + 8u * g + 4u + q, 2u * c + (p >> 1)) + 8u * (p & 1u)));
    return (bf16x8){t0[0], t0[1], t0[2], t0[3], t1[0], t1[1], t1[2], t1[3]};
}
#define MFMA16(a, b, c) __builtin_amdgcn_mfma_f32_16x16x32_bf16((a), (b), (c), 0, 0, 0)
__device__ __forceinline__ void p4_ssd(Frame& F) {
    const bf16* XB = (const bf16*)(F.out + O_Y); const bf16* PROJ = (const bf16*)(F.ws + WS_PROJ); bf16* MIX = (bf16*)(F.ws + WS_MIX);
    const float* DT = (const float*)(F.ws + WS_DT); float* SSQ = (float*)(F.ws + WS_SSQ);
    LAS unsigned char* Bs = F.lds + RING_OFF; LAS unsigned char* Cs = Bs + 16384; LAS unsigned char* Hs = Bs + 32768; LAS unsigned char* Xs = Bs + 49152; LAS unsigned char* Xd = Bs + 65536; LAS unsigned char* Ms = Bs + 81920;
    LAS float* Ys = (LAS float*)(Bs + 98304);
    LAS float* accs = Ys + 64 * 68; LAS float* dts = accs + 64;
    const int tid = F.tid, lane = F.lane, w = F.wave, l15 = lane & 15, l4 = lane >> 4;
    const int xj = tid >> 3, xch = tid & 7;
    for (int it = blockIdx.x; it < NB_P * NH + NB_S * NH; it += F.G) {
        int rowbase, L, h; float* sout; f32x4 st[4];
        if (it < NB_P * NH) { const int b = it >> 4; h = it & 15; rowbase = b * SEQ; L = SEQ; sout = F.out + O_SP + (size_t)it * HD * NST;
#pragma unroll
            for (int pt = 0; pt < 4; ++pt) st[pt] = (f32x4){0.f, 0.f, 0.f, 0.f}; }
        else { const int s = it - NB_P * NH, sb = s >> 4; h = s & 15; rowbase = MP + sb * DSEQ; L = DSEQ; sout = F.out + O_SS + (size_t)s * HD * NST;
            const float* sin = F.in[IN_SSM] + (size_t)s * HD * NST;
#pragma unroll
            for (int pt = 0; pt < 4; ++pt) st[pt] = *(const f32x4*)(sin + (size_t)(16 * pt + l15) * NST + 16 * w + 4 * l4); }
        const int g = h >> 3; const float Ah = -expf(F.in[IN_ALOG][h]), dtb = F.in[IN_DTB][h], Dh = F.in[IN_DSKIP][h];
        v4u xw, bw[2], cw[2]; float dtr = 0.f;
        { const int nt0 = L < 64 ? L : 64;
          xw = (v4u){0u, 0u, 0u, 0u}; if (xj < nt0) xw = *(const v4u*)(XB + (size_t)(rowbase + xj) * CONVD + h * HD + 8 * xch);
#pragma unroll
          for (int rep = 0; rep < 2; ++rep) { const int tt = (tid >> 4) + 32 * rep; bw[rep] = (v4u){0u, 0u, 0u, 0u}; cw[rep] = (v4u){0u, 0u, 0u, 0u};
              if (tt < nt0) { const bf16* rp = XB + (size_t)(rowbase + tt) * CONVD + 1024 + g * NST + 8 * (tid & 15); bw[rep] = *(const v4u*)rp; cw[rep] = *(const v4u*)(rp + 256); } }
          if (w == 0 && lane < nt0) dtr = DT[(size_t)(rowbase + lane) * 16 + h]; }
        for (int t0 = 0; t0 < L; t0 += 64) {
            const int nt = (L - t0) < 64 ? (L - t0) : 64;
            if (w == 0) { float d = 0.f; if (lane < nt) { const float r = dtr + dtb; d = fmaxf(r, 0.f) + log1pf(expf(-fabsf(r))); }
                float c = d * Ah;
#pragma unroll
                for (int o = 1; o < 64; o <<= 1) { const float v = __shfl_up(c, o); if (lane >= o) c += v; }
                accs[lane] = c; dts[lane] = d; }
#pragma unroll
            for (int pt = 0; pt < 4; ++pt) { v2u o; o.x = pk2(st[pt].x, st[pt].y); o.y = pk2(st[pt].z, st[pt].w);
                *(LAS v2u*)(Hs + offb((unsigned)(16 * pt + l15), (unsigned)(2 * w + (lane >> 5))) + 8u * (l4 & 1)) = o; }
            __syncthreads();
            const float acs63 = accs[63];
#pragma unroll
            for (int rep = 0; rep < 2; ++rep) { const unsigned tt = (unsigned)(tid >> 4) + 32u * rep, ch = (unsigned)tid & 15u;
                *(LAS v4u*)(Bs + offb(tt, ch)) = bw[rep]; *(LAS v4u*)(Cs + offb(tt, ch)) = cw[rep]; }
            const v4u xkeep = xw;
            { const float d = dts[xj], dec = __expf(acs63 - accs[xj]);
              const float x0 = bflo(xw.x) * d, x1 = bfhi(xw.x) * d, x2 = bflo(xw.y) * d, x3 = bfhi(xw.y) * d, x4 = bflo(xw.z) * d, x5 = bfhi(xw.z) * d, x6 = bflo(xw.w) * d, x7 = bfhi(xw.w) * d;
              v4u a; a.x = pk2(x0, x1); a.y = pk2(x2, x3); a.z = pk2(x4, x5); a.w = pk2(x6, x7);
              v4u b; b.x = pk2(x0 * dec, x1 * dec); b.y = pk2(x2 * dec, x3 * dec); b.z = pk2(x4 * dec, x5 * dec); b.w = pk2(x6 * dec, x7 * dec);
              *(LAS v4u*)(Xs + offb((unsigned)xj, (unsigned)xch)) = a; *(LAS v4u*)(Xd + offb((unsigned)xj, (unsigned)xch)) = b; }
            v4u zw = (v4u){0u, 0u, 0u, 0u}; if (xj < nt) zw = *(const v4u*)(PROJ + (size_t)(rowbase + t0 + xj) * NPROJ + 1024 + h * HD + 8 * xch);
            if (t0 + 64 < L) { const int r1 = rowbase + t0 + 64;
                xw = *(const v4u*)(XB + (size_t)(r1 + xj) * CONVD + h * HD + 8 * xch);
#pragma unroll
                for (int rep = 0; rep < 2; ++rep) { const int tt = (tid >> 4) + 32 * rep; const bf16* rp = XB + (size_t)(r1 + tt) * CONVD + 1024 + g * NST + 8 * (tid & 15); bw[rep] = *(const v4u*)rp; cw[rep] = *(const v4u*)(rp + 256); }
                if (w == 0) dtr = DT[(size_t)(r1 + lane) * 16 + h]; }
            __syncthreads();
            { const int itile = w >> 1, jt0 = 2 * (w & 1);
              f32x4 g0 = (f32x4){0.f, 0.f, 0.f, 0.f}, g1 = g0;
#pragma unroll
              for (int ks = 0; ks < 4; ++ks) { const bf16x8 bC = frag_row(Cs, lane, itile, ks), a0 = frag_row(Bs, lane, jt0, ks), a1 = frag_row(Bs, lane, jt0 + 1, ks);
                  g0 = MFMA16(a0, bC, g0); g1 = MFMA16(a1, bC, g1); }
              const int i = 16 * itile + l15; const float ai = accs[i];
#pragma unroll
              for (int jj = 0; jj < 2; ++jj) { const int j0 = 16 * (jt0 + jj) + 4 * l4; const f32x4 aj = *(const LAS f32x4*)(accs + j0); const f32x4 gv = jj ? g1 : g0;
                  float m[4];
#pragma unroll
                  for (int r = 0; r < 4; ++r) m[r] = (j0 + r <= i) ? gv[r] * __expf(ai - aj[r]) : 0.f;
                  v2u o; o.x = pk2(m[0], m[1]); o.y = pk2(m[2], m[3]);
                  *(LAS v2u*)(Ms + offb((unsigned)i, (unsigned)(2 * (jt0 + jj) + (lane >> 5))) + 8u * (l4 & 1)) = o; } }
            __syncthreads();
            { const int itile = w >> 1, pt0 = 2 * (w & 1);
              f32x4 yd0 = (f32x4){0.f, 0.f, 0.f, 0.f}, yd1 = yd0, yo0 = yd0, yo1 = yd0;
#pragma unroll
              for (int ks = 0; ks < 2; ++ks) { const bf16x8 aM = frag_row(Ms, lane, itile, ks), b0 = frag_tr(Xs, lane, pt0, ks), b1 = frag_tr(Xs, lane, pt0 + 1, ks);
                  yd0 = MFMA16(aM, b0, yd0); yd1 = MFMA16(aM, b1, yd1); }
#pragma unroll
              for (int ks = 0; ks < 4; ++ks) { const bf16x8 aC = frag_row(Cs, lane, itile, ks), b0 = frag_row(Hs, lane, pt0, ks), b1 = frag_row(Hs, lane, pt0 + 1, ks);
                  yo0 = MFMA16(aC, b0, yo0); yo1 = MFMA16(aC, b1, yo1); }
              const int i0 = 16 * itile + 4 * l4; const f32x4 av = *(const LAS f32x4*)(accs + i0);
#pragma unroll
              for (int r = 0; r < 4; ++r) { const float e = __expf(av[r]);
                  Ys[(i0 + r) * 68 + 16 * pt0 + l15] = yd0[r] + e * yo0[r]; Ys[(i0 + r) * 68 + 16 * (pt0 + 1) + l15] = yd1[r] + e * yo1[r]; } }
            { const float cd = __expf(acs63);
#pragma unroll
              for (int pt = 0; pt < 4; ++pt) st[pt] = st[pt] * cd;
#pragma unroll
              for (int ks = 0; ks < 2; ++ks) { const bf16x8 aB = frag_tr(Bs, lane, w, ks);
#pragma unroll
                  for (int pt = 0; pt < 4; ++pt) { const bf16x8 bX = frag_tr(Xd, lane, pt, ks); st[pt] = MFMA16(aB, bX, st[pt]); } } }
            __syncthreads();
            if (xj < nt) { const size_t row = (size_t)(rowbase + t0 + xj);
                const f32x4 y0 = *(const LAS f32x4*)(Ys + xj * 68 + 8 * xch), y1 = *(const LAS f32x4*)(Ys + xj * 68 + 8 * xch + 4);
                const float xv[8] = {bflo(xkeep.x), bfhi(xkeep.x), bflo(xkeep.y), bfhi(xkeep.y), bflo(xkeep.z), bfhi(xkeep.z), bflo(xkeep.w), bfhi(xkeep.w)};
                const float z[8] = {bflo(zw.x), bfhi(zw.x), bflo(zw.y), bfhi(zw.y), bflo(zw.z), bfhi(zw.z), bflo(zw.w), bfhi(zw.w)};
                float o[8]; float ss = 0.f;
#pragma unroll
                for (int i = 0; i < 4; ++i) { o[i] = (y0[i] + Dh * xv[i]) * silu_f(z[i]); o[4 + i] = (y1[i] + Dh * xv[4 + i]) * silu_f(z[4 + i]); }
#pragma unroll
                for (int i = 0; i < 8; ++i) ss += o[i] * o[i];
                ss += __shfl_xor(ss, 1); ss += __shfl_xor(ss, 2); ss += __shfl_xor(ss, 4);
                if (xch == 0) SSQ[row * 16 + h] = ss;
                v4u ow; ow.x = pk2(o[0], o[1]); ow.y = pk2(o[2], o[3]); ow.z = pk2(o[4], o[5]); ow.w = pk2(o[6], o[7]);
                *(v4u*)(MIX + row * MIXW + 1024 + h * HD + 8 * xch) = ow; }
        }
#pragma unroll
        for (int pt = 0; pt < 4; ++pt) *(f32x4*)(sout + (size_t)(16 * pt + l15) * NST + 16 * w + 4 * l4) = st[pt];
        __syncthreads();
    }
}
__device__ __forceinline__ void p4b_gnorm(Frame& F) {
    bf16* MIX = (bf16*)(F.ws + WS_MIX); const float* SSQ = (const float*)(F.ws + WS_SSQ);
    const int gw = F.vcu * NWAVES + F.wave, NGW = F.G * NWAVES, lane = F.lane;
    for (int row = gw; row < MT; row += NGW) {
        float s = SSQ[(size_t)row * 16 + (lane & 15)];
        s += __shfl_xor(s, 1); s += __shfl_xor(s, 2); s += __shfl_xor(s, 4);
        const float sg = __shfl(s, (lane >> 5) * 8);
        const float rs = 1.0f / sqrtf(sg * (1.f / 512.f) + EPS);
        v4u* p = (v4u*)(MIX + (size_t)row * MIXW + 1024 + 16 * lane);
#pragma unroll
        for (int q = 0; q < 2; ++q) { v4u w = p[q];
            w.x = pk2(bflo(w.x) * rs, bfhi(w.x) * rs); w.y = pk2(bflo(w.y) * rs, bfhi(w.y) * rs); w.z = pk2(bflo(w.z) * rs, bfhi(w.z) * rs); w.w = pk2(bflo(w.w) * rs, bfhi(w.w) * rs);
            p[q] = w; }
    }
}
__device__ __forceinline__ void p9_final(Frame& F) {
    const float* fw = F.in[IN_FNW]; const int gw = F.vcu * NWAVES + F.wave, NGW = F.G * NWAVES, lane = F.lane;
    f32x4 w[4];
#pragma unroll
    for (int j = 0; j < 4; ++j) w[j] = *(const f32x4*)(fw + 256 * j + 4 * lane);
    for (int row = gw; row < MT; row += NGW) {
        GAS f32x4* xr = (GAS f32x4*)(F.out + O_Y + (size_t)row * DM) + lane;
        f32x4 v[4]; float ss = 0.f;
#pragma unroll
        for (int j = 0; j < 4; ++j) { v[j] = xr[64 * j]; ss += (v[j].x * v[j].x + v[j].y * v[j].y) + (v[j].z * v[j].z + v[j].w * v[j].w); }
        const float rs = 1.0f / sqrtf(wave_sum(ss) * (1.f / DM) + EPS);
#pragma unroll
        for (int j = 0; j < 4; ++j) xr[64 * j] = v[j] * rs * w[j];
    }
}

constexpr int N_PHASES = 11;
struct Args { const float* in[27]; float* out; unsigned char* ws; int ph_lo, ph_hi; };
__global__ void __launch_bounds__(NWAVES * 64, 2) hymba_fwd(Args args) {
    extern __shared__ __attribute__((aligned(16))) unsigned char lds[];
    Frame F;
    F.lds = (LAS unsigned char*)lds;
    F.tid = threadIdx.x; F.lane = F.tid & 63; F.wave = __builtin_amdgcn_readfirstlane(F.tid >> 6);
    F.G = gridDim.x; { const int bx = blockIdx.x; F.vcu = (F.G % 8 == 0) ? (bx % 8) * (F.G / 8) + bx / 8 : bx; }
#pragma unroll
    for (int i = 0; i < 27; ++i) F.in[i] = args.in[i];
    F.out = args.out; F.ws = args.ws;
    const int lo = args.ph_lo, hi = args.ph_hi;
    for (int u = F.tid; u < (LDS_BYTES - LDSCTL_OFF) / 4; u += NWAVES * 64) ((LAS unsigned*)(F.lds + LDSCTL_OFF))[u] = 0u;
    __syncthreads();
    XcdBarrier bar; bar.bar = (unsigned*)(F.ws + WS_CTL) + CW_BAR; bar.x = 0; bar.st = nullptr;
    if (hi - lo > 1) bar = xcd_barrier_post((unsigned*)(F.ws + WS_CTL) + CW_BAR, (volatile LAS unsigned*)(F.lds + MISC_OFF) + 8);
#ifndef PHASE_MASK
#define PHASE_MASK 0x7ff
#endif
#define IN(k) (((PHASE_MASK >> (k)) & 1) && lo <= (k) && (k) < hi)
#define SEAM(k) do { if (IN(k) && IN((k) + 1)) { xcd_barrier(bar); } } while (0)
    bf16* Hb = (bf16*)(F.ws + WS_H); bf16* PROJ = (bf16*)(F.ws + WS_PROJ); bf16* MIX = (bf16*)(F.ws + WS_MIX); bf16* HMID = (bf16*)(F.ws + WS_HMID);
    const float* mod = (const float*)(F.ws + WS_MOD);

    if (IN(0)) { p0_mod(F); p0_weights(F); } SEAM(0);
    if (IN(1)) { p_norm<true>(F); } SEAM(1);
    if (IN(2)) {
        pg8::Gemm g{Hb, (const bf16*)(F.ws + WS_WIN), MT, NPROJ, DM}; pg8::StaticOrder S; S.init(MT, NPROJ, F.G, (int)blockIdx.x);
        pg8::EpiProj E{PROJ, F.out, O_PP, O_CP, O_PS, O_CS};
        pg8::gemm_phase<pg8::EpiProj, pg8::StaticOrder, true, true>(F.lds + RING_OFF, g, S, E);
    } SEAM(2);
    if (IN(3)) { p3_pool(F); p3_conv(F); } SEAM(3);
    if (IN(4)) { p4_ssd(F); } SEAM(4);
    if (IN(5)) { p4b_gnorm(F); } SEAM(5);
    if (IN(6)) {
        pg8::Gemm g{MIX, (const bf16*)(F.ws + WS_WOUT), MT, DM, MIXW}; pg8::StaticOrder S; S.init(MT, DM, F.G, (int)blockIdx.x);
        pg8::EpiRes E{F.in[IN_XP], F.in[IN_XS], F.out + O_Y, (const float*)(F.ws + WS_BIASA), mod + 2 * DM};
        pg8::gemm_phase<pg8::EpiRes, pg8::StaticOrder, true, true>(F.lds + RING_OFF, g, S, E);
    } SEAM(6);
    if (IN(7)) { p_norm<false>(F); } SEAM(7);
    if (IN(8)) {
        pg8::Gemm g{Hb, (const bf16*)(F.ws + WS_W1), MT, DFF, DM}; pg8::StaticOrder S; S.init(MT, DFF, F.G, (int)blockIdx.x);
        pg8::EpiRelu2 E{HMID, F.in[IN_B1]};
        pg8::gemm_phase<pg8::EpiRelu2, pg8::StaticOrder, true, true>(F.lds + RING_OFF, g, S, E);
    } SEAM(8);
    if (IN(9)) {
        pg8::Gemm g{HMID, (const bf16*)(F.ws + WS_W2), MT, DM, DFF}; pg8::StaticOrder S; S.init(MT, DM, F.G, (int)blockIdx.x);
        pg8::EpiRes E{F.out + O_Y, F.out + O_Y + (size_t)MP * DM, F.out + O_Y, F.in[IN_B2], mod + 5 * DM};
        pg8::gemm_phase<pg8::EpiRes, pg8::StaticOrder, true, true>(F.lds + RING_OFF, g, S, E);
    } SEAM(9);
    if (IN(10)) { p9_final(F); }
#undef IN
#undef SEAM
}

#ifndef MK_ONE_LAUNCH
#define MK_ONE_LAUNCH 1
#endif
extern "C" void kernel_launch(void* const* d_in, const int* in_sizes, int n_in, void* d_out, int out_size, void* d_ws, size_t ws_size, hipStream_t stream) {
    static int grid = 0;
    if (grid == 0) {
        if (n_in != 27 || in_sizes[0] != MP * DM || (size_t)out_size != O_END || ws_size < WS_END) {
            fprintf(stderr, "kernel_launch: shape mismatch: n_in %d in0 %d out %d ws %zu (need %zu)\n", n_in, n_in > 0 ? in_sizes[0] : -1, out_size, ws_size, (size_t)WS_END); grid = -1; return; }
        int dev = 0, cus = 0, per_cu = 0;
        if (hipGetDevice(&dev) != hipSuccess || hipDeviceGetAttribute(&cus, hipDeviceAttributeMultiprocessorCount, dev) != hipSuccess) { grid = -1; return; }
        if (hipFuncSetAttribute((const void*)hymba_fwd, hipFuncAttributeMaxDynamicSharedMemorySize, LDS_BYTES) != hipSuccess) { fprintf(stderr, "kernel_launch: hipFuncSetAttribute failed\n"); grid = -1; return; }
        if (hipOccupancyMaxActiveBlocksPerMultiprocessor(&per_cu, (const void*)hymba_fwd, NWAVES * 64, LDS_BYTES) != hipSuccess || per_cu < 1) { fprintf(stderr, "kernel_launch: occupancy query says %d blocks per CU\n", per_cu); per_cu = 1; }
        (void)hipGetLastError();
        grid = cus;
        if (grid > cus * per_cu) grid = cus * per_cu;
    }
    if (grid < 0) return;
    Args a{};
    for (int i = 0; i < 27; ++i) a.in[i] = (const float*)d_in[i];
    a.out = (float*)d_out; a.ws = (unsigned char*)d_ws;
#if MK_ONE_LAUNCH
    a.ph_lo = 0; a.ph_hi = N_PHASES;
    if (hipMemsetAsync((char*)d_ws + WS_CTL, 0, CTL_ZERO_BYTES, stream) != hipSuccess) { fprintf(stderr, "kernel_launch: hipMemsetAsync failed\n"); return; }
    hipLaunchKernelGGL(hymba_fwd, dim3(grid), dim3(NWAVES * 64), LDS_BYTES, stream, a);
    { const hipError_t le = hipPeekAtLastError(); if (le != hipSuccess) fprintf(stderr, "kernel_launch: launch failed: %s (grid %d)\n", hipGetErrorName(le), grid); }
#else
    for (int p = 0; p < N_PHASES; ++p) { a.ph_lo = p; a.ph_hi = p + 1;
        hipLaunchKernelGGL(hymba_fwd, dim3(grid), dim3(NWAVES * 64), LDS_BYTES, stream, a);
        const hipError_t le = hipPeekAtLastError(); if (le != hipSuccess) { fprintf(stderr, "kernel_launch: launch %d failed: %s\n", p, hipGetErrorName(le)); break; } }
#endif
}
```

```cpp
#include <hip/hip_runtime.h>
#include <hip/hip_cooperative_groups.h>
#include <cstdio>
#include <cstdint>
namespace cg = cooperative_groups;

constexpr int DM = 1024, NB_P = 16, SEQ = 4096, NB_S = 32, DSEQ = 16;
constexpr int MP = NB_P * SEQ, MS = NB_S * DSEQ, MT = MP + MS, NBT = NB_P + NB_S;
constexpr int NPROJ = 3584, LDWIN = 3600, DFF = 4096, MIXW = 2048, CONVD = 1536, NH = 16, HD = 64, NST = 128, NMOD = 6 * DM;
constexpr float EPS = 1e-6f;
constexpr size_t O_Y = 0, O_PP = (size_t)MT * DM, O_CP = O_PP + (size_t)NB_P * 15 * DM, O_SP = O_CP + (size_t)NB_P * 3 * CONVD,
                 O_PS = O_SP + (size_t)NB_P * NH * HD * NST, O_CS = O_PS + (size_t)NB_S * 15 * DM, O_SS = O_CS + (size_t)NB_S * 3 * CONVD,
                 O_END = O_SS + (size_t)NB_S * NH * HD * NST;
namespace pg8 {
#define PG8_LAS __attribute__((address_space(3)))
typedef unsigned short bf16_t;
typedef short bf16x8 __attribute__((ext_vector_type(8)));
typedef float f32x4 __attribute__((ext_vector_type(4)));
typedef unsigned u32x4 __attribute__((ext_vector_type(4)));
constexpr int BM = 256, BK = 64, HALF = 128, HTB = HALF * BK * 2  , STAGE_BYTES = 8 * HTB, NXCD = 8, WGM = 8;

__host__ __device__ __forceinline__ int lds_byte(int r, int c) { const int st = (r >> 4) * 2 + (c >> 5), rr = r & 15, cc = c & 31, ob = rr * 64 + cc * 2; return st * 1024 + (ob ^ (((ob >> 9) & 1) << 5)); }
__host__ __device__ __forceinline__ void stage_rc(int b, int& R, int& C) { const int st = b / 1024, sb = b % 1024, swz = sb ^ (((sb >> 9) & 1) << 5); R = (st >> 1) * 16 + swz / 64; C = (st & 1) * 32 + (swz % 64) / 2; }
__host__ __device__ __forceinline__ int perm32(int rho) { const int n = rho >> 4, i = rho & 15; return 8 * (i >> 2) + 4 * n + (i & 3); }

struct Unit { int pm, pn; };
struct Gemm { const bf16_t* A; const bf16_t* Bt; int M, N, K; };

struct StaticOrder {
    int nM, nN, nwg, G, c;
    __host__ __device__ void init(int M, int N, int G_, int c_) { nM = M / BM; nN = N / BM; nwg = nM * nN; G = G_; c = c_; }
    __host__ __device__ bool next(int i, Unit& u) const {
        const long L = (long)i * G + c; if (L >= nwg) return false;
        int wgid = (int)L; { const int q = nwg / NXCD, r = nwg % NXCD, xcd = wgid % NXCD, off = wgid / NXCD; wgid = (xcd < r ? xcd * (q + 1) : r * (q + 1) + (xcd - r) * q) + off; }
        const int nig = WGM * nN, gid = wgid / nig, fm = gid * WGM, gsz = (nM - fm) < WGM ? (nM - fm) : WGM;
        u.pm = fm + ((wgid % nig) % gsz); u.pn = (wgid % nig) / gsz; return true;
    }
    __device__ __forceinline__ void a_ready(const Unit&) const {}
    __device__ __forceinline__ void done(const Unit&) const {}
};
__device__ __forceinline__ unsigned cvt_pk_bf16(float lo, float hi) { unsigned r; asm volatile("v_cvt_pk_bf16_f32 %0, %1, %2" : "=v"(r) : "v"(lo), "v"(hi)); return r; }
typedef unsigned u32x2 __attribute__((ext_vector_type(2)));
struct EpiProj {
    static constexpr bool PERM = true, AFTER_DRAIN = false, KHOOK = false; static constexpr int KH0 = -1, KH1 = -1;
    bf16_t* O; float* out;
    size_t o_pp, o_cp, o_ps, o_cs;
    __device__ __forceinline__ void operator()(const f32x4 (&acc)[2][2][4][2], const Unit& u, int wr, int wc, int fr, int fq) const {
        const int row0 = u.pm * BM + wr * 64 + fr, col0 = u.pn * BM + wc * 32 + 8 * fq;
#pragma unroll
        for (int ai = 0; ai < 2; ++ai)
#pragma unroll
            for (int m = 0; m < 4; ++m) { bf16_t* rowp = O + (size_t)(row0 + ai * HALF + m * 16) * 3584 + col0;
#pragma unroll
                for (int bj = 0; bj < 2; ++bj) { const f32x4 v0 = acc[ai][bj][m][0], v1 = acc[ai][bj][m][1];
                    u32x4 w; w.x = cvt_pk_bf16(v0[0], v0[1]); w.y = cvt_pk_bf16(v0[2], v0[3]); w.z = cvt_pk_bf16(v1[0], v1[1]); w.w = cvt_pk_bf16(v1[2], v1[3]);
                    *(u32x4*)(rowp + bj * HALF) = w; } }
        const bool is_u = u.pn < 4, is_c = u.pn >= 8;
        if (!(is_u || is_c)) return;
        if (u.pm < 256) {
            if ((u.pm & 15) != 15 || wr != 1) return;
            const int b = u.pm >> 4, lr = 240 + fr;
            if (is_u) { if (fr >= 1) { float* dst = out + o_pp + ((size_t)(b * 15 + (fr - 1)) * 1024 + col0);
#pragma unroll
                    for (int bj = 0; bj < 2; ++bj) { *(f32x4*)(dst + bj * HALF) = acc[1][bj][3][0]; *(f32x4*)(dst + bj * HALF + 4) = acc[1][bj][3][1]; } } }
            else { if (fr >= 13) { float* dst = out + o_cp + ((size_t)(b * 3 + (fr - 13)) * 1536 + (col0 - 2048));
#pragma unroll
                    for (int bj = 0; bj < 2; ++bj) { *(f32x4*)(dst + bj * HALF) = acc[1][bj][3][0]; *(f32x4*)(dst + bj * HALF + 4) = acc[1][bj][3][1]; } } }
            (void)lr;
        } else {
#pragma unroll
            for (int ai = 0; ai < 2; ++ai)
#pragma unroll
                for (int m = 0; m < 4; ++m) { const int sb = (u.pm - 256) * 16 + 8 * ai + 4 * wr + m;
                    if (is_u) { if (fr >= 1) { float* dst = out + o_ps + ((size_t)(sb * 15 + (fr - 1)) * 1024 + col0);
#pragma unroll
                            for (int bj = 0; bj < 2; ++bj) { *(f32x4*)(dst + bj * HALF) = acc[ai][bj][m][0]; *(f32x4*)(dst + bj * HALF + 4) = acc[ai][bj][m][1]; } } }
                    else { if (fr >= 13) { float* dst = out + o_cs + ((size_t)(sb * 3 + (fr - 13)) * 1536 + (col0 - 2048));
#pragma unroll
                            for (int bj = 0; bj < 2; ++bj) { *(f32x4*)(dst + bj * HALF) = acc[ai][bj][m][0]; *(f32x4*)(dst + bj * HALF + 4) = acc[ai][bj][m][1]; } } } }
        }
    }
};
struct EpiRelu2 {
    static constexpr bool PERM = true, AFTER_DRAIN = false, KHOOK = false; static constexpr int KH0 = -1, KH1 = -1;
    bf16_t* O; const float* bias;
    __device__ __forceinline__ void operator()(const f32x4 (&acc)[2][2][4][2], const Unit& u, int wr, int wc, int fr, int fq) const {
        const int row0 = u.pm * BM + wr * 64 + fr, col0 = u.pn * BM + wc * 32 + 8 * fq;
        f32x4 bv[2][2];
#pragma unroll
        for (int bj = 0; bj < 2; ++bj)
#pragma unroll
            for (int n = 0; n < 2; ++n) bv[bj][n] = *(const f32x4*)(bias + col0 + bj * HALF + 4 * n);
#pragma unroll
        for (int ai = 0; ai < 2; ++ai)
#pragma unroll
            for (int m = 0; m < 4; ++m) { bf16_t* rowp = O + (size_t)(row0 + ai * HALF + m * 16) * 4096 + col0;
#pragma unroll
                for (int bj = 0; bj < 2; ++bj) { f32x4 v0 = acc[ai][bj][m][0] + bv[bj][0], v1 = acc[ai][bj][m][1] + bv[bj][1];
#pragma unroll
                    for (int j = 0; j < 4; ++j) { const float a = fmaxf(v0[j], 0.f), b = fmaxf(v1[j], 0.f); v0[j] = a * a; v1[j] = b * b; }
                    u32x4 w; w.x = cvt_pk_bf16(v0[0], v0[1]); w.y = cvt_pk_bf16(v0[2], v0[3]); w.z = cvt_pk_bf16(v1[0], v1[1]); w.w = cvt_pk_bf16(v1[2], v1[3]);
                    *(u32x4*)(rowp + bj * HALF) = w; } }
    }
};
struct EpiRes {
    static constexpr bool PERM = false, AFTER_DRAIN = false, KHOOK = false; static constexpr int KH0 = -1, KH1 = -1;
    const float* baseP; const float* baseS;
    float* out;
    const float* bias;
    const float* gate;
    __device__ __forceinline__ void operator()(const f32x4 (&acc)[2][2][4][2], const Unit& u, int wr, int wc, int fr, int fq) const {
        const bool smp = u.pm >= 256;
        const float* bp = smp ? baseS + (size_t)(u.pm - 256) * BM * 1024 : baseP + (size_t)u.pm * BM * 1024;
        float* op = out + (size_t)u.pm * BM * 1024;
        const int col0 = u.pn * BM + wc * 32 + 4 * fq;
        f32x4 bv[2][2];
#pragma unroll
        for (int bj = 0; bj < 2; ++bj)
#pragma unroll
            for (int n = 0; n < 2; ++n) bv[bj][n] = *(const f32x4*)(bias + col0 + bj * HALF + n * 16);
#pragma unroll
        for (int ai = 0; ai < 2; ++ai)
#pragma unroll
            for (int m = 0; m < 4; ++m) { const int lr = ai * HALF + wr * 64 + m * 16 + fr;
                const int b = smp ? 16 + (u.pm - 256) * 16 + (lr >> 4) : (u.pm >> 4);
                const float* gp = gate + (size_t)b * 6144 + col0; const size_t off = (size_t)lr * 1024 + col0;
#pragma unroll
                for (int bj = 0; bj < 2; ++bj)
#pragma unroll
                    for (int n = 0; n < 2; ++n) { const f32x4 g = *(const f32x4*)(gp + bj * HALF + n * 16), x = *(const f32x4*)(bp + off + bj * HALF + n * 16);
                        *(f32x4*)(op + off + bj * HALF + n * 16) = x + g * (acc[ai][bj][m][n] + bv[bj][n]); }
                asm volatile("" ::: "memory"); }
    }
};


struct PanelOrder {
    int nunits, G, v;
    __host__ __device__ void init(int M, int G_, int v_) { nunits = (M / BM) * 4; G = G_; v = v_; }
    __host__ __device__ bool next(int i, Unit& u) const { const int L = i * G + v; if (L >= nunits) return false; u.pm = L >> 2; u.pn = L & 3; return true; }
    __device__ __forceinline__ void a_ready(const Unit&) const {}
    __device__ __forceinline__ void done(const Unit&) const {}
};
template <int MODE> struct EpiResNorm {
    static constexpr bool PERM = false, AFTER_DRAIN = false, KHOOK = (MODE == 0); static constexpr int KH0 = 8, KH1 = 16;
    const float* baseP; const float* baseS; float* out; const float* bias; const float* gate;
    unsigned* xslots;
    unsigned* cnt;
    PG8_LAS unsigned char* ldsx;
    bf16_t* H; const float* A2; const float* sh2;
    const float* ssq;
    const float* fw;
    __device__ __forceinline__ void prep(const Unit& u) const {
        int tid = threadIdx.x; asm volatile("" : "+v"(tid));
        if (tid < 256) { const f32x4* p = (const f32x4*)(ssq + (size_t)(u.pm * BM + tid) * 16); const f32x4 a = p[0], b = p[1], c = p[2], d = p[3];
            const float s0 = ((a.x + a.y) + (a.z + a.w)) + ((b.x + b.y) + (b.z + b.w)), s1 = ((c.x + c.y) + (c.z + c.w)) + ((d.x + d.y) + (d.z + d.w));
            const float r0 = 1.0f / sqrtf(s0 * (1.f / 512.f) + 1e-6f), r1 = 1.0f / sqrtf(s1 * (1.f / 512.f) + 1e-6f);
            PG8_LAS float* t = (PG8_LAS float*)ldsx; t[tid] = r0 / r1; t[256 + tid] = r1; }
    }
    __device__ __forceinline__ void khook(f32x4 (&acc)[2][2][4][2], int t, int wr, int fr_) const {
        int fr = fr_; asm volatile("" : "+v"(fr));
        const PG8_LAS float* tb = (const PG8_LAS float*)ldsx + (t == KH0 ? 0 : 256);
#pragma unroll
        for (int ai = 0; ai < 2; ++ai)
#pragma unroll
            for (int m = 0; m < 4; ++m) { const float f = tb[ai * HALF + wr * 64 + m * 16 + fr];
#pragma unroll
                for (int bj = 0; bj < 2; ++bj)
#pragma unroll
                    for (int n = 0; n < 2; ++n) acc[ai][bj][m][n] = acc[ai][bj][m][n] * f; }
    }
    __device__ __forceinline__ void operator()(f32x4 (&acc)[2][2][4][2], const Unit& u, int wr, int wc, int fr_, int fq_) const {
        int tid = threadIdx.x, fr = fr_, fq = fq_;
        asm volatile("" : "+v"(tid), "+v"(fr), "+v"(fq));
        const int lane = tid & 63, wid = __builtin_amdgcn_readfirstlane(tid >> 6);
        const bool smp = u.pm >= 256;
        const float* bp = smp ? baseS + (size_t)(u.pm - 256) * BM * 1024 : baseP + (size_t)u.pm * BM * 1024;
        float* op = out + (size_t)u.pm * BM * 1024;
        const int col0 = u.pn * BM + wc * 32 + 4 * fq;
        PG8_LAS float* P = (PG8_LAS float*)(ldsx + 2048); PG8_LAS float* S = (PG8_LAS float*)(ldsx + 6144);
#pragma unroll
        for (int bj = 0; bj < 2; ++bj)
#pragma unroll
            for (int n = 0; n < 2; ++n) { const f32x4 bv = *(const f32x4*)(bias + col0 + bj * HALF + n * 16);
#pragma unroll
                for (int ai = 0; ai < 2; ++ai)
#pragma unroll
                    for (int m = 0; m < 4; ++m) acc[ai][bj][m][n] += bv; }
#pragma unroll
        for (int ai = 0; ai < 2; ++ai)
#pragma unroll
            for (int m = 0; m < 4; ++m) { const int lr = ai * HALF + wr * 64 + m * 16 + fr;
                const int b = smp ? 16 + (u.pm - 256) * 16 + (lr >> 4) : (u.pm >> 4);
                const float* gp = gate + (size_t)b * 6144 + col0; const size_t off = (size_t)lr * 1024 + col0; float s = 0.f;
#pragma unroll
                for (int bj = 0; bj < 2; ++bj)
#pragma unroll
                    for (int n = 0; n < 2; ++n) { const f32x4 g = *(const f32x4*)(gp + bj * HALF + n * 16), x = *(const f32x4*)(bp + off + bj * HALF + n * 16);
                        const f32x4 v = x + g * acc[ai][bj][m][n]; acc[ai][bj][m][n] = v; s += (v.x * v.x + v.y * v.y) + (v.z * v.z + v.w * v.w); }
                s += __shfl_xor(s, 16); s += __shfl_xor(s, 32);
                if (fq == 0) P[lr * 4 + wc] = s;
                asm volatile("" : "+v"(acc[ai][0][m][0]), "+v"(acc[ai][0][m][1]), "+v"(acc[ai][1][m][0]), "+v"(acc[ai][1][m][1]));
                asm volatile("" ::: "memory"); }
        asm volatile("s_waitcnt lgkmcnt(0)" ::: "memory"); __builtin_amdgcn_s_barrier(); asm volatile("" ::: "memory");
        if (tid < 256) { const f32x4 p4 = *(const PG8_LAS f32x4*)(P + tid * 4); const float t = (p4.x + p4.y) + (p4.z + p4.w);
            __hip_atomic_store(xslots + ((size_t)(u.pm * BM + tid) * 4 + u.pn), __float_as_uint(t), __ATOMIC_RELAXED, __HIP_MEMORY_SCOPE_AGENT); }
        asm volatile("s_waitcnt vmcnt(0)" ::: "memory");
        if (wid < 4 && lane == 0) __hip_atomic_fetch_add(cnt + 64 * u.pm, 1u, __ATOMIC_RELAXED, __HIP_MEMORY_SCOPE_AGENT);
        if (wid == 0) { unsigned sp = 0;
            while ((unsigned)__builtin_amdgcn_readfirstlane(__hip_atomic_load(cnt + 64 * u.pm, __ATOMIC_RELAXED, __HIP_MEMORY_SCOPE_AGENT)) < 16u) { __builtin_amdgcn_s_sleep(2); if (++sp > (1u << 22)) break; }
            __builtin_amdgcn_fence(__ATOMIC_ACQUIRE, "agent"); }
        asm volatile("s_waitcnt vmcnt(0) lgkmcnt(0)" ::: "memory"); __builtin_amdgcn_s_barrier(); asm volatile("" ::: "memory");
        if (tid < 256) { const unsigned* sl = xslots + (size_t)(u.pm * BM + tid) * 4; float t = 0.f;
#pragma unroll
            for (int q = 0; q < 4; ++q) t += __uint_as_float(__hip_atomic_load(sl + q, __ATOMIC_RELAXED, __HIP_MEMORY_SCOPE_AGENT));
            S[tid] = 1.0f / sqrtf(t * (1.f / 1024.f) + 1e-6f); }
        asm volatile("s_waitcnt lgkmcnt(0)" ::: "memory"); __builtin_amdgcn_s_barrier(); asm volatile("" ::: "memory");
#pragma unroll
        for (int ai = 0; ai < 2; ++ai)
#pragma unroll
            for (int m = 0; m < 4; ++m) { const int lr = ai * HALF + wr * 64 + m * 16 + fr; const float rs = S[lr]; const size_t off = (size_t)lr * 1024 + col0;
                if constexpr (MODE == 0) {
                    const int b = smp ? 16 + (u.pm - 256) * 16 + (lr >> 4) : (u.pm >> 4);
                    const float* ap = A2 + (size_t)b * 1024 + col0; const float* sp = sh2 + (size_t)b * 6144 + col0; bf16_t* hp = H + (size_t)(u.pm * BM + lr) * 1024 + col0;
#pragma unroll
                    for (int bj = 0; bj < 2; ++bj)
#pragma unroll
                        for (int n = 0; n < 2; ++n) { const f32x4 v = acc[ai][bj][m][n]; *(f32x4*)(op + off + bj * HALF + n * 16) = v;
                            const f32x4 hv = v * rs * *(const f32x4*)(ap + bj * HALF + n * 16) + *(const f32x4*)(sp + bj * HALF + n * 16);
                            u32x2 w; w.x = cvt_pk_bf16(hv.x, hv.y); w.y = cvt_pk_bf16(hv.z, hv.w); *(u32x2*)(hp + bj * HALF + n * 16) = w; }
                } else {
#pragma unroll
                    for (int bj = 0; bj < 2; ++bj)
#pragma unroll
                        for (int n = 0; n < 2; ++n) *(f32x4*)(op + off + bj * HALF + n * 16) = acc[ai][bj][m][n] * rs * *(const f32x4*)(fw + col0 + bj * HALF + n * 16);
                }
                asm volatile("" ::: "memory"); }
    }
};
template <class Epi, class Sched, bool ALIGN_EPI = false, bool SP2 = false>
__device__ __forceinline__ void gemm_phase(PG8_LAS unsigned char* lds, const Gemm g, const Sched& S, const Epi& E) {
    const int tid = threadIdx.x, wid = __builtin_amdgcn_readfirstlane(tid >> 6), lane = tid & 63, wr = wid >> 2, wc = wid & 3, fr = lane & 15, fq = lane >> 4;
    const int K = g.K, nt = K / BK;
    unsigned voffA[2], voffB[2];
#pragma unroll
    for (int i = 0; i < 2; ++i) { int R, C; stage_rc(tid * 16 + i * 8192, R, C); const int Rb = Epi::PERM ? ((R & ~31) + perm32(R & 31)) : R;
        voffA[i] = (unsigned)(R * K + C) * 2u; voffB[i] = (unsigned)(Rb * K + C) * 2u; }
    const size_t kstep = (size_t)(BK * 2);
    const size_t hstep = (size_t)HALF * K * 2;
    const size_t tstep = 2 * hstep;
    const unsigned ldsw = (unsigned)wid * 1024u;
    const int aoff = lds_byte(wr * 64 + fr, fq * 8), boff = lds_byte(wc * 32 + fr, fq * 8);
#define PG8_SA(b, h) (((b) * 2 + (h)) * HTB)
#define PG8_SB(b, h) ((4 + (b) * 2 + (h)) * HTB)
#define PG8_STAGE(bufoff, gbase, voff) do { _Pragma("unroll") for (int _i = 0; _i < 2; ++_i) \
        __builtin_amdgcn_global_load_lds((const unsigned*)((const char*)(gbase) + (voff)[_i]), (PG8_LAS unsigned*)(lds + (bufoff) + ldsw + _i * 8192), 16, 0, 0); } while (0)
#define PG8_LDA(dst, b, h) do { _Pragma("unroll") for (int m = 0; m < 4; ++m) _Pragma("unroll") for (int k = 0; k < 2; ++k) dst[m][k] = *(const PG8_LAS bf16x8*)(lds + PG8_SA(b, h) + aoff + m * 2048 + k * 1024); } while (0)
#define PG8_LDB(dst, b, h) do { _Pragma("unroll") for (int n = 0; n < 2; ++n) _Pragma("unroll") for (int k = 0; k < 2; ++k) dst[n][k] = *(const PG8_LAS bf16x8*)(lds + PG8_SB(b, h) + boff + n * 2048 + k * 1024); } while (0)
#define PG8_MMA(ai, bj, At, Bt) do { __builtin_amdgcn_s_setprio(1); _Pragma("unroll") for (int m = 0; m < 4; ++m) _Pragma("unroll") for (int n = 0; n < 2; ++n) _Pragma("unroll") for (int k = 0; k < 2; ++k) \
        acc[ai][bj][m][n] = __builtin_amdgcn_mfma_f32_16x16x32_bf16(Bt[n][k], At[m][k], acc[ai][bj][m][n], 0, 0, 0); __builtin_amdgcn_s_setprio(0); } while (0)
#define PG8_WAIT_V(n) asm volatile("s_waitcnt vmcnt(" #n ")" ::: "memory")
#define PG8_WAIT_L(n) asm volatile("s_waitcnt lgkmcnt(" #n ")" ::: "memory")
#define PG8_BAR __builtin_amdgcn_s_barrier()
#define PG8_SCHED __builtin_amdgcn_sched_barrier(0)
    Unit cur, nxt; int ui = 0;
    if (!S.next(0, cur)) return;
    f32x4 acc[2][2][4][2];
#pragma unroll
    for (int a = 0; a < 2; ++a)
#pragma unroll
        for (int b = 0; b < 2; ++b)
#pragma unroll
            for (int m = 0; m < 4; ++m)
#pragma unroll
                for (int n = 0; n < 2; ++n) acc[a][b][m][n] = (f32x4){0.f, 0.f, 0.f, 0.f};
    bf16x8 At[4][2], B0[2][2], B1[2][2];
    const char* cA = (const char*)g.A + (size_t)cur.pm * tstep; const char* cB = (const char*)g.Bt + (size_t)cur.pn * tstep;
    S.a_ready(cur);
    if constexpr (Epi::KHOOK) E.prep(cur);
    if constexpr (SP2) {
        PG8_STAGE(PG8_SB(0, 0), cB, voffB); PG8_STAGE(PG8_SB(0, 1), cB + hstep, voffB); PG8_STAGE(PG8_SA(0, 0), cA, voffA); PG8_STAGE(PG8_SA(0, 1), cA + hstep, voffA);
        if (wr == 1) PG8_BAR;
        PG8_WAIT_V(2); PG8_BAR;
        PG8_STAGE(PG8_SB(1, 0), cB + kstep, voffB); PG8_STAGE(PG8_SA(1, 0), cA + kstep, voffA); PG8_STAGE(PG8_SB(1, 1), cB + hstep + kstep, voffB);
        PG8_WAIT_V(6); PG8_BAR;
    } else {
        PG8_STAGE(PG8_SB(0, 0), cB, voffB); PG8_STAGE(PG8_SA(0, 0), cA, voffA); PG8_STAGE(PG8_SB(0, 1), cB + hstep, voffB); PG8_STAGE(PG8_SA(0, 1), cA + hstep, voffA);
        if (wr == 1) PG8_BAR;
        PG8_WAIT_V(4); PG8_BAR;
        PG8_STAGE(PG8_SB(1, 0), cB + kstep, voffB); PG8_STAGE(PG8_SA(1, 0), cA + kstep, voffA); PG8_STAGE(PG8_SB(1, 1), cB + hstep + kstep, voffB);
        PG8_WAIT_V(6); PG8_BAR;
    }
    for (;;) {
        const bool has_next = S.next(ui + 1, nxt);
        const char* nA = has_next ? (const char*)g.A + (size_t)nxt.pm * tstep : cA; const char* nB = has_next ? (const char*)g.Bt + (size_t)nxt.pn * tstep : cB;
        for (int t = 0; t < nt; t += 2) {
            const bool last = (t == nt - 2);
            const char* a1 = cA + (size_t)(t + 1) * kstep;
            const char* a2 = last ? nA : cA + (size_t)(t + 2) * kstep; const char* b2 = last ? nB : cB + (size_t)(t + 2) * kstep;
            const char* a3 = a2 + kstep; const char* b3 = b2 + kstep;
            if (last && has_next) S.a_ready(nxt);
            if constexpr (Epi::KHOOK) { if (t == Epi::KH0 || t == Epi::KH1) E.khook(acc, t, wr, fr); }
            if constexpr (SP2) {
            PG8_LDB(B0, 0, 0); PG8_LDB(B1, 0, 1); PG8_SCHED; PG8_LDA(At, 0, 0); PG8_STAGE(PG8_SA(1, 1), a1 + hstep, voffA);
            PG8_WAIT_V(8); PG8_WAIT_L(0); PG8_BAR; PG8_MMA(0, 0, At, B0); PG8_MMA(0, 1, At, B1); PG8_BAR; PG8_SCHED;
            PG8_LDA(At, 0, 1); PG8_STAGE(PG8_SB(0, 0), b2, voffB); PG8_STAGE(PG8_SB(0, 1), b2 + hstep, voffB); PG8_STAGE(PG8_SA(0, 0), a2, voffA);
            PG8_WAIT_V(8); PG8_WAIT_L(0); PG8_BAR; PG8_MMA(1, 0, At, B0); PG8_MMA(1, 1, At, B1); PG8_BAR; PG8_SCHED;
            PG8_LDB(B0, 1, 0); PG8_LDB(B1, 1, 1); PG8_SCHED; PG8_LDA(At, 1, 0); PG8_STAGE(PG8_SA(0, 1), a2 + hstep, voffA);
            PG8_WAIT_V(8); PG8_WAIT_L(0); PG8_BAR; PG8_MMA(0, 0, At, B0); PG8_MMA(0, 1, At, B1); PG8_BAR; PG8_SCHED;
            PG8_LDA(At, 1, 1); PG8_STAGE(PG8_SB(1, 0), b3, voffB); PG8_STAGE(PG8_SB(1, 1), b3 + hstep, voffB); PG8_STAGE(PG8_SA(1, 0), a3, voffA);
            PG8_WAIT_V(8); PG8_WAIT_L(0); PG8_BAR; PG8_MMA(1, 0, At, B0); PG8_MMA(1, 1, At, B1); PG8_BAR; PG8_SCHED;
            } else {
            PG8_LDB(B0, 0, 0); PG8_SCHED; PG8_LDA(At, 0, 0); PG8_STAGE(PG8_SA(1, 1), a1 + hstep, voffA);
            PG8_WAIT_L(8); PG8_BAR; PG8_WAIT_L(0); PG8_MMA(0, 0, At, B0); PG8_BAR; PG8_SCHED;
            PG8_LDB(B1, 0, 1); PG8_STAGE(PG8_SB(0, 0), b2, voffB);
            PG8_BAR; PG8_WAIT_L(0); PG8_MMA(0, 1, At, B1); PG8_BAR;
            PG8_LDA(At, 0, 1); PG8_STAGE(PG8_SA(0, 0), a2, voffA);
            PG8_BAR; PG8_WAIT_L(0); PG8_MMA(1, 0, At, B0); PG8_BAR; PG8_SCHED;
            PG8_STAGE(PG8_SB(0, 1), b2 + hstep, voffB);
            PG8_WAIT_V(6); PG8_BAR; PG8_MMA(1, 1, At, B1); PG8_BAR;
            PG8_LDB(B0, 1, 0); PG8_SCHED; PG8_LDA(At, 1, 0); PG8_STAGE(PG8_SA(0, 1), a2 + hstep, voffA);
            PG8_WAIT_L(8); PG8_BAR; PG8_WAIT_L(0); PG8_MMA(0, 0, At, B0); PG8_BAR; PG8_SCHED;
            PG8_LDB(B1, 1, 1); PG8_STAGE(PG8_SB(1, 0), b3, voffB);
            PG8_BAR; PG8_WAIT_L(0); PG8_MMA(0, 1, At, B1); PG8_BAR;
            PG8_LDA(At, 1, 1); PG8_STAGE(PG8_SA(1, 0), a3, voffA);
            PG8_BAR; PG8_WAIT_L(0); PG8_MMA(1, 0, At, B0); PG8_BAR; PG8_SCHED;
            PG8_STAGE(PG8_SB(1, 1), b3 + hstep, voffB);
            PG8_WAIT_V(6); PG8_BAR; PG8_MMA(1, 1, At, B1); PG8_BAR;
            }
        }
        if constexpr (ALIGN_EPI) { if (wr == 0) PG8_BAR; }
        if constexpr (!Epi::AFTER_DRAIN) { E(acc, cur, wr, wc, fr, fq); S.done(cur); }
        if constexpr (Epi::KHOOK) { if (has_next) E.prep(nxt); }
        if (!has_next) break;
#pragma unroll
        for (int a = 0; a < 2; ++a)
#pragma unroll
            for (int b = 0; b < 2; ++b)
#pragma unroll
                for (int m = 0; m < 4; ++m)
#pragma unroll
                    for (int n = 0; n < 2; ++n) acc[a][b][m][n] = (f32x4){0.f, 0.f, 0.f, 0.f};
        cur = nxt; cA = nA; cB = nB; ++ui;
        if constexpr (ALIGN_EPI) { if (wr == 1) PG8_BAR; }
    }
    PG8_WAIT_V(0);
    if constexpr (!ALIGN_EPI) { if (wr == 0) PG8_BAR; }
    PG8_BAR;
    if constexpr (Epi::AFTER_DRAIN) { E.fused(acc, cur, wr, wc, fr, fq, lds, wid, lane); S.done(cur); }
#undef PG8_SA
#undef PG8_SB
#undef PG8_STAGE
#undef PG8_LDA
#undef PG8_LDB
#undef PG8_MMA
#undef PG8_WAIT_V
#undef PG8_WAIT_L
#undef PG8_BAR
#undef PG8_SCHED
}
}
constexpr size_t MiB = 1u << 20;
constexpr size_t WS_CTL = 0, CTL_ZERO_BYTES = 1 * MiB;
constexpr size_t WS_MOD = 1 * MiB;
constexpr size_t WS_BIASA = 2 * MiB + 512 * 1024;
constexpr size_t WS_A2 = 2 * MiB + 640 * 1024;
constexpr size_t WS_XSL = 30 * MiB;
constexpr size_t WS_WIN = 3 * MiB, WS_WOUT = 10 * MiB, WS_W1 = 14 * MiB, WS_W2 = 22 * MiB;
constexpr size_t WS_H = 32 * MiB;
constexpr size_t WS_PROJ = 161 * MiB;
constexpr size_t WS_DT = 613 * MiB;
constexpr size_t WS_MIX = 618 * MiB;
constexpr size_t WS_SSQ = 876 * MiB;
constexpr size_t WS_HMID = 161 * MiB;
constexpr size_t WS_END = 882 * MiB;
static_assert(WS_H + (size_t)MT * DM * 2 <= WS_PROJ && WS_PROJ + (size_t)MT * NPROJ * 2 <= WS_DT && WS_DT + (size_t)MT * 16 * 4 <= WS_MIX && WS_MIX + (size_t)MT * MIXW * 2 <= WS_SSQ
              && WS_SSQ + (size_t)MT * 16 * 4 <= WS_END && WS_HMID + (size_t)MT * DFF * 2 <= WS_SSQ && WS_MOD + (size_t)NBT * NMOD * 4 <= WS_BIASA && WS_W2 + (size_t)DM * DFF * 2 <= WS_H, "d_ws map");

constexpr int NWAVES = 8;
constexpr int RING_OFF = 0, RING_BYTES = 131072;
constexpr int LDS_BYTES = 147456;

#define GAS __attribute__((address_space(1)))
#define LAS __attribute__((address_space(3)))
typedef unsigned short bf16;
typedef unsigned v4u __attribute__((ext_vector_type(4)));
typedef unsigned v2u __attribute__((ext_vector_type(2)));
typedef float f32x4 __attribute__((ext_vector_type(4)));
#define LDS_WAIT() asm volatile("s_waitcnt lgkmcnt(0)" ::: "memory")
__device__ __forceinline__ unsigned f2bf(float f) { unsigned u = __builtin_bit_cast(unsigned, f); return (u + 0x7fffu + ((u >> 16) & 1u)) >> 16; }
__device__ __forceinline__ unsigned pk2(float lo, float hi) { return f2bf(lo) | (f2bf(hi) << 16); }
__device__ __forceinline__ float bflo(unsigned w) { return __builtin_bit_cast(float, w << 16); }
__device__ __forceinline__ float bfhi(unsigned w) { return __builtin_bit_cast(float, w & 0xffff0000u); }
__device__ __forceinline__ float wave_sum(float v) {
#pragma unroll
    for (int o = 1; o < 64; o <<= 1) v += __shfl_xor(v, o);
    return v;
}
__device__ __forceinline__ float silu_f(float x) { return x / (1.f + __expf(-x)); }

typedef GAS unsigned gu32;
typedef GAS unsigned long long gu64;
#define RLX_AGENT __ATOMIC_RELAXED, __HIP_MEMORY_SCOPE_AGENT
constexpr int CW_TMO = 0, CW_CODE = 1, CW_BAR = 4096, CW_SEAM = 16384, SEAM_BANK = 320 * 64;
constexpr int LDSX_OFF = RING_BYTES + 512;
constexpr int LDSCTL_OFF = RING_BYTES, MISC_OFF = LDSCTL_OFF + 320;
#define XB_TMO      128
#define XB_XCNT(j)  (256  + 64 * (j))
#define XB_XSUB(j)  (1280 + 64 * (j))
#define XB_XGEN(j)  (2304 + 64 * (j))
#define XB_TOP      3328
#define XB_TOPGEN   3392
#define XCD_BAR_WORDS 3456
#define XB_SPIN_CAP (1u << 18)

__device__ __forceinline__ unsigned xb_ld(unsigned* p)              { return __hip_atomic_load(p, __ATOMIC_RELAXED, __HIP_MEMORY_SCOPE_AGENT); }
__device__ __forceinline__ unsigned xb_add(unsigned* p, unsigned v) { return __hip_atomic_fetch_add(p, v, __ATOMIC_RELAXED, __HIP_MEMORY_SCOPE_AGENT); }
__device__ __forceinline__ unsigned xb_xcc_id() { return (unsigned)__builtin_amdgcn_s_getreg((3 << 11) | 20) & 0xFu; }
#define XB_SPIN(cond, bar) do { unsigned _sp = 0; while (cond) { __builtin_amdgcn_s_sleep(1); \
    if ((++_sp & 255u) == 0u) { if (xb_ld(&(bar)[XB_TMO])) break; if (_sp > XB_SPIN_CAP) { atomicAdd(&(bar)[XB_TMO], 1u); break; } } } } while (0)

struct XcdBarrier {
    unsigned* bar; unsigned x;
    volatile LAS unsigned* st;
};

__device__ __forceinline__ XcdBarrier xcd_barrier_post(unsigned* bar, volatile LAS unsigned* st) {
    XcdBarrier b; b.bar = bar; b.x = xb_xcc_id(); b.st = st;
    if (threadIdx.x == 0) (void)xb_add(&bar[XB_XCNT(b.x)], 1u);
    return b;
}
__device__ __forceinline__ void xcd_barrier_complete(unsigned* bar, unsigned x, unsigned& nloc, unsigned& nx) {
    const unsigned G = gridDim.x * gridDim.y * gridDim.z;
    unsigned sum, cnt, mine, sp = 0u;
    for (;;) {
        sum = 0u; cnt = 0u; mine = 0u;
#pragma unroll
        for (unsigned j = 0; j < 16; ++j) { const unsigned c = xb_ld(&bar[XB_XCNT(j)]); sum += c; cnt += (c > 0u) ? 1u : 0u; mine = (j == x) ? c : mine; }
        if (sum == G) break;
        __builtin_amdgcn_s_sleep(1);
        if ((++sp & 255u) == 0u) { if (xb_ld(&bar[XB_TMO])) break; if (sp > XB_SPIN_CAP) { atomicAdd(&bar[XB_TMO], 1u); break; } }
    }
    nloc = mine > 0u ? mine : 1u; nx = cnt > 0u ? cnt : 1u;
}

__device__ __forceinline__ void xcd_barrier(const XcdBarrier& b) {
    asm volatile("s_waitcnt vmcnt(0)" ::: "memory");
    __syncthreads();
    if (threadIdx.x == 0) {
        unsigned* bar = b.bar;
        __builtin_amdgcn_s_waitcnt(0);
        unsigned nloc = b.st[0], nx = b.st[1];
        if (nloc == 0u) { xcd_barrier_complete(bar, b.x, nloc, nx); b.st[0] = nloc; b.st[1] = nx; }
        const unsigned old = xb_add(&bar[XB_XSUB(b.x)], 1u);
        const unsigned gen = old / nloc;
        if (old + 1u == (gen + 1u) * nloc) {
            __builtin_amdgcn_fence(__ATOMIC_RELEASE, "agent");
            asm volatile("s_waitcnt vmcnt(0)" ::: "memory");
            const unsigned og = xb_add(&bar[XB_TOP], 1u);
            const unsigned tg = og / nx;
            if (og + 1u == (tg + 1u) * nx) xb_add(&bar[XB_TOPGEN], 1u);
            else XB_SPIN(xb_ld(&bar[XB_TOPGEN]) == tg, bar);
            __builtin_amdgcn_fence(__ATOMIC_ACQUIRE, "agent");
            xb_add(&bar[XB_XGEN(b.x)], 1u);
            asm volatile("s_waitcnt vmcnt(0)" ::: "memory");
        } else {
            XB_SPIN(xb_ld(&bar[XB_XGEN(b.x)]) == gen, bar);
            __builtin_amdgcn_fence(__ATOMIC_ACQUIRE, "agent");
            asm volatile("s_waitcnt vmcnt(0)" ::: "memory");
        }
    }
    __syncthreads();
}

struct Frame {
    LAS unsigned char* lds;
    int tid, lane, wave, vcu, G;
    const float* in[27]; float* out; unsigned char* ws;
};
#define IN_XP 0
#define IN_XS 1
#define IN_CPOOL 2
#define IN_CCONV 3
#define IN_SSM 4
#define IN_CP 5
#define IN_CS 6
#define IN_NW1 7
#define IN_NW2 8
#define IN_WADA 9
#define IN_BADA 10
#define IN_WIN 11
#define IN_POOLW 12
#define IN_POOLB 13
#define IN_POOLS 14
#define IN_CONVW 15
#define IN_CONVB 16
#define IN_DTB 17
#define IN_ALOG 18
#define IN_DSKIP 19
#define IN_SNW 20
#define IN_WOUT 21
#define IN_W1 22
#define IN_B1 23
#define IN_W2 24
#define IN_B2 25
#define IN_FNW 26

__device__ __forceinline__ void p0_mod(Frame& F) {
    const float* w_ada = F.in[IN_WADA]; const float* b_ada = F.in[IN_BADA]; float* mod = (float*)(F.ws + WS_MOD);
    LAS float* red = (LAS float*)(F.lds + RING_OFF);
    const int lane = F.lane, li = lane & 15, kq = lane >> 4;
    for (int ct = blockIdx.x; ct < NMOD / 16; ct += F.G) {
        f32x4 acc[3];
#pragma unroll
        for (int mt = 0; mt < 3; ++mt) acc[mt] = (f32x4){0.f, 0.f, 0.f, 0.f};
        const int k0 = F.wave * 128, col = ct * 16 + li;
        const float* cp[3]; cp[0] = F.in[IN_CP] + (size_t)li * DM; cp[1] = F.in[IN_CS] + (size_t)li * DM; cp[2] = F.in[IN_CS] + (size_t)(16 + li) * DM;
#pragma unroll 8
        for (int s = 0; s < 32; ++s) { const int k = k0 + 4 * s + kq; const float bval = w_ada[(size_t)k * NMOD + col];
#pragma unroll
            for (int mt = 0; mt < 3; ++mt) { const float a = silu_f(cp[mt][k]); acc[mt] = __builtin_amdgcn_mfma_f32_16x16x4f32(a, bval, acc[mt], 0, 0, 0); } }
#pragma unroll
        for (int mt = 0; mt < 3; ++mt)
#pragma unroll
            for (int r = 0; r < 4; ++r) red[((F.wave * 3 + mt) * 4 + r) * 64 + lane] = acc[mt][r];
        __syncthreads();
        for (int e = F.tid; e < 768; e += NWAVES * 64) { const int mt = e >> 8, r = (e >> 6) & 3, ln = e & 63; float s = 0.f;
#pragma unroll
            for (int w = 0; w < 8; ++w) s += red[((w * 3 + mt) * 4 + r) * 64 + ln];
            const int batch = 16 * mt + 4 * (ln >> 4) + r, c = ct * 16 + (ln & 15);
            mod[(size_t)batch * NMOD + c] = s + b_ada[c]; }
        __syncthreads();
    }
}
__device__ __forceinline__ void p0_transpose_item(const float* W, int ldw, int nblk, bf16* WT, int ldt, int kofs, const float* kscale, LAS float* scr, int item, int lane) {
    const int kb = item / nblk, nb = item % nblk, k0 = 64 * kb, n0 = 32 * nb;
#pragma unroll 8
    for (int i = 0; i < 32; ++i) { const int kk = 2 * i + (lane >> 5); float v = W[(size_t)(k0 + kk) * ldw + n0 + (lane & 31)]; if (kscale) v *= kscale[k0 + kk]; scr[kk * 33 + (lane & 31)] = v; }
    LDS_WAIT(); asm volatile("" ::: "memory");
    const int c = lane & 7;
#pragma unroll
    for (int j = 0; j < 4; ++j) { const int n = (lane >> 3) + 8 * j; const LAS float* s = scr + (8 * c) * 33 + n;
        v4u o; o.x = pk2(s[0 * 33], s[1 * 33]); o.y = pk2(s[2 * 33], s[3 * 33]); o.z = pk2(s[4 * 33], s[5 * 33]); o.w = pk2(s[6 * 33], s[7 * 33]);
        *(GAS v4u*)(WT + (size_t)(n0 + n) * ldt + kofs + k0 + 8 * c) = o; }
    LDS_WAIT(); asm volatile("" ::: "memory");
}
__device__ __forceinline__ void p0_weights(Frame& F) {
    LAS float* scr = (LAS float*)(F.lds + RING_OFF + 32768 + F.wave * 12288);
    const int gw = F.vcu * NWAVES + F.wave, NGW = F.G * NWAVES;
    bf16* Win_t = (bf16*)(F.ws + WS_WIN); bf16* Wout_t = (bf16*)(F.ws + WS_WOUT); bf16* W1_t = (bf16*)(F.ws + WS_W1); bf16* W2_t = (bf16*)(F.ws + WS_W2);
    constexpr int I_IN = (DM / 64) * (NPROJ / 32), I_OB = (DM / 64) * (DM / 32), I_1 = (DM / 64) * (DFF / 32), I_2 = (DFF / 64) * (DM / 32);
    constexpr int NITEMS = I_IN + I_OB + I_1 + I_2;
    for (int it = gw; it < NITEMS; it += NGW) {
        int r = it;
        if (r < I_IN) { p0_transpose_item(F.in[IN_WIN], LDWIN, NPROJ / 32, Win_t, DM, 0, nullptr, scr, r, F.lane); continue; } r -= I_IN;
        if (r < I_OB) { p0_transpose_item(F.in[IN_WOUT] + (size_t)DM * DM, DM, DM / 32, Wout_t, MIXW, 0, F.in[IN_SNW], scr, r, F.lane); continue; } r -= I_OB;
        if (r < I_1) { p0_transpose_item(F.in[IN_W1], DFF, DFF / 32, W1_t, DM, 0, nullptr, scr, r, F.lane); continue; } r -= I_1;
        p0_transpose_item(F.in[IN_W2], DM, DM / 32, W2_t, DFF, 0, nullptr, scr, r, F.lane);
    }
    const float* pw = F.in[IN_POOLW]; const float* ps = F.in[IN_POOLS]; const float* wo = F.in[IN_WOUT];
    const int li = F.lane & 15, kq = F.lane >> 4;
    for (int t = gw; t < 64 * 64; t += NGW) { const int it = t >> 6, nt = t & 63, g = it >> 4;
        f32x4 acc = (f32x4){0.f, 0.f, 0.f, 0.f};
        const float* arow = pw + ((size_t)(16 * it + li)) * 256;
#pragma unroll 8
        for (int s = 0; s < 64; ++s) { const int d = 4 * s + kq; const float a = arow[d] * ps[256 * g + d]; const float b = wo[(size_t)(256 * g + d) * DM + nt * 16 + li];
            acc = __builtin_amdgcn_mfma_f32_16x16x4f32(a, b, acc, 0, 0, 0); }
        v2u o; o.x = pk2(acc[0], acc[1]); o.y = pk2(acc[2], acc[3]);
        *(GAS v2u*)(Wout_t + (size_t)(nt * 16 + li) * MIXW + 1024 + 16 * it + 4 * kq) = o; }
    if (blockIdx.x < 16) { const float* pb = F.in[IN_POOLB]; LAS float* red = (LAS float*)(F.lds + RING_OFF);
        const int n = blockIdx.x * 64 + F.lane; float s = 0.f;
        for (int k = F.wave * 128; k < F.wave * 128 + 128; ++k) s += pb[k] * ps[k] * wo[(size_t)k * DM + n];
        __syncthreads(); red[F.wave * 64 + F.lane] = s; __syncthreads();
        if (F.wave == 0) { float t = 0.f;
#pragma unroll
            for (int w = 0; w < 8; ++w) t += red[w * 64 + F.lane];
            ((float*)(F.ws + WS_BIASA))[n] = t; }
        __syncthreads(); }
}

template <bool WITH_DT>
__device__ __forceinline__ void norm_rows(Frame& F, const float* xrows  , int nrows, int grow0  , int batch, const float* nw, int sc_off, int sh_off, LAS float* wdt) {
    const float* mod = (const float*)(F.ws + WS_MOD) + (size_t)batch * NMOD; bf16* H = (bf16*)(F.ws + WS_H); float* DT = (float*)(F.ws + WS_DT);
    const int lane = F.lane;
    f32x4 a1[4], s1[4];
#pragma unroll
    for (int j = 0; j < 4; ++j) { const f32x4 w = *(const f32x4*)(nw + 256 * j + 4 * lane), sc = *(const f32x4*)(mod + sc_off + 256 * j + 4 * lane); a1[j] = w * (sc + 1.0f); s1[j] = *(const f32x4*)(mod + sh_off + 256 * j + 4 * lane); }
    for (int r = 0; r < nrows; ++r) {
        const GAS f32x4* xr = (const GAS f32x4*)(xrows + (size_t)r * DM) + lane;
        f32x4 v[4]; float ss = 0.f;
#pragma unroll
        for (int j = 0; j < 4; ++j) { v[j] = xr[64 * j]; ss += (v[j].x * v[j].x + v[j].y * v[j].y) + (v[j].z * v[j].z + v[j].w * v[j].w); }
        const float rs = 1.0f / sqrtf(wave_sum(ss) * (1.f / DM) + EPS);
#pragma unroll
        for (int j = 0; j < 4; ++j) v[j] = v[j] * rs * a1[j] + s1[j];
        GAS unsigned long long* o8 = (GAS unsigned long long*)(H + (size_t)(grow0 + r) * DM) + lane;
#pragma unroll
        for (int j = 0; j < 4; ++j) o8[64 * j] = (unsigned long long)pk2(v[j].x, v[j].y) | ((unsigned long long)pk2(v[j].z, v[j].w) << 32);
        if constexpr (WITH_DT) {
            float acc[16];
#pragma unroll
            for (int c = 0; c < 16; ++c) acc[c] = 0.f;
#pragma unroll
            for (int j = 0; j < 4; ++j)
#pragma unroll
                for (int i = 0; i < 4; ++i) { const float hv = v[j][i]; const LAS f32x4* wr = (const LAS f32x4*)(wdt + (i * 256 + j * 64 + lane) * 20);
#pragma unroll
                    for (int q = 0; q < 4; ++q) { const f32x4 w = wr[q]; acc[4 * q + 0] += hv * w.x; acc[4 * q + 1] += hv * w.y; acc[4 * q + 2] += hv * w.z; acc[4 * q + 3] += hv * w.w; }
                    if (i & 1) asm volatile("" ::: "memory"); }
#pragma unroll
            for (int c = 0; c < 8; ++c) { const bool hi = lane & 1; const float keep = hi ? acc[c + 8] : acc[c], send = hi ? acc[c] : acc[c + 8]; acc[c] = keep + __shfl_xor(send, 1); }
#pragma unroll
            for (int c = 0; c < 4; ++c) { const bool hi = lane & 2; const float keep = hi ? acc[c + 4] : acc[c], send = hi ? acc[c] : acc[c + 4]; acc[c] = keep + __shfl_xor(send, 2); }
#pragma unroll
            for (int c = 0; c < 2; ++c) { const bool hi = lane & 4; const float keep = hi ? acc[c + 2] : acc[c], send = hi ? acc[c] : acc[c + 2]; acc[c] = keep + __shfl_xor(send, 4); }
            { const bool hi = lane & 8; const float keep = hi ? acc[1] : acc[0], send = hi ? acc[0] : acc[1]; acc[0] = keep + __shfl_xor(send, 8); }
            float t = acc[0]; t += __shfl_xor(t, 16); t += __shfl_xor(t, 32);
            if (lane < 16) { const int ch = 8 * (lane & 1) + 4 * ((lane >> 1) & 1) + 2 * ((lane >> 2) & 1) + ((lane >> 3) & 1); DT[(size_t)(grow0 + r) * 16 + ch] = t; }
        }
    }
}
template <bool FIRST>
__device__ __forceinline__ void p_norm(Frame& F) {
    LAS float* wdt = (LAS float*)(F.lds + RING_OFF);
    if constexpr (FIRST) {
        for (int k = F.tid; k < DM; k += NWAVES * 64) { const f32x4* src = (const f32x4*)(F.in[IN_WIN] + (size_t)k * LDWIN + NPROJ);
            LAS f32x4* dst = (LAS f32x4*)(wdt + ((k & 3) * 256 + (k >> 8) * 64 + ((k >> 2) & 63)) * 20);
            dst[0] = src[0]; dst[1] = src[1]; dst[2] = src[2]; dst[3] = src[3]; }
        __syncthreads();
        if (blockIdx.x < NBT) { const int b = blockIdx.x; const float* md = (const float*)(F.ws + WS_MOD) + (size_t)b * NMOD; float* A2 = (float*)(F.ws + WS_A2) + (size_t)b * DM;
            for (int c = F.tid; c < DM; c += NWAVES * 64) A2[c] = F.in[IN_NW2][c] * (1.0f + md[4 * DM + c]); }
    }
    const int gw = F.vcu * NWAVES + F.wave;
    const float* nw = F.in[FIRST ? IN_NW1 : IN_NW2]; const int sc_off = FIRST ? DM : 4 * DM, sh_off = FIRST ? 0 : 3 * DM;
    for (int w = gw; w < MP / 32; w += F.G * NWAVES) {
        const float* src = FIRST ? F.in[IN_XP] + (size_t)w * 32 * DM : F.out + O_Y + (size_t)w * 32 * DM;
        norm_rows<FIRST>(F, src, 32, w * 32, w >> 7, nw, sc_off, sh_off, wdt); }
    for (int w = gw; w < MS; w += F.G * NWAVES) {
        const float* src = FIRST ? F.in[IN_XS] + (size_t)w * DM : F.out + O_Y + (size_t)(MP + w) * DM;
        norm_rows<FIRST>(F, src, 1, MP + w, NB_P + (w >> 4), nw, sc_off, sh_off, wdt); }
}

template <int W>
__device__ __forceinline__ void pool_item(const bf16* PROJ, bf16* MIX, int row0, int nblk16, bool seq_start, const float* hist  , int c0) {
    float px[16], py[16];
#pragma unroll
    for (int i = 0; i < 16; ++i) { px[i] = 0.f; py[i] = 0.f; }
    if (hist) {
#pragma unroll
        for (int i = 0; i < 15; ++i) { const float2 h = *(const float2*)(hist + (size_t)i * DM + c0); px[i + 1] = h.x; py[i + 1] = h.y; }
    } else if (!seq_start) {
#pragma unroll
        for (int i = 0; i < 16; ++i) { const unsigned w = *(const unsigned*)(PROJ + (size_t)(row0 - 16 + i) * NPROJ + c0); px[i] = bflo(w); py[i] = bfhi(w); }
    }
    for (int blk = 0; blk < nblk16; ++blk) {
        float cx[16], cy[16];
#pragma unroll
        for (int j = 0; j < 16; ++j) { const unsigned w = *(const unsigned*)(PROJ + (size_t)(row0 + 16 * blk + j) * NPROJ + c0); cx[j] = bflo(w); cy[j] = bfhi(w); }
        float sx = 0.f, sy = 0.f;
#pragma unroll
        for (int i = 1; i < W; ++i) { sx += px[16 - i]; sy += py[16 - i]; }
        const bool first = seq_start && blk == 0;
#pragma unroll
        for (int j = 0; j < 16; ++j) {
            sx += cx[j]; sy += cy[j];
            const float inv = (first && j + 1 < W) ? 1.0f / (float)(j + 1) : 1.0f / (float)W;
            const float ox = sx * inv - cx[j], oy = sy * inv - cy[j];
            *(unsigned*)(MIX + (size_t)(row0 + 16 * blk + j) * MIXW + 1024 + c0) = pk2(ox, oy);
            const int idx = j - (W - 1);
            if (idx < 0) { sx -= px[16 + idx]; sy -= py[16 + idx]; } else { sx -= cx[idx]; sy -= cy[idx]; }
        }
#pragma unroll
        for (int i = 0; i < 16; ++i) { px[i] = cx[i]; py[i] = cy[i]; }
    }
}
__device__ __forceinline__ void p3_pool(Frame& F) {
    const bf16* PROJ = (const bf16*)(F.ws + WS_PROJ); bf16* MIX = (bf16*)(F.ws + WS_MIX);
    const int c0 = 2 * F.tid, g = F.tid >> 7;
    for (int it = blockIdx.x; it < MP / 64 + NB_S; it += F.G) {
        int row0, nb; bool st; const float* hist = nullptr;
        if (it < MP / 64) { row0 = it * 64; nb = 4; st = (row0 & (SEQ - 1)) == 0; }
        else { const int sb = it - MP / 64; row0 = MP + sb * DSEQ; nb = 1; st = false; hist = F.in[IN_CPOOL] + (size_t)sb * 15 * DM; }
        if (g == 0) pool_item<2>(PROJ, MIX, row0, nb, st, hist, c0);
        else if (g == 1) pool_item<4>(PROJ, MIX, row0, nb, st, hist, c0);
        else if (g == 2) pool_item<8>(PROJ, MIX, row0, nb, st, hist, c0);
        else pool_item<16>(PROJ, MIX, row0, nb, st, hist, c0);
    }
}
__device__ __forceinline__ void p3_conv(Frame& F) {
    const bf16* PROJ = (const bf16*)(F.ws + WS_PROJ); bf16* XB = (bf16*)(F.out + O_Y);
    const float* cw = F.in[IN_CONVW]; const float* cb = F.in[IN_CONVB];
    const int gw = F.vcu * NWAVES + F.wave, NGW = F.G * NWAVES;
    constexpr int NQ_P = (MP / 64) * 12, NQ = NQ_P + NB_S * 12;
    for (int q = gw; q < NQ; q += NGW) {
        int row0, nr, strip; bool zero_hist; const float* hist = nullptr;
        if (q < NQ_P) { const int blk = q / 12; strip = q - blk * 12; row0 = blk * 64; nr = 64; zero_hist = (row0 & (SEQ - 1)) == 0; }
        else { const int qq = q - NQ_P, sb = qq / 12; strip = qq - sb * 12; row0 = MP + sb * DSEQ; nr = DSEQ; zero_hist = false; hist = F.in[IN_CCONV] + (size_t)sb * 3 * CONVD; }
        const int c0 = strip * 128 + 2 * F.lane;
        float w0x = cw[c0], w0y = cw[c0 + 1], w1x = cw[CONVD + c0], w1y = cw[CONVD + c0 + 1], w2x = cw[2 * CONVD + c0], w2y = cw[2 * CONVD + c0 + 1], w3x = cw[3 * CONVD + c0], w3y = cw[3 * CONVD + c0 + 1];
        const float bx = cb[c0], by = cb[c0 + 1];
        float x3x = 0.f, x3y = 0.f, x2x = 0.f, x2y = 0.f, x1x = 0.f, x1y = 0.f;
        if (hist) { x3x = hist[c0]; x3y = hist[c0 + 1]; x2x = hist[CONVD + c0]; x2y = hist[CONVD + c0 + 1]; x1x = hist[2 * CONVD + c0]; x1y = hist[2 * CONVD + c0 + 1]; }
        else if (!zero_hist) { const unsigned a = *(const unsigned*)(PROJ + (size_t)(row0 - 3) * NPROJ + 2048 + c0), b = *(const unsigned*)(PROJ + (size_t)(row0 - 2) * NPROJ + 2048 + c0), c = *(const unsigned*)(PROJ + (size_t)(row0 - 1) * NPROJ + 2048 + c0);
            x3x = bflo(a); x3y = bfhi(a); x2x = bflo(b); x2y = bfhi(b); x1x = bflo(c); x1y = bfhi(c); }
#pragma unroll 8
        for (int j = 0; j < nr; ++j) {
            const unsigned w = *(const unsigned*)(PROJ + (size_t)(row0 + j) * NPROJ + 2048 + c0); const float x0x = bflo(w), x0y = bfhi(w);
            const float ox = bx + w0x * x3x + w1x * x2x + w2x * x1x + w3x * x0x, oy = by + w0y * x3y + w1y * x2y + w2y * x1y + w3y * x0y;
            *(unsigned*)(XB + (size_t)(row0 + j) * CONVD + c0) = pk2(silu_f(ox), silu_f(oy));
            x3x = x2x; x3y = x2y; x2x = x1x; x2y = x1y; x1x = x0x; x1y = x0y;
        }
    }
}

typedef short bf16x8 __attribute__((ext_vector_type(8)));
typedef short s16x4 __attribute__((ext_vector_type(4)));
__device__ __forceinline__ unsigned offb(unsigned row, unsigned ch) { return 256u * row + 16u * (ch ^ (((row & 3u) << 2) | ((row >> 2) & 3u))); }
__device__ __forceinline__ bf16x8 frag_row(LAS unsigned char* img, int lane, int rb, int s) { return *(const LAS bf16x8*)(img + offb((unsigned)((lane & 15) + 16 * rb), (unsigned)(4 * s + (lane >> 4)))); }
__device__ __forceinline__ bf16x8 frag_tr(LAS unsigned char* img, int lane, int c, int ks) {
    const unsigned g = (unsigned)lane >> 4, q = ((unsigned)lane & 15u) >> 2, p = (unsigned)lane & 3u;
    const s16x4 t0 = __builtin_amdgcn_ds_read_tr16_b64_v4i16((LAS s16x4*)(img + offb(32u * ks + 8u * g + q, 2u * c + (p >> 1)) + 8u * (p & 1u)));
    const s16x4 t1 = __builtin_amdgcn_ds_read_tr16_b64_v4i16((LAS s16x4*)(img + offb(32u * ks + 8u * g + 4u + q, 2u * c + (p >> 1)) + 8u * (p & 1u)));
    return (bf16x8){t0[0], t0[1], t0[2], t0[3], t1[0], t1[1], t1[2], t1[3]};
}
#define MFMA16(a, b, c) __builtin_amdgcn_mfma_f32_16x16x32_bf16((a), (b), (c), 0, 0, 0)
__device__ __forceinline__ void p4_ssd(Frame& F) {
    const bf16* XB = (const bf16*)(F.out + O_Y); const bf16* PROJ = (const bf16*)(F.ws + WS_PROJ); bf16* MIX = (bf16*)(F.ws + WS_MIX);
    const float* DT = (const float*)(F.ws + WS_DT); float* SSQ = (float*)(F.ws + WS_SSQ);
    LAS unsigned char* Bs = F.lds + RING_OFF; LAS unsigned char* Cs = Bs + 16384; LAS unsigned char* Hs = Bs + 32768; LAS unsigned char* Xs = Bs + 49152; LAS unsigned char* Xd = Bs + 65536; LAS unsigned char* Ms = Bs + 81920;
    LAS float* Ys = (LAS float*)(Bs + 98304);
    LAS float* accs = Ys + 64 * 68; LAS float* dts = accs + 64;
    const int tid = F.tid, lane = F.lane, w = F.wave, l15 = lane & 15, l4 = lane >> 4;
    const int xj = tid >> 3, xch = tid & 7;
    for (int it = blockIdx.x; it < NB_P * NH + NB_S * NH; it += F.G) {
        int rowbase, L, h; float* sout; f32x4 st[4];
        if (it < NB_P * NH) { const int b = it >> 4; h = it & 15; rowbase = b * SEQ; L = SEQ; sout = F.out + O_SP + (size_t)it * HD * NST;
#pragma unroll
            for (int pt = 0; pt < 4; ++pt) st[pt] = (f32x4){0.f, 0.f, 0.f, 0.f}; }
        else { const int s = it - NB_P * NH, sb = s >> 4; h = s & 15; rowbase = MP + sb * DSEQ; L = DSEQ; sout = F.out + O_SS + (size_t)s * HD * NST;
            const float* sin = F.in[IN_SSM] + (size_t)s * HD * NST;
#pragma unroll
            for (int pt = 0; pt < 4; ++pt) st[pt] = *(const f32x4*)(sin + (size_t)(16 * pt + l15) * NST + 16 * w + 4 * l4); }
        const int g = h >> 3; const float Ah = -expf(F.in[IN_ALOG][h]), dtb = F.in[IN_DTB][h], Dh = F.in[IN_DSKIP][h];
        v4u xw, bw[2], cw[2]; float dtr = 0.f;
        { const int nt0 = L < 64 ? L : 64;
          xw = (v4u){0u, 0u, 0u, 0u}; if (xj < nt0) xw = *(const v4u*)(XB + (size_t)(rowbase + xj) * CONVD + h * HD + 8 * xch);
#pragma unroll
          for (int rep = 0; rep < 2; ++rep) { const int tt = (tid >> 4) + 32 * rep; bw[rep] = (v4u){0u, 0u, 0u, 0u}; cw[rep] = (v4u){0u, 0u, 0u, 0u};
              if (tt < nt0) { const bf16* rp = XB + (size_t)(rowbase + tt) * CONVD + 1024 + g * NST + 8 * (tid & 15); bw[rep] = *(const v4u*)rp; cw[rep] = *(const v4u*)(rp + 256); } }
          if (w == 0 && lane < nt0) dtr = DT[(size_t)(rowbase + lane) * 16 + h]; }
        for (int t0 = 0; t0 < L; t0 += 64) {
            const int nt = (L - t0) < 64 ? (L - t0) : 64;
            if (w == 0) { float d = 0.f; if (lane < nt) { const float r = dtr + dtb; d = fmaxf(r, 0.f) + log1pf(expf(-fabsf(r))); }
                float c = d * Ah;
#pragma unroll
                for (int o = 1; o < 64; o <<= 1) { const float v = __shfl_up(c, o); if (lane >= o) c += v; }
                accs[lane] = c; dts[lane] = d; }
#pragma unroll
            for (int pt = 0; pt < 4; ++pt) { v2u o; o.x = pk2(st[pt].x, st[pt].y); o.y = pk2(st[pt].z, st[pt].w);
                *(LAS v2u*)(Hs + offb((unsigned)(16 * pt + l15), (unsigned)(2 * w + (lane >> 5))) + 8u * (l4 & 1)) = o; }
            __syncthreads();
            const float acs63 = accs[63];
#pragma unroll
            for (int rep = 0; rep < 2; ++rep) { const unsigned tt = (unsigned)(tid >> 4) + 32u * rep, ch = (unsigned)tid & 15u;
                *(LAS v4u*)(Bs + offb(tt, ch)) = bw[rep]; *(LAS v4u*)(Cs + offb(tt, ch)) = cw[rep]; }
            const v4u xkeep = xw;
            { const float d = dts[xj], dec = __expf(acs63 - accs[xj]);
              const float x0 = bflo(xw.x) * d, x1 = bfhi(xw.x) * d, x2 = bflo(xw.y) * d, x3 = bfhi(xw.y) * d, x4 = bflo(xw.z) * d, x5 = bfhi(xw.z) * d, x6 = bflo(xw.w) * d, x7 = bfhi(xw.w) * d;
              v4u a; a.x = pk2(x0, x1); a.y = pk2(x2, x3); a.z = pk2(x4, x5); a.w = pk2(x6, x7);
              v4u b; b.x = pk2(x0 * dec, x1 * dec); b.y = pk2(x2 * dec, x3 * dec); b.z = pk2(x4 * dec, x5 * dec); b.w = pk2(x6 * dec, x7 * dec);
              *(LAS v4u*)(Xs + offb((unsigned)xj, (unsigned)xch)) = a; *(LAS v4u*)(Xd + offb((unsigned)xj, (unsigned)xch)) = b; }
            v4u zw = (v4u){0u, 0u, 0u, 0u}; if (xj < nt) zw = *(const v4u*)(PROJ + (size_t)(rowbase + t0 + xj) * NPROJ + 1024 + h * HD + 8 * xch);
            if (t0 + 64 < L) { const int r1 = rowbase + t0 + 64;
                xw = *(const v4u*)(XB + (size_t)(r1 + xj) * CONVD + h * HD + 8 * xch);
#pragma unroll
                for (int rep = 0; rep < 2; ++rep) { const int tt = (tid >> 4) + 32 * rep; const bf16* rp = XB + (size_t)(r1 + tt) * CONVD + 1024 + g * NST + 8 * (tid & 15); bw[rep] = *(const v4u*)rp; cw[rep] = *(const v4u*)(rp + 256); }
                if (w == 0) dtr = DT[(size_t)(r1 + lane) * 16 + h]; }
            __syncthreads();
            { const int itile = w >> 1, jt0 = 2 * (w & 1);
              f32x4 g0 = (f32x4){0.f, 0.f, 0.f, 0.f}, g1 = g0;
#pragma unroll
              for (int ks = 0; ks < 4; ++ks) { const bf16x8 bC = frag_row(Cs, lane, itile, ks), a0 = frag_row(Bs, lane, jt0, ks), a1 = frag_row(Bs, lane, jt0 + 1, ks);
                  g0 = MFMA16(a0, bC, g0); g1 = MFMA16(a1, bC, g1); }
              const int i = 16 * itile + l15; const float ai = accs[i];
#pragma unroll
              for (int jj = 0; jj < 2; ++jj) { const int j0 = 16 * (jt0 + jj) + 4 * l4; const f32x4 aj = *(const LAS f32x4*)(accs + j0); const f32x4 gv = jj ? g1 : g0;
                  float m[4];
#pragma unroll
                  for (int r = 0; r < 4; ++r) m[r] = (j0 + r <= i) ? gv[r] * __expf(ai - aj[r]) : 0.f;
                  v2u o; o.x = pk2(m[0], m[1]); o.y = pk2(m[2], m[3]);
                  *(LAS v2u*)(Ms + offb((unsigned)i, (unsigned)(2 * (jt0 + jj) + (lane >> 5))) + 8u * (l4 & 1)) = o; } }
            __syncthreads();
            { const int itile = w >> 1, pt0 = 2 * (w & 1);
              f32x4 yd0 = (f32x4){0.f, 0.f, 0.f, 0.f}, yd1 = yd0, yo0 = yd0, yo1 = yd0;
#pragma unroll
              for (int ks = 0; ks < 2; ++ks) { const bf16x8 aM = frag_row(Ms, lane, itile, ks), b0 = frag_tr(Xs, lane, pt0, ks), b1 = frag_tr(Xs, lane, pt0 + 1, ks);
                  yd0 = MFMA16(aM, b0, yd0); yd1 = MFMA16(aM, b1, yd1); }
#pragma unroll
              for (int ks = 0; ks < 4; ++ks) { const bf16x8 aC = frag_row(Cs, lane, itile, ks), b0 = frag_row(Hs, lane, pt0, ks), b1 = frag_row(Hs, lane, pt0 + 1, ks);
                  yo0 = MFMA16(aC, b0, yo0); yo1 = MFMA16(aC, b1, yo1); }
              const int i0 = 16 * itile + 4 * l4; const f32x4 av = *(const LAS f32x4*)(accs + i0);
#pragma unroll
              for (int r = 0; r < 4; ++r) { const float e = __expf(av[r]);
                  Ys[(i0 + r) * 68 + 16 * pt0 + l15] = yd0[r] + e * yo0[r]; Ys[(i0 + r) * 68 + 16 * (pt0 + 1) + l15] = yd1[r] + e * yo1[r]; } }
            { const float cd = __expf(acs63);
#pragma unroll
              for (int pt = 0; pt < 4; ++pt) st[pt] = st[pt] * cd;
#pragma unroll
              for (int ks = 0; ks < 2; ++ks) { const bf16x8 aB = frag_tr(Bs, lane, w, ks);
#pragma unroll
                  for (int pt = 0; pt < 4; ++pt) { const bf16x8 bX = frag_tr(Xd, lane, pt, ks); st[pt] = MFMA16(aB, bX, st[pt]); } } }
            __syncthreads();
            if (xj < nt) { const size_t row = (size_t)(rowbase + t0 + xj);
                const f32x4 y0 = *(const LAS f32x4*)(Ys + xj * 68 + 8 * xch), y1 = *(const LAS f32x4*)(Ys + xj * 68 + 8 * xch + 4);
                const float xv[8] = {bflo(xkeep.x), bfhi(xkeep.x), bflo(xkeep.y), bfhi(xkeep.y), bflo(xkeep.z), bfhi(xkeep.z), bflo(xkeep.w), bfhi(xkeep.w)};
                const float z[8] = {bflo(zw.x), bfhi(zw.x), bflo(zw.y), bfhi(zw.y), bflo(zw.z), bfhi(zw.z), bflo(zw.w), bfhi(zw.w)};
                float o[8]; float ss = 0.f;
#pragma unroll
                for (int i = 0; i < 4; ++i) { o[i] = (y0[i] + Dh * xv[i]) * silu_f(z[i]); o[4 + i] = (y1[i] + Dh * xv[4 + i]) * silu_f(z[4 + i]); }
#pragma unroll
                for (int i = 0; i < 8; ++i) ss += o[i] * o[i];
                ss += __shfl_xor(ss, 1); ss += __shfl_xor(ss, 2); ss += __shfl_xor(ss, 4);
                if (xch == 0) SSQ[row * 16 + h] = ss;
                v4u ow; ow.x = pk2(o[0], o[1]); ow.y = pk2(o[2], o[3]); ow.z = pk2(o[4], o[5]); ow.w = pk2(o[6], o[7]);
                *(v4u*)(MIX + row * MIXW + h * HD + 8 * xch) = ow; }
        }
#pragma unroll
        for (int pt = 0; pt < 4; ++pt) *(f32x4*)(sout + (size_t)(16 * pt + l15) * NST + 16 * w + 4 * l4) = st[pt];
        __syncthreads();
    }
}
__device__ __forceinline__ void p4b_gnorm(Frame& F) {
    bf16* MIX = (bf16*)(F.ws + WS_MIX); const float* SSQ = (const float*)(F.ws + WS_SSQ);
    const int gw = F.vcu * NWAVES + F.wave, NGW = F.G * NWAVES, lane = F.lane;
    for (int row = gw; row < MT; row += NGW) {
        float s = SSQ[(size_t)row * 16 + (lane & 15)];
        s += __shfl_xor(s, 1); s += __shfl_xor(s, 2); s += __shfl_xor(s, 4);
        const float sg = __shfl(s, (lane >> 5) * 8);
        const float rs = 1.0f / sqrtf(sg * (1.f / 512.f) + EPS);
        v4u* p = (v4u*)(MIX + (size_t)row * MIXW + 1024 + 16 * lane);
#pragma unroll
        for (int q = 0; q < 2; ++q) { v4u w = p[q];
            w.x = pk2(bflo(w.x) * rs, bfhi(w.x) * rs); w.y = pk2(bflo(w.y) * rs, bfhi(w.y) * rs); w.z = pk2(bflo(w.z) * rs, bfhi(w.z) * rs); w.w = pk2(bflo(w.w) * rs, bfhi(w.w) * rs);
            p[q] = w; }
    }
}
__device__ __forceinline__ void p9_final(Frame& F) {
    const float* fw = F.in[IN_FNW]; const int gw = F.vcu * NWAVES + F.wave, NGW = F.G * NWAVES, lane = F.lane;
    f32x4 w[4];
#pragma unroll
    for (int j = 0; j < 4; ++j) w[j] = *(const f32x4*)(fw + 256 * j + 4 * lane);
    for (int row = gw; row < MT; row += NGW) {
        GAS f32x4* xr = (GAS f32x4*)(F.out + O_Y + (size_t)row * DM) + lane;
        f32x4 v[4]; float ss = 0.f;
#pragma unroll
        for (int j = 0; j < 4; ++j) { v[j] = xr[64 * j]; ss += (v[j].x * v[j].x + v[j].y * v[j].y) + (v[j].z * v[j].z + v[j].w * v[j].w); }
        const float rs = 1.0f / sqrtf(wave_sum(ss) * (1.f / DM) + EPS);
#pragma unroll
        for (int j = 0; j < 4; ++j) xr[64 * j] = v[j] * rs * w[j];
    }
}

constexpr int N_PHASES = 8;
struct Args { const float* in[27]; float* out; unsigned char* ws; int ph_lo, ph_hi; };
__global__ void __launch_bounds__(NWAVES * 64, 2) hymba_fwd(Args args) {
    extern __shared__ __attribute__((aligned(16))) unsigned char lds[];
    Frame F;
    F.lds = (LAS unsigned char*)lds;
    F.tid = threadIdx.x; F.lane = F.tid & 63; F.wave = __builtin_amdgcn_readfirstlane(F.tid >> 6);
    F.G = gridDim.x; { const int bx = blockIdx.x; F.vcu = (F.G % 8 == 0) ? (bx % 8) * (F.G / 8) + bx / 8 : bx; }
#pragma unroll
    for (int i = 0; i < 27; ++i) F.in[i] = args.in[i];
    F.out = args.out; F.ws = args.ws;
    const int lo = args.ph_lo, hi = args.ph_hi;
    for (int u = F.tid; u < (LDS_BYTES - LDSCTL_OFF) / 4; u += NWAVES * 64) ((LAS unsigned*)(F.lds + LDSCTL_OFF))[u] = 0u;
    __syncthreads();
    XcdBarrier bar; bar.bar = (unsigned*)(F.ws + WS_CTL) + CW_BAR; bar.x = 0; bar.st = nullptr;
    if (hi - lo > 1) bar = xcd_barrier_post((unsigned*)(F.ws + WS_CTL) + CW_BAR, (volatile LAS unsigned*)(F.lds + MISC_OFF) + 8);
#ifndef PHASE_MASK
#define PHASE_MASK 0xff
#endif
#define IN(k) (((PHASE_MASK >> (k)) & 1) && lo <= (k) && (k) < hi)
#define SEAM(k) do { if (IN(k) && IN((k) + 1)) { xcd_barrier(bar); } } while (0)
    bf16* Hb = (bf16*)(F.ws + WS_H); bf16* PROJ = (bf16*)(F.ws + WS_PROJ); bf16* MIX = (bf16*)(F.ws + WS_MIX); bf16* HMID = (bf16*)(F.ws + WS_HMID);
    const float* mod = (const float*)(F.ws + WS_MOD);

    if (IN(0)) { p0_mod(F); p0_weights(F); } SEAM(0);
    if (IN(1)) { p_norm<true>(F); } SEAM(1);
    if (IN(2)) {
        pg8::Gemm g{Hb, (const bf16*)(F.ws + WS_WIN), MT, NPROJ, DM}; pg8::StaticOrder S; S.init(MT, NPROJ, F.G, (int)blockIdx.x);
        pg8::EpiProj E{PROJ, F.out, O_PP, O_CP, O_PS, O_CS};
        pg8::gemm_phase<pg8::EpiProj, pg8::StaticOrder, true, true>(F.lds + RING_OFF, g, S, E);
    } SEAM(2);
    if (IN(3)) { p3_pool(F); p3_conv(F); } SEAM(3);
    if (IN(4)) { p4_ssd(F); } SEAM(4);
    if (IN(5)) {
        pg8::Gemm g{MIX, (const bf16*)(F.ws + WS_WOUT), MT, DM, MIXW}; pg8::PanelOrder S; S.init(MT, F.G, F.vcu);
        pg8::EpiResNorm<0> E{F.in[IN_XP], F.in[IN_XS], F.out + O_Y, (const float*)(F.ws + WS_BIASA), mod + 2 * DM,
                             (unsigned*)(F.ws + WS_XSL), (unsigned*)(F.ws + WS_CTL) + CW_SEAM, F.lds + LDSX_OFF,
                             Hb, (const float*)(F.ws + WS_A2), mod + 3 * DM, (const float*)(F.ws + WS_SSQ), nullptr};
        pg8::gemm_phase<pg8::EpiResNorm<0>, pg8::PanelOrder, true, true>(F.lds + RING_OFF, g, S, E);
    } SEAM(5);
    if (IN(6)) {
        pg8::Gemm g{Hb, (const bf16*)(F.ws + WS_W1), MT, DFF, DM}; pg8::StaticOrder S; S.init(MT, DFF, F.G, (int)blockIdx.x);
        pg8::EpiRelu2 E{HMID, F.in[IN_B1]};
        pg8::gemm_phase<pg8::EpiRelu2, pg8::StaticOrder, true, true>(F.lds + RING_OFF, g, S, E);
    } SEAM(6);
    if (IN(7)) {
        pg8::Gemm g{HMID, (const bf16*)(F.ws + WS_W2), MT, DM, DFF}; pg8::PanelOrder S; S.init(MT, F.G, F.vcu);
        pg8::EpiResNorm<1> E{F.out + O_Y, F.out + O_Y + (size_t)MP * DM, F.out + O_Y, F.in[IN_B2], mod + 5 * DM,
                             (unsigned*)(F.ws + WS_XSL) + (size_t)MT * 4, (unsigned*)(F.ws + WS_CTL) + CW_SEAM + SEAM_BANK, F.lds + LDSX_OFF,
                             nullptr, nullptr, nullptr, nullptr, F.in[IN_FNW]};
        pg8::gemm_phase<pg8::EpiResNorm<1>, pg8::PanelOrder, true, true>(F.lds + RING_OFF, g, S, E);
    }
#undef IN
#undef SEAM
}

#ifndef MK_ONE_LAUNCH
#define MK_ONE_LAUNCH 1
#endif
extern "C" void kernel_launch(void* const* d_in, const int* in_sizes, int n_in, void* d_out, int out_size, void* d_ws, size_t ws_size, hipStream_t stream) {
    static int grid = 0;
    if (grid == 0) {
        if (n_in != 27 || in_sizes[0] != MP * DM || (size_t)out_size != O_END || ws_size < WS_END) {
            fprintf(stderr, "kernel_launch: shape mismatch: n_in %d in0 %d out %d ws %zu (need %zu)\n", n_in, n_in > 0 ? in_sizes[0] : -1, out_size, ws_size, (size_t)WS_END); grid = -1; return; }
        int dev = 0, cus = 0, per_cu = 0;
        if (hipGetDevice(&dev) != hipSuccess || hipDeviceGetAttribute(&cus, hipDeviceAttributeMultiprocessorCount, dev) != hipSuccess) { grid = -1; return; }
        if (hipFuncSetAttribute((const void*)hymba_fwd, hipFuncAttributeMaxDynamicSharedMemorySize, LDS_BYTES) != hipSuccess) { fprintf(stderr, "kernel_launch: hipFuncSetAttribute failed\n"); grid = -1; return; }
        if (hipOccupancyMaxActiveBlocksPerMultiprocessor(&per_cu, (const void*)hymba_fwd, NWAVES * 64, LDS_BYTES) != hipSuccess || per_cu < 1) { fprintf(stderr, "kernel_launch: occupancy query says %d blocks per CU\n", per_cu); per_cu = 1; }
        (void)hipGetLastError();
        grid = cus;
        if (grid > cus * per_cu) grid = cus * per_cu;
    }
    if (grid < 0) return;
    Args a{};
    for (int i = 0; i < 27; ++i) a.in[i] = (const float*)d_in[i];
    a.out = (float*)d_out; a.ws = (unsigned char*)d_ws;
#if MK_ONE_LAUNCH
    a.ph_lo = 0; a.ph_hi = N_PHASES;
    if (hipMemsetAsync((char*)d_ws + WS_CTL, 0, CTL_ZERO_BYTES, stream) != hipSuccess) { fprintf(stderr, "kernel_launch: hipMemsetAsync failed\n"); return; }
    hipLaunchKernelGGL(hymba_fwd, dim3(grid), dim3(NWAVES * 64), LDS_BYTES, stream, a);
    { const hipError_t le = hipPeekAtLastError(); if (le != hipSuccess) fprintf(stderr, "kernel_launch: launch failed: %s (grid %d)\n", hipGetErrorName(le), grid); }
#else
    for (int p = 0; p < N_PHASES; ++p) { a.ph_lo = p; a.ph_hi = p + 1;
        hipLaunchKernelGGL(hymba_fwd, dim3(grid), dim3(NWAVES * 64), LDS_BYTES, stream, a);
        const hipError_t le = hipPeekAtLastError(); if (le != hipSuccess) { fprintf(stderr, "kernel_launch: launch %d failed: %s\n", p, hipGetErrorName(le)); break; } }
#endif
}
```

```cpp
#include <hip/hip_runtime.h>
#include <hip/hip_cooperative_groups.h>
#include <cstdio>
#include <cstdint>
namespace cg = cooperative_groups;

constexpr int DM = 1024, NB_P = 16, SEQ = 4096, NB_S = 32, DSEQ = 16;
constexpr int MP = NB_P * SEQ, MS = NB_S * DSEQ, MT = MP + MS, NBT = NB_P + NB_S;
constexpr int NPROJ = 3584, LDWIN = 3600, DFF = 4096, MIXW = 2048, CONVD = 1536, NH = 16, HD = 64, NST = 128, NMOD = 6 * DM;
constexpr float EPS = 1e-6f;
constexpr size_t O_Y = 0, O_PP = (size_t)MT * DM, O_CP = O_PP + (size_t)NB_P * 15 * DM, O_SP = O_CP + (size_t)NB_P * 3 * CONVD,
                 O_PS = O_SP + (size_t)NB_P * NH * HD * NST, O_CS = O_PS + (size_t)NB_S * 15 * DM, O_SS = O_CS + (size_t)NB_S * 3 * CONVD,
                 O_END = O_SS + (size_t)NB_S * NH * HD * NST;
namespace pg8 {
#define PG8_LAS __attribute__((address_space(3)))
typedef unsigned short bf16_t;
typedef short bf16x8 __attribute__((ext_vector_type(8)));
typedef float f32x4 __attribute__((ext_vector_type(4)));
typedef unsigned u32x4 __attribute__((ext_vector_type(4)));
constexpr int BM = 256, BK = 64, HALF = 128, HTB = HALF * BK * 2  , STAGE_BYTES = 8 * HTB, NXCD = 8, WGM = 8;

__host__ __device__ __forceinline__ int lds_byte(int r, int c) { const int st = (r >> 4) * 2 + (c >> 5), rr = r & 15, cc = c & 31, ob = rr * 64 + cc * 2; return st * 1024 + (ob ^ (((ob >> 9) & 1) << 5)); }
__host__ __device__ __forceinline__ void stage_rc(int b, int& R, int& C) { const int st = b / 1024, sb = b % 1024, swz = sb ^ (((sb >> 9) & 1) << 5); R = (st >> 1) * 16 + swz / 64; C = (st & 1) * 32 + (swz % 64) / 2; }
__host__ __device__ __forceinline__ int perm32(int rho) { const int n = rho >> 4, i = rho & 15; return 8 * (i >> 2) + 4 * n + (i & 3); }

struct Unit { int pm, pn; };
struct Gemm { const bf16_t* A; const bf16_t* Bt; int M, N, K; };

struct StaticOrder {
    int nM, nN, nwg, G, c;
    __host__ __device__ void init(int M, int N, int G_, int c_) { nM = M / BM; nN = N / BM; nwg = nM * nN; G = G_; c = c_; }
    __host__ __device__ bool next(int i, Unit& u) const {
        const long L = (long)i * G + c; if (L >= nwg) return false;
        int wgid = (int)L; { const int q = nwg / NXCD, r = nwg % NXCD, xcd = wgid % NXCD, off = wgid / NXCD; wgid = (xcd < r ? xcd * (q + 1) : r * (q + 1) + (xcd - r) * q) + off; }
        const int nig = WGM * nN, gid = wgid / nig, fm = gid * WGM, gsz = (nM - fm) < WGM ? (nM - fm) : WGM;
        u.pm = fm + ((wgid % nig) % gsz); u.pn = (wgid % nig) / gsz; return true;
    }
    __device__ __forceinline__ void a_ready(const Unit&) const {}
    __device__ __forceinline__ void done(const Unit&) const {}
};
__device__ __forceinline__ unsigned cvt_pk_bf16(float lo, float hi) { unsigned r; asm volatile("v_cvt_pk_bf16_f32 %0, %1, %2" : "=v"(r) : "v"(lo), "v"(hi)); return r; }
typedef unsigned u32x2 __attribute__((ext_vector_type(2)));
struct EpiProj {
    static constexpr bool PERM = true, AFTER_DRAIN = false, KHOOK = false; static constexpr int KH0 = -1, KH1 = -1;
    bf16_t* O; float* out;
    size_t o_pp, o_cp, o_ps, o_cs;
    __device__ __forceinline__ void operator()(const f32x4 (&acc)[2][2][4][2], const Unit& u, int wr, int wc, int fr, int fq) const {
        const int row0 = u.pm * BM + wr * 64 + fr, col0 = u.pn * BM + wc * 32 + 8 * fq;
#pragma unroll
        for (int ai = 0; ai < 2; ++ai)
#pragma unroll
            for (int m = 0; m < 4; ++m) { bf16_t* rowp = O + (size_t)(row0 + ai * HALF + m * 16) * 3584 + col0;
#pragma unroll
                for (int bj = 0; bj < 2; ++bj) { const f32x4 v0 = acc[ai][bj][m][0], v1 = acc[ai][bj][m][1];
                    u32x4 w; w.x = cvt_pk_bf16(v0[0], v0[1]); w.y = cvt_pk_bf16(v0[2], v0[3]); w.z = cvt_pk_bf16(v1[0], v1[1]); w.w = cvt_pk_bf16(v1[2], v1[3]);
                    *(u32x4*)(rowp + bj * HALF) = w; } }
        const bool is_u = u.pn < 4, is_c = u.pn >= 8;
        if (!(is_u || is_c)) return;
        if (u.pm < 256) {
            if ((u.pm & 15) != 15 || wr != 1) return;
            const int b = u.pm >> 4, lr = 240 + fr;
            if (is_u) { if (fr >= 1) { float* dst = out + o_pp + ((size_t)(b * 15 + (fr - 1)) * 1024 + col0);
#pragma unroll
                    for (int bj = 0; bj < 2; ++bj) { *(f32x4*)(dst + bj * HALF) = acc[1][bj][3][0]; *(f32x4*)(dst + bj * HALF + 4) = acc[1][bj][3][1]; } } }
            else { if (fr >= 13) { float* dst = out + o_cp + ((size_t)(b * 3 + (fr - 13)) * 1536 + (col0 - 2048));
#pragma unroll
                    for (int bj = 0; bj < 2; ++bj) { *(f32x4*)(dst + bj * HALF) = acc[1][bj][3][0]; *(f32x4*)(dst + bj * HALF + 4) = acc[1][bj][3][1]; } } }
            (void)lr;
        } else {
#pragma unroll
            for (int ai = 0; ai < 2; ++ai)
#pragma unroll
                for (int m = 0; m < 4; ++m) { const int sb = (u.pm - 256) * 16 + 8 * ai + 4 * wr + m;
                    if (is_u) { if (fr >= 1) { float* dst = out + o_ps + ((size_t)(sb * 15 + (fr - 1)) * 1024 + col0);
#pragma unroll
                            for (int bj = 0; bj < 2; ++bj) { *(f32x4*)(dst + bj * HALF) = acc[ai][bj][m][0]; *(f32x4*)(dst + bj * HALF + 4) = acc[ai][bj][m][1]; } } }
                    else { if (fr >= 13) { float* dst = out + o_cs + ((size_t)(sb * 3 + (fr - 13)) * 1536 + (col0 - 2048));
#pragma unroll
                            for (int bj = 0; bj < 2; ++bj) { *(f32x4*)(dst + bj * HALF) = acc[ai][bj][m][0]; *(f32x4*)(dst + bj * HALF + 4) = acc[ai][bj][m][1]; } } } }
        }
    }
};
struct EpiRelu2 {
    static constexpr bool PERM = true, AFTER_DRAIN = false, KHOOK = false; static constexpr int KH0 = -1, KH1 = -1;
    bf16_t* O; const float* bias;
    __device__ __forceinline__ void operator()(const f32x4 (&acc)[2][2][4][2], const Unit& u, int wr, int wc, int fr, int fq) const {
        const int row0 = u.pm * BM + wr * 64 + fr, col0 = u.pn * BM + wc * 32 + 8 * fq;
        f32x4 bv[2][2];
#pragma unroll
        for (int bj = 0; bj < 2; ++bj)
#pragma unroll
            for (int n = 0; n < 2; ++n) bv[bj][n] = *(const f32x4*)(bias + col0 + bj * HALF + 4 * n);
#pragma unroll
        for (int ai = 0; ai < 2; ++ai)
#pragma unroll
            for (int m = 0; m < 4; ++m) { bf16_t* rowp = O + (size_t)(row0 + ai * HALF + m * 16) * 4096 + col0;
#pragma unroll
                for (int bj = 0; bj < 2; ++bj) { f32x4 v0 = acc[ai][bj][m][0] + bv[bj][0], v1 = acc[ai][bj][m][1] + bv[bj][1];
#pragma unroll
                    for (int j = 0; j < 4; ++j) { const float a = fmaxf(v0[j], 0.f), b = fmaxf(v1[j], 0.f); v0[j] = a * a; v1[j] = b * b; }
                    u32x4 w; w.x = cvt_pk_bf16(v0[0], v0[1]); w.y = cvt_pk_bf16(v0[2], v0[3]); w.z = cvt_pk_bf16(v1[0], v1[1]); w.w = cvt_pk_bf16(v1[2], v1[3]);
                    *(u32x4*)(rowp + bj * HALF) = w; } }
    }
};
struct EpiRes {
    static constexpr bool PERM = false, AFTER_DRAIN = false, KHOOK = false; static constexpr int KH0 = -1, KH1 = -1;
    const float* baseP; const float* baseS;
    float* out;
    const float* bias;
    const float* gate;
    __device__ __forceinline__ void operator()(const f32x4 (&acc)[2][2][4][2], const Unit& u, int wr, int wc, int fr, int fq) const {
        const bool smp = u.pm >= 256;
        const float* bp = smp ? baseS + (size_t)(u.pm - 256) * BM * 1024 : baseP + (size_t)u.pm * BM * 1024;
        float* op = out + (size_t)u.pm * BM * 1024;
        const int col0 = u.pn * BM + wc * 32 + 4 * fq;
        f32x4 bv[2][2];
#pragma unroll
        for (int bj = 0; bj < 2; ++bj)
#pragma unroll
            for (int n = 0; n < 2; ++n) bv[bj][n] = *(const f32x4*)(bias + col0 + bj * HALF + n * 16);
#pragma unroll
        for (int ai = 0; ai < 2; ++ai)
#pragma unroll
            for (int m = 0; m < 4; ++m) { const int lr = ai * HALF + wr * 64 + m * 16 + fr;
                const int b = smp ? 16 + (u.pm - 256) * 16 + (lr >> 4) : (u.pm >> 4);
                const float* gp = gate + (size_t)b * 6144 + col0; const size_t off = (size_t)lr * 1024 + col0;
#pragma unroll
                for (int bj = 0; bj < 2; ++bj)
#pragma unroll
                    for (int n = 0; n < 2; ++n) { const f32x4 g = *(const f32x4*)(gp + bj * HALF + n * 16), x = *(const f32x4*)(bp + off + bj * HALF + n * 16);
                        *(f32x4*)(op + off + bj * HALF + n * 16) = x + g * (acc[ai][bj][m][n] + bv[bj][n]); }
                asm volatile("" ::: "memory"); }
    }
};


struct PanelOrder {
    int nunits, G, v;
    __host__ __device__ void init(int M, int G_, int v_) { nunits = (M / BM) * 4; G = G_; v = v_; }
    __host__ __device__ bool next(int i, Unit& u) const { const int L = i * G + v; if (L >= nunits) return false; u.pm = L >> 2; u.pn = L & 3; return true; }
    __device__ __forceinline__ void a_ready(const Unit&) const {}
    __device__ __forceinline__ void done(const Unit&) const {}
};
template <int MODE> struct EpiResNorm {
    static constexpr bool PERM = false, AFTER_DRAIN = false, KHOOK = (MODE == 0); static constexpr int KH0 = 8, KH1 = 16;
    const float* baseP; const float* baseS; float* out; const float* bias; const float* gate;
    unsigned* xslots;
    unsigned* cnt;
    PG8_LAS unsigned char* ldsx;
    bf16_t* H; const float* A2; const float* sh2;
    const float* ssq;
    const float* fw;
    __device__ __forceinline__ void prep(const Unit& u) const {
        int tid = threadIdx.x; asm volatile("" : "+v"(tid));
        if (tid < 256) { const f32x4* p = (const f32x4*)(ssq + (size_t)(u.pm * BM + tid) * 16); const f32x4 a = p[0], b = p[1], c = p[2], d = p[3];
            const float s0 = ((a.x + a.y) + (a.z + a.w)) + ((b.x + b.y) + (b.z + b.w)), s1 = ((c.x + c.y) + (c.z + c.w)) + ((d.x + d.y) + (d.z + d.w));
            const float r0 = 1.0f / sqrtf(s0 * (1.f / 512.f) + 1e-6f), r1 = 1.0f / sqrtf(s1 * (1.f / 512.f) + 1e-6f);
            PG8_LAS float* t = (PG8_LAS float*)ldsx; t[tid] = r0 / r1; t[256 + tid] = r1; }
    }
    __device__ __forceinline__ void khook(f32x4 (&acc)[2][2][4][2], int t, int wr, int fr_) const {
        int fr = fr_; asm volatile("" : "+v"(fr));
        const PG8_LAS float* tb = (const PG8_LAS float*)ldsx + (t == KH0 ? 0 : 256);
#pragma unroll
        for (int ai = 0; ai < 2; ++ai)
#pragma unroll
            for (int m = 0; m < 4; ++m) { const float f = tb[ai * HALF + wr * 64 + m * 16 + fr];
#pragma unroll
                for (int bj = 0; bj < 2; ++bj)
#pragma unroll
                    for (int n = 0; n < 2; ++n) acc[ai][bj][m][n] = acc[ai][bj][m][n] * f; }
    }
    __device__ __forceinline__ void operator()(f32x4 (&acc)[2][2][4][2], const Unit& u, int wr, int wc, int fr_, int fq_) const {
        int tid = threadIdx.x, fr = fr_, fq = fq_;
        asm volatile("" : "+v"(tid), "+v"(fr), "+v"(fq));
        const int lane = tid & 63, wid = __builtin_amdgcn_readfirstlane(tid >> 6);
        const bool smp = u.pm >= 256;
        const float* bp = smp ? baseS + (size_t)(u.pm - 256) * BM * 1024 : baseP + (size_t)u.pm * BM * 1024;
        float* op = out + (size_t)u.pm * BM * 1024;
        const int col0 = u.pn * BM + wc * 32 + 4 * fq;
        PG8_LAS float* P = (PG8_LAS float*)(ldsx + 2048); PG8_LAS float* S = (PG8_LAS float*)(ldsx + 6144);
#pragma unroll
        for (int bj = 0; bj < 2; ++bj)
#pragma unroll
            for (int n = 0; n < 2; ++n) { const f32x4 bv = *(const f32x4*)(bias + col0 + bj * HALF + n * 16);
#pragma unroll
                for (int ai = 0; ai < 2; ++ai)
#pragma unroll
                    for (int m = 0; m < 4; ++m) acc[ai][bj][m][n] += bv; }
#pragma unroll
        for (int ai = 0; ai < 2; ++ai)
#pragma unroll
            for (int m = 0; m < 4; ++m) { const int lr = ai * HALF + wr * 64 + m * 16 + fr;
                const int b = smp ? 16 + (u.pm - 256) * 16 + (lr >> 4) : (u.pm >> 4);
                const float* gp = gate + (size_t)b * 6144 + col0; const size_t off = (size_t)lr * 1024 + col0; float s = 0.f;
#pragma unroll
                for (int bj = 0; bj < 2; ++bj)
#pragma unroll
                    for (int n = 0; n < 2; ++n) { const f32x4 g = *(const f32x4*)(gp + bj * HALF + n * 16), x = *(const f32x4*)(bp + off + bj * HALF + n * 16);
                        const f32x4 v = x + g * acc[ai][bj][m][n]; acc[ai][bj][m][n] = v; s += (v.x * v.x + v.y * v.y) + (v.z * v.z + v.w * v.w); }
                s += __shfl_xor(s, 16); s += __shfl_xor(s, 32);
                if (fq == 0) P[lr * 4 + wc] = s;
                asm volatile("" : "+v"(acc[ai][0][m][0]), "+v"(acc[ai][0][m][1]), "+v"(acc[ai][1][m][0]), "+v"(acc[ai][1][m][1]));
                asm volatile("" ::: "memory"); }
        asm volatile("s_waitcnt lgkmcnt(0)" ::: "memory"); __builtin_amdgcn_s_barrier(); asm volatile("" ::: "memory");
        if (tid < 256) { const f32x4 p4 = *(const PG8_LAS f32x4*)(P + tid * 4); const float t = (p4.x + p4.y) + (p4.z + p4.w);
            __hip_atomic_store(xslots + ((size_t)(u.pm * BM + tid) * 4 + u.pn), __float_as_uint(t), __ATOMIC_RELAXED, __HIP_MEMORY_SCOPE_AGENT); }
        asm volatile("s_waitcnt vmcnt(0)" ::: "memory");
        if (wid < 4 && lane == 0) __hip_atomic_fetch_add(cnt + 64 * u.pm, 1u, __ATOMIC_RELAXED, __HIP_MEMORY_SCOPE_AGENT);
        if (wid == 0) { unsigned sp = 0;
            while ((unsigned)__builtin_amdgcn_readfirstlane(__hip_atomic_load(cnt + 64 * u.pm, __ATOMIC_RELAXED, __HIP_MEMORY_SCOPE_AGENT)) < 16u) { __builtin_amdgcn_s_sleep(2); if (++sp > (1u << 22)) break; }
            __builtin_amdgcn_fence(__ATOMIC_ACQUIRE, "agent"); }
        asm volatile("s_waitcnt vmcnt(0) lgkmcnt(0)" ::: "memory"); __builtin_amdgcn_s_barrier(); asm volatile("" ::: "memory");
        if (tid < 256) { const unsigned* sl = xslots + (size_t)(u.pm * BM + tid) * 4; float t = 0.f;
#pragma unroll
            for (int q = 0; q < 4; ++q) t += __uint_as_float(__hip_atomic_load(sl + q, __ATOMIC_RELAXED, __HIP_MEMORY_SCOPE_AGENT));
            S[tid] = 1.0f / sqrtf(t * (1.f / 1024.f) + 1e-6f); }
        asm volatile("s_waitcnt lgkmcnt(0)" ::: "memory"); __builtin_amdgcn_s_barrier(); asm volatile("" ::: "memory");
#pragma unroll
        for (int ai = 0; ai < 2; ++ai)
#pragma unroll
            for (int m = 0; m < 4; ++m) { const int lr = ai * HALF + wr * 64 + m * 16 + fr; const float rs = S[lr]; const size_t off = (size_t)lr * 1024 + col0;
                if constexpr (MODE == 0) {
                    const int b = smp ? 16 + (u.pm - 256) * 16 + (lr >> 4) : (u.pm >> 4);
                    const float* ap = A2 + (size_t)b * 1024 + col0; const float* sp = sh2 + (size_t)b * 6144 + col0; bf16_t* hp = H + (size_t)(u.pm * BM + lr) * 1024 + col0;
#pragma unroll
                    for (int bj = 0; bj < 2; ++bj)
#pragma unroll
                        for (int n = 0; n < 2; ++n) { const f32x4 v = acc[ai][bj][m][n]; *(f32x4*)(op + off + bj * HALF + n * 16) = v;
                            const f32x4 hv = v * rs * *(const f32x4*)(ap + bj * HALF + n * 16) + *(const f32x4*)(sp + bj * HALF + n * 16);
                            u32x2 w; w.x = cvt_pk_bf16(hv.x, hv.y); w.y = cvt_pk_bf16(hv.z, hv.w); *(u32x2*)(hp + bj * HALF + n * 16) = w; }
                } else {
#pragma unroll
                    for (int bj = 0; bj < 2; ++bj)
#pragma unroll
                        for (int n = 0; n < 2; ++n) *(f32x4*)(op + off + bj * HALF + n * 16) = acc[ai][bj][m][n] * rs * *(const f32x4*)(fw + col0 + bj * HALF + n * 16);
                }
                asm volatile("" ::: "memory"); }
    }
};
template <class Epi, class Sched, bool ALIGN_EPI = false, bool SP2 = false>
__device__ __forceinline__ void gemm_phase(PG8_LAS unsigned char* lds, const Gemm g, const Sched& S, const Epi& E) {
    const int tid = threadIdx.x, wid = __builtin_amdgcn_readfirstlane(tid >> 6), lane = tid & 63, wr = wid >> 2, wc = wid & 3, fr = lane & 15, fq = lane >> 4;
    const int K = g.K, nt = K / BK;
    unsigned voffA[2], voffB[2];
#pragma unroll
    for (int i = 0; i < 2; ++i) { int R, C; stage_rc(tid * 16 + i * 8192, R, C); const int Rb = Epi::PERM ? ((R & ~31) + perm32(R & 31)) : R;
        voffA[i] = (unsigned)(R * K + C) * 2u; voffB[i] = (unsigned)(Rb * K + C) * 2u; }
    const size_t kstep = (size_t)(BK * 2);
    const size_t hstep = (size_t)HALF * K * 2;
    const size_t tstep = 2 * hstep;
    const unsigned ldsw = (unsigned)wid * 1024u;
    const int aoff = lds_byte(wr * 64 + fr, fq * 8), boff = lds_byte(wc * 32 + fr, fq * 8);
#define PG8_SA(b, h) (((b) * 2 + (h)) * HTB)
#define PG8_SB(b, h) ((4 + (b) * 2 + (h)) * HTB)
#define PG8_STAGE(bufoff, gbase, voff) do { _Pragma("unroll") for (int _i = 0; _i < 2; ++_i) \
        __builtin_amdgcn_global_load_lds((const unsigned*)((const char*)(gbase) + (voff)[_i]), (PG8_LAS unsigned*)(lds + (bufoff) + ldsw + _i * 8192), 16, 0, 0); } while (0)
#define PG8_LDA(dst, b, h) do { _Pragma("unroll") for (int m = 0; m < 4; ++m) _Pragma("unroll") for (int k = 0; k < 2; ++k) dst[m][k] = *(const PG8_LAS bf16x8*)(lds + PG8_SA(b, h) + aoff + m * 2048 + k * 1024); } while (0)
#define PG8_LDB(dst, b, h) do { _Pragma("unroll") for (int n = 0; n < 2; ++n) _Pragma("unroll") for (int k = 0; k < 2; ++k) dst[n][k] = *(const PG8_LAS bf16x8*)(lds + PG8_SB(b, h) + boff + n * 2048 + k * 1024); } while (0)
#define PG8_MMA(ai, bj, At, Bt) do { __builtin_amdgcn_s_setprio(1); _Pragma("unroll") for (int m = 0; m < 4; ++m) _Pragma("unroll") for (int n = 0; n < 2; ++n) _Pragma("unroll") for (int k = 0; k < 2; ++k) \
        acc[ai][bj][m][n] = __builtin_amdgcn_mfma_f32_16x16x32_bf16(Bt[n][k], At[m][k], acc[ai][bj][m][n], 0, 0, 0); __builtin_amdgcn_s_setprio(0); } while (0)
#define PG8_WAIT_V(n) asm volatile("s_waitcnt vmcnt(" #n ")" ::: "memory")
#define PG8_WAIT_L(n) asm volatile("s_waitcnt lgkmcnt(" #n ")" ::: "memory")
#define PG8_BAR __builtin_amdgcn_s_barrier()
#define PG8_SCHED __builtin_amdgcn_sched_barrier(0)
    Unit cur, nxt; int ui = 0;
    if (!S.next(0, cur)) return;
    f32x4 acc[2][2][4][2];
#pragma unroll
    for (int a = 0; a < 2; ++a)
#pragma unroll
        for (int b = 0; b < 2; ++b)
#pragma unroll
            for (int m = 0; m < 4; ++m)
#pragma unroll
                for (int n = 0; n < 2; ++n) acc[a][b][m][n] = (f32x4){0.f, 0.f, 0.f, 0.f};
    bf16x8 At[4][2], B0[2][2], B1[2][2];
    const char* cA = (const char*)g.A + (size_t)cur.pm * tstep; const char* cB = (const char*)g.Bt + (size_t)cur.pn * tstep;
    S.a_ready(cur);
    if constexpr (Epi::KHOOK) E.prep(cur);
    if constexpr (SP2) {
        PG8_STAGE(PG8_SB(0, 0), cB, voffB); PG8_STAGE(PG8_SB(0, 1), cB + hstep, voffB); PG8_STAGE(PG8_SA(0, 0), cA, voffA); PG8_STAGE(PG8_SA(0, 1), cA + hstep, voffA);
        if (wr == 1) PG8_BAR;
        PG8_WAIT_V(2); PG8_BAR;
        PG8_STAGE(PG8_SB(1, 0), cB + kstep, voffB); PG8_STAGE(PG8_SA(1, 0), cA + kstep, voffA); PG8_STAGE(PG8_SB(1, 1), cB + hstep + kstep, voffB);
        PG8_WAIT_V(6); PG8_BAR;
    } else {
        PG8_STAGE(PG8_SB(0, 0), cB, voffB); PG8_STAGE(PG8_SA(0, 0), cA, voffA); PG8_STAGE(PG8_SB(0, 1), cB + hstep, voffB); PG8_STAGE(PG8_SA(0, 1), cA + hstep, voffA);
        if (wr == 1) PG8_BAR;
        PG8_WAIT_V(4); PG8_BAR;
        PG8_STAGE(PG8_SB(1, 0), cB + kstep, voffB); PG8_STAGE(PG8_SA(1, 0), cA + kstep, voffA); PG8_STAGE(PG8_SB(1, 1), cB + hstep + kstep, voffB);
        PG8_WAIT_V(6); PG8_BAR;
    }
    for (;;) {
        const bool has_next = S.next(ui + 1, nxt);
        const char* nA = has_next ? (const char*)g.A + (size_t)nxt.pm * tstep : cA; const char* nB = has_next ? (const char*)g.Bt + (size_t)nxt.pn * tstep : cB;
        for (int t = 0; t < nt; t += 2) {
            const bool last = (t == nt - 2);
            const char* a1 = cA + (size_t)(t + 1) * kstep;
            const char* a2 = last ? nA : cA + (size_t)(t + 2) * kstep; const char* b2 = last ? nB : cB + (size_t)(t + 2) * kstep;
            const char* a3 = a2 + kstep; const char* b3 = b2 + kstep;
            if (last && has_next) S.a_ready(nxt);
            if constexpr (Epi::KHOOK) { if (t == Epi::KH0 || t == Epi::KH1) E.khook(acc, t, wr, fr); }
            if constexpr (SP2) {
            PG8_LDB(B0, 0, 0); PG8_LDB(B1, 0, 1); PG8_SCHED; PG8_LDA(At, 0, 0); PG8_STAGE(PG8_SA(1, 1), a1 + hstep, voffA);
            PG8_WAIT_V(8); PG8_WAIT_L(0); PG8_BAR; PG8_MMA(0, 0, At, B0); PG8_MMA(0, 1, At, B1); PG8_BAR; PG8_SCHED;
            PG8_LDA(At, 0, 1); PG8_STAGE(PG8_SB(0, 0), b2, voffB); PG8_STAGE(PG8_SB(0, 1), b2 + hstep, voffB); PG8_STAGE(PG8_SA(0, 0), a2, voffA);
            PG8_WAIT_V(8); PG8_WAIT_L(0); PG8_BAR; PG8_MMA(1, 0, At, B0); PG8_MMA(1, 1, At, B1); PG8_BAR; PG8_SCHED;
            PG8_LDB(B0, 1, 0); PG8_LDB(B1, 1, 1); PG8_SCHED; PG8_LDA(At, 1, 0); PG8_STAGE(PG8_SA(0, 1), a2 + hstep, voffA);
            PG8_WAIT_V(8); PG8_WAIT_L(0); PG8_BAR; PG8_MMA(0, 0, At, B0); PG8_MMA(0, 1, At, B1); PG8_BAR; PG8_SCHED;
            PG8_LDA(At, 1, 1); PG8_STAGE(PG8_SB(1, 0), b3, voffB); PG8_STAGE(PG8_SB(1, 1), b3 + hstep, voffB); PG8_STAGE(PG8_SA(1, 0), a3, voffA);
            PG8_WAIT_V(8); PG8_WAIT_L(0); PG8_BAR; PG8_MMA(1, 0, At, B0); PG8_MMA(1, 1, At, B1); PG8_BAR; PG8_SCHED;
            } else {
            PG8_LDB(B0, 0, 0); PG8_SCHED; PG8_LDA(At, 0, 0); PG8_STAGE(PG8_SA(1, 1), a1 + hstep, voffA);
            PG8_WAIT_L(8); PG8_BAR; PG8_WAIT_L(0); PG8_MMA(0, 0, At, B0); PG8_BAR; PG8_SCHED;
            PG8_LDB(B1, 0, 1); PG8_STAGE(PG8_SB(0, 0), b2, voffB);
            PG8_BAR; PG8_WAIT_L(0); PG8_MMA(0, 1, At, B1); PG8_BAR;
            PG8_LDA(At, 0, 1); PG8_STAGE(PG8_SA(0, 0), a2, voffA);
            PG8_BAR; PG8_WAIT_L(0); PG8_MMA(1, 0, At, B0); PG8_BAR; PG8_SCHED;
            PG8_STAGE(PG8_SB(0, 1), b2 + hstep, voffB);
            PG8_WAIT_V(6); PG8_BAR; PG8_MMA(1, 1, At, B1); PG8_BAR;
            PG8_LDB(B0, 1, 0); PG8_SCHED; PG8_LDA(At, 1, 0); PG8_STAGE(PG8_SA(0, 1), a2 + hstep, voffA);
            PG8_WAIT_L(8); PG8_BAR; PG8_WAIT_L(0); PG8_MMA(0, 0, At, B0); PG8_BAR; PG8_SCHED;
            PG8_LDB(B1, 1, 1); PG8_STAGE(PG8_SB(1, 0), b3, voffB);
            PG8_BAR; PG8_WAIT_L(0); PG8_MMA(0, 1, At, B1); PG8_BAR;
            PG8_LDA(At, 1, 1); PG8_STAGE(PG8_SA(1, 0), a3, voffA);
            PG8_BAR; PG8_WAIT_L(0); PG8_MMA(1, 0, At, B0); PG8_BAR; PG8_SCHED;
            PG8_STAGE(PG8_SB(1, 1), b3 + hstep, voffB);
            PG8_WAIT_V(6); PG8_BAR; PG8_MMA(1, 1, At, B1); PG8_BAR;
            }
        }
        if constexpr (ALIGN_EPI) { if (wr == 0) PG8_BAR; }
        if constexpr (!Epi::AFTER_DRAIN) { E(acc, cur, wr, wc, fr, fq); S.done(cur); }
        if constexpr (Epi::KHOOK) { if (has_next) E.prep(nxt); }
        if (!has_next) break;
#pragma unroll
        for (int a = 0; a < 2; ++a)
#pragma unroll
            for (int b = 0; b < 2; ++b)
#pragma unroll
                for (int m = 0; m < 4; ++m)
#pragma unroll
                    for (int n = 0; n < 2; ++n) acc[a][b][m][n] = (f32x4){0.f, 0.f, 0.f, 0.f};
        cur = nxt; cA = nA; cB = nB; ++ui;
        if constexpr (ALIGN_EPI) { if (wr == 1) PG8_BAR; }
    }
    PG8_WAIT_V(0);
    if constexpr (!ALIGN_EPI) { if (wr == 0) PG8_BAR; }
    PG8_BAR;
    if constexpr (Epi::AFTER_DRAIN) { E.fused(acc, cur, wr, wc, fr, fq, lds, wid, lane); S.done(cur); }
#undef PG8_SA
#undef PG8_SB
#undef PG8_STAGE
#undef PG8_LDA
#undef PG8_LDB
#undef PG8_MMA
#undef PG8_WAIT_V
#undef PG8_WAIT_L
#undef PG8_BAR
#undef PG8_SCHED
}
}
constexpr size_t MiB = 1u << 20;
constexpr size_t WS_CTL = 0, CTL_ZERO_BYTES = 1 * MiB;
constexpr size_t WS_MOD = 1 * MiB;
constexpr size_t WS_BIASA = 2 * MiB + 512 * 1024;
constexpr size_t WS_A2 = 2 * MiB + 640 * 1024;
constexpr size_t WS_XSL = 30 * MiB;
constexpr size_t WS_WIN = 3 * MiB, WS_WOUT = 10 * MiB, WS_W1 = 14 * MiB, WS_W2 = 22 * MiB;
constexpr size_t WS_H = 32 * MiB;
constexpr size_t WS_PROJ = 161 * MiB;
constexpr size_t WS_DT = 613 * MiB;
constexpr size_t WS_MIX = 618 * MiB;
constexpr size_t WS_SSQ = 876 * MiB;
constexpr size_t WS_HMID = 161 * MiB;
constexpr size_t WS_END = 882 * MiB;
static_assert(WS_H + (size_t)MT * DM * 2 <= WS_PROJ && WS_PROJ + (size_t)MT * NPROJ * 2 <= WS_DT && WS_DT + (size_t)MT * 16 * 4 <= WS_MIX && WS_MIX + (size_t)MT * MIXW * 2 <= WS_SSQ
              && WS_SSQ + (size_t)MT * 16 * 4 <= WS_END && WS_HMID + (size_t)MT * DFF * 2 <= WS_SSQ && WS_MOD + (size_t)NBT * NMOD * 4 <= WS_BIASA && WS_W2 + (size_t)DM * DFF * 2 <= WS_H, "d_ws map");

constexpr int NWAVES = 8;
constexpr int RING_OFF = 0, RING_BYTES = 131072;
constexpr int LDS_BYTES = 147456;

#define GAS __attribute__((address_space(1)))
#define LAS __attribute__((address_space(3)))
typedef unsigned short bf16;
typedef unsigned v4u __attribute__((ext_vector_type(4)));
typedef unsigned v2u __attribute__((ext_vector_type(2)));
typedef float f32x4 __attribute__((ext_vector_type(4)));
#define LDS_WAIT() asm volatile("s_waitcnt lgkmcnt(0)" ::: "memory")
__device__ __forceinline__ unsigned f2bf(float f) { unsigned u = __builtin_bit_cast(unsigned, f); return (u + 0x7fffu + ((u >> 16) & 1u)) >> 16; }
__device__ __forceinline__ unsigned pk2(float lo, float hi) { return f2bf(lo) | (f2bf(hi) << 16); }
__device__ __forceinline__ float bflo(unsigned w) { return __builtin_bit_cast(float, w << 16); }
__device__ __forceinline__ float bfhi(unsigned w) { return __builtin_bit_cast(float, w & 0xffff0000u); }
__device__ __forceinline__ float wave_sum(float v) {
#pragma unroll
    for (int o = 1; o < 64; o <<= 1) v += __shfl_xor(v, o);
    return v;
}
__device__ __forceinline__ float silu_f(float x) { return x / (1.f + __expf(-x)); }

typedef GAS unsigned gu32;
typedef GAS unsigned long long gu64;
#define RLX_AGENT __ATOMIC_RELAXED, __HIP_MEMORY_SCOPE_AGENT
constexpr int CW_TMO = 0, CW_CODE = 1, CW_BAR = 4096, CW_SEAM = 16384, SEAM_BANK = 320 * 64;
constexpr int LDSX_OFF = RING_BYTES + 512;
constexpr int LDSCTL_OFF = RING_BYTES, MISC_OFF = LDSCTL_OFF + 320;
#define XB_TMO      128
#define XB_XCNT(j)  (256  + 64 * (j))
#define XB_XSUB(j)  (1280 + 64 * (j))
#define XB_XGEN(j)  (2304 + 64 * (j))
#define XB_TOP      3328
#define XB_TOPGEN   3392
#define XCD_BAR_WORDS 3456
#define XB_SPIN_CAP (1u << 18)

__device__ __forceinline__ unsigned xb_ld(unsigned* p)              { return __hip_atomic_load(p, __ATOMIC_RELAXED, __HIP_MEMORY_SCOPE_AGENT); }
__device__ __forceinline__ unsigned xb_add(unsigned* p, unsigned v) { return __hip_atomic_fetch_add(p, v, __ATOMIC_RELAXED, __HIP_MEMORY_SCOPE_AGENT); }
__device__ __forceinline__ unsigned xb_xcc_id() { return (unsigned)__builtin_amdgcn_s_getreg((3 << 11) | 20) & 0xFu; }
#define XB_SPIN(cond, bar) do { unsigned _sp = 0; while (cond) { __builtin_amdgcn_s_sleep(1); \
    if ((++_sp & 255u) == 0u) { if (xb_ld(&(bar)[XB_TMO])) break; if (_sp > XB_SPIN_CAP) { atomicAdd(&(bar)[XB_TMO], 1u); break; } } } } while (0)

struct XcdBarrier {
    unsigned* bar; unsigned x;
    volatile LAS unsigned* st;
};

__device__ __forceinline__ XcdBarrier xcd_barrier_post(unsigned* bar, volatile LAS unsigned* st) {
    XcdBarrier b; b.bar = bar; b.x = xb_xcc_id(); b.st = st;
    if (threadIdx.x == 0) (void)xb_add(&bar[XB_XCNT(b.x)], 1u);
    return b;
}
__device__ __forceinline__ void xcd_barrier_complete(unsigned* bar, unsigned x, unsigned& nloc, unsigned& nx) {
    const unsigned G = gridDim.x * gridDim.y * gridDim.z;
    unsigned sum, cnt, mine, sp = 0u;
    for (;;) {
        sum = 0u; cnt = 0u; mine = 0u;
#pragma unroll
        for (unsigned j = 0; j < 16; ++j) { const unsigned c = xb_ld(&bar[XB_XCNT(j)]); sum += c; cnt += (c > 0u) ? 1u : 0u; mine = (j == x) ? c : mine; }
        if (sum == G) break;
        __builtin_amdgcn_s_sleep(1);
        if ((++sp & 255u) == 0u) { if (xb_ld(&bar[XB_TMO])) break; if (sp > XB_SPIN_CAP) { atomicAdd(&bar[XB_TMO], 1u); break; } }
    }
    nloc = mine > 0u ? mine : 1u; nx = cnt > 0u ? cnt : 1u;
}

__device__ __forceinline__ void xcd_barrier(const XcdBarrier& b) {
    asm volatile("s_waitcnt vmcnt(0)" ::: "memory");
    __syncthreads();
    if (threadIdx.x == 0) {
        unsigned* bar = b.bar;
        __builtin_amdgcn_s_waitcnt(0);
        unsigned nloc = b.st[0], nx = b.st[1];
        if (nloc == 0u) { xcd_barrier_complete(bar, b.x, nloc, nx); b.st[0] = nloc; b.st[1] = nx; }
        const unsigned old = xb_add(&bar[XB_XSUB(b.x)], 1u);
        const unsigned gen = old / nloc;
        if (old + 1u == (gen + 1u) * nloc) {
            __builtin_amdgcn_fence(__ATOMIC_RELEASE, "agent");
            asm volatile("s_waitcnt vmcnt(0)" ::: "memory");
            const unsigned og = xb_add(&bar[XB_TOP], 1u);
            const unsigned tg = og / nx;
            if (og + 1u == (tg + 1u) * nx) xb_add(&bar[XB_TOPGEN], 1u);
            else XB_SPIN(xb_ld(&bar[XB_TOPGEN]) == tg, bar);
            __builtin_amdgcn_fence(__ATOMIC_ACQUIRE, "agent");
            xb_add(&bar[XB_XGEN(b.x)], 1u);
            asm volatile("s_waitcnt vmcnt(0)" ::: "memory");
        } else {
            XB_SPIN(xb_ld(&bar[XB_XGEN(b.x)]) == gen, bar);
            __builtin_amdgcn_fence(__ATOMIC_ACQUIRE, "agent");
            asm volatile("s_waitcnt vmcnt(0)" ::: "memory");
        }
    }
    __syncthreads();
}

struct Frame {
    LAS unsigned char* lds;
    int tid, lane, wave, vcu, G;
    const float* in[27]; float* out; unsigned char* ws;
};
#define IN_XP 0
#define IN_XS 1
#define IN_CPOOL 2
#define IN_CCONV 3
#define IN_SSM 4
#define IN_CP 5
#define IN_CS 6
#define IN_NW1 7
#define IN_NW2 8
#define IN_WADA 9
#define IN_BADA 10
#define IN_WIN 11
#define IN_POOLW 12
#define IN_POOLB 13
#define IN_POOLS 14
#define IN_CONVW 15
#define IN_CONVB 16
#define IN_DTB 17
#define IN_ALOG 18
#define IN_DSKIP 19
#define IN_SNW 20
#define IN_WOUT 21
#define IN_W1 22
#define IN_B1 23
#define IN_W2 24
#define IN_B2 25
#define IN_FNW 26

__device__ __forceinline__ void p0_mod(Frame& F) {
    const float* w_ada = F.in[IN_WADA]; const float* b_ada = F.in[IN_BADA]; float* mod = (float*)(F.ws + WS_MOD);
    LAS float* red = (LAS float*)(F.lds + RING_OFF);
    const int lane = F.lane, li = lane & 15, kq = lane >> 4;
    for (int ct = blockIdx.x; ct < NMOD / 16; ct += F.G) {
        f32x4 acc[3];
#pragma unroll
        for (int mt = 0; mt < 3; ++mt) acc[mt] = (f32x4){0.f, 0.f, 0.f, 0.f};
        const int k0 = F.wave * 128, col = ct * 16 + li;
        const float* cp[3]; cp[0] = F.in[IN_CP] + (size_t)li * DM; cp[1] = F.in[IN_CS] + (size_t)li * DM; cp[2] = F.in[IN_CS] + (size_t)(16 + li) * DM;
#pragma unroll 8
        for (int s = 0; s < 32; ++s) { const int k = k0 + 4 * s + kq; const float bval = w_ada[(size_t)k * NMOD + col];
#pragma unroll
            for (int mt = 0; mt < 3; ++mt) { const float a = silu_f(cp[mt][k]); acc[mt] = __builtin_amdgcn_mfma_f32_16x16x4f32(a, bval, acc[mt], 0, 0, 0); } }
#pragma unroll
        for (int mt = 0; mt < 3; ++mt)
#pragma unroll
            for (int r = 0; r < 4; ++r) red[((F.wave * 3 + mt) * 4 + r) * 64 + lane] = acc[mt][r];
        __syncthreads();
        for (int e = F.tid; e < 768; e += NWAVES * 64) { const int mt = e >> 8, r = (e >> 6) & 3, ln = e & 63; float s = 0.f;
#pragma unroll
            for (int w = 0; w < 8; ++w) s += red[((w * 3 + mt) * 4 + r) * 64 + ln];
            const int batch = 16 * mt + 4 * (ln >> 4) + r, c = ct * 16 + (ln & 15);
            mod[(size_t)batch * NMOD + c] = s + b_ada[c]; }
        __syncthreads();
    }
}
__device__ __forceinline__ void p0_transpose_item(const float* W, int ldw, int nblk, bf16* WT, int ldt, int kofs, const float* kscale, LAS float* scr, int item, int lane) {
    const int kb = item / nblk, nb = item % nblk, k0 = 64 * kb, n0 = 32 * nb;
#pragma unroll 8
    for (int i = 0; i < 32; ++i) { const int kk = 2 * i + (lane >> 5); float v = W[(size_t)(k0 + kk) * ldw + n0 + (lane & 31)]; if (kscale) v *= kscale[k0 + kk]; scr[kk * 33 + (lane & 31)] = v; }
    LDS_WAIT(); asm volatile("" ::: "memory");
    const int c = lane & 7;
#pragma unroll
    for (int j = 0; j < 4; ++j) { const int n = (lane >> 3) + 8 * j; const LAS float* s = scr + (8 * c) * 33 + n;
        v4u o; o.x = pk2(s[0 * 33], s[1 * 33]); o.y = pk2(s[2 * 33], s[3 * 33]); o.z = pk2(s[4 * 33], s[5 * 33]); o.w = pk2(s[6 * 33], s[7 * 33]);
        *(GAS v4u*)(WT + (size_t)(n0 + n) * ldt + kofs + k0 + 8 * c) = o; }
    LDS_WAIT(); asm volatile("" ::: "memory");
}
__device__ __forceinline__ void p0_weights(Frame& F) {
    LAS float* scr = (LAS float*)(F.lds + RING_OFF + 32768 + F.wave * 12288);
    const int gw = F.vcu * NWAVES + F.wave, NGW = F.G * NWAVES;
    bf16* Win_t = (bf16*)(F.ws + WS_WIN); bf16* Wout_t = (bf16*)(F.ws + WS_WOUT); bf16* W1_t = (bf16*)(F.ws + WS_W1); bf16* W2_t = (bf16*)(F.ws + WS_W2);
    constexpr int I_IN = (DM / 64) * (NPROJ / 32), I_OB = (DM / 64) * (DM / 32), I_1 = (DM / 64) * (DFF / 32), I_2 = (DFF / 64) * (DM / 32);
    constexpr int NITEMS = I_IN + I_OB + I_1 + I_2;
    for (int it = gw; it < NITEMS; it += NGW) {
        int r = it;
        if (r < I_IN) { p0_transpose_item(F.in[IN_WIN], LDWIN, NPROJ / 32, Win_t, DM, 0, nullptr, scr, r, F.lane); continue; } r -= I_IN;
        if (r < I_OB) { p0_transpose_item(F.in[IN_WOUT] + (size_t)DM * DM, DM, DM / 32, Wout_t, MIXW, 0, F.in[IN_SNW], scr, r, F.lane); continue; } r -= I_OB;
        if (r < I_1) { p0_transpose_item(F.in[IN_W1], DFF, DFF / 32, W1_t, DM, 0, nullptr, scr, r, F.lane); continue; } r -= I_1;
        p0_transpose_item(F.in[IN_W2], DM, DM / 32, W2_t, DFF, 0, nullptr, scr, r, F.lane);
    }
    const float* pw = F.in[IN_POOLW]; const float* ps = F.in[IN_POOLS]; const float* wo = F.in[IN_WOUT];
    const int li = F.lane & 15, kq = F.lane >> 4;
    for (int t = gw; t < 64 * 64; t += NGW) { const int it = t >> 6, nt = t & 63, g = it >> 4;
        f32x4 acc = (f32x4){0.f, 0.f, 0.f, 0.f};
        const float* arow = pw + ((size_t)(16 * it + li)) * 256;
#pragma unroll 8
        for (int s = 0; s < 64; ++s) { const int d = 4 * s + kq; const float a = arow[d] * ps[256 * g + d]; const float b = wo[(size_t)(256 * g + d) * DM + nt * 16 + li];
            acc = __builtin_amdgcn_mfma_f32_16x16x4f32(a, b, acc, 0, 0, 0); }
        v2u o; o.x = pk2(acc[0], acc[1]); o.y = pk2(acc[2], acc[3]);
        *(GAS v2u*)(Wout_t + (size_t)(nt * 16 + li) * MIXW + 1024 + 16 * it + 4 * kq) = o; }
    if (blockIdx.x < 16) { const float* pb = F.in[IN_POOLB]; LAS float* red = (LAS float*)(F.lds + RING_OFF);
        const int n = blockIdx.x * 64 + F.lane; float s = 0.f;
        for (int k = F.wave * 128; k < F.wave * 128 + 128; ++k) s += pb[k] * ps[k] * wo[(size_t)k * DM + n];
        __syncthreads(); red[F.wave * 64 + F.lane] = s; __syncthreads();
        if (F.wave == 0) { float t = 0.f;
#pragma unroll
            for (int w = 0; w < 8; ++w) t += red[w * 64 + F.lane];
            ((float*)(F.ws + WS_BIASA))[n] = t; }
        __syncthreads(); }
}

typedef short bf16x8 __attribute__((ext_vector_type(8)));
typedef short s16x4 __attribute__((ext_vector_type(4)));
#define MFMA16(a, b, c) __builtin_amdgcn_mfma_f32_16x16x32_bf16((a), (b), (c), 0, 0, 0)
constexpr int WDT_PITCH = 2064;
__device__ __forceinline__ void norm16(Frame& F, const float* xrows, int grow0, int batch, LAS unsigned char* wdt, int nrows  ) {
    const float* mod = (const float*)(F.ws + WS_MOD) + (size_t)batch * NMOD; bf16* H = (bf16*)(F.ws + WS_H); float* DT = (float*)(F.ws + WS_DT);
    const int lane = F.lane, l15 = lane & 15, l4 = lane >> 4;
    f32x4 a1[4], s1[4];
#pragma unroll
    for (int j = 0; j < 4; ++j) { const f32x4 w = *(const f32x4*)(F.in[IN_NW1] + 256 * j + 4 * lane), sc = *(const f32x4*)(mod + DM + 256 * j + 4 * lane); a1[j] = w * (sc + 1.0f); s1[j] = *(const f32x4*)(mod + 256 * j + 4 * lane); }
    f32x4 nx[4][4];
#pragma unroll
    for (int q = 0; q < 4; ++q) { const GAS f32x4* xr = (const GAS f32x4*)(xrows + (size_t)q * DM) + lane;
#pragma unroll
        for (int j = 0; j < 4; ++j) nx[q][j] = xr[64 * j]; }
    for (int r0 = 0; r0 < nrows; r0 += 4) {
        f32x4 v[4][4];
#pragma unroll
        for (int q = 0; q < 4; ++q)
#pragma unroll
            for (int j = 0; j < 4; ++j) v[q][j] = nx[q][j];
        if (r0 + 4 < nrows) {
#pragma unroll
            for (int q = 0; q < 4; ++q) { const GAS f32x4* xr = (const GAS f32x4*)(xrows + (size_t)(r0 + 4 + q) * DM) + lane;
#pragma unroll
                for (int j = 0; j < 4; ++j) nx[q][j] = xr[64 * j]; } }
        __builtin_amdgcn_sched_barrier(0);
        float ss[4];
#pragma unroll
        for (int q = 0; q < 4; ++q) { ss[q] = 0.f;
#pragma unroll
            for (int j = 0; j < 4; ++j) ss[q] += (v[q][j].x * v[q][j].x + v[q][j].y * v[q][j].y) + (v[q][j].z * v[q][j].z + v[q][j].w * v[q][j].w); }
#pragma unroll
        for (int o = 1; o < 64; o <<= 1) {
#pragma unroll
            for (int q = 0; q < 4; ++q) ss[q] += __shfl_xor(ss[q], o); }
#pragma unroll
        for (int q = 0; q < 4; ++q) { const float rs = 1.0f / sqrtf(ss[q] * (1.f / DM) + EPS);
            GAS unsigned long long* o8 = (GAS unsigned long long*)(H + (size_t)(grow0 + r0 + q) * DM) + lane;
#pragma unroll
            for (int j = 0; j < 4; ++j) { const f32x4 hv = v[q][j] * rs * a1[j] + s1[j]; o8[64 * j] = (unsigned long long)pk2(hv.x, hv.y) | ((unsigned long long)pk2(hv.z, hv.w) << 32); } }
    }
    asm volatile("s_waitcnt vmcnt(0)" ::: "memory");
#ifndef TAIL_REPS
#define TAIL_REPS 1
#endif
    for (int trep = 0; trep < TAIL_REPS; ++trep) {
    f32x4 acc0 = (f32x4){0.f, 0.f, 0.f, 0.f}, acc1 = acc0;
    const bf16* arow = H + (size_t)(grow0 + l15) * DM + 8 * l4; const LAS unsigned char* brow = wdt + l15 * WDT_PITCH + 16 * l4;
#pragma unroll
    for (int ks = 0; ks < 32; ks += 2) {
        const bf16x8 A0 = *(const bf16x8*)(arow + 32 * ks), A1 = *(const bf16x8*)(arow + 32 * ks + 32);
        const bf16x8 B0 = *(const LAS bf16x8*)(brow + 64 * ks), B1 = *(const LAS bf16x8*)(brow + 64 * ks + 64);
        acc0 = MFMA16(A0, B0, acc0); acc1 = MFMA16(A1, B1, acc1); }
    const float dtb = F.in[IN_DTB][l15];
#pragma unroll
    for (int r = 0; r < 4; ++r) { const float raw = acc0[r] + acc1[r] + dtb; if (4 * l4 + r < nrows) DT[(size_t)(grow0 + 4 * l4 + r) * 16 + l15] = fmaxf(raw, 0.f) + log1pf(expf(-fabsf(raw))); }
    }
}
__device__ __forceinline__ void p_norm(Frame& F) {
    LAS unsigned char* wdt = F.lds + RING_OFF;
    for (int k = F.tid; k < DM; k += NWAVES * 64) { const f32x4* src = (const f32x4*)(F.in[IN_WIN] + (size_t)k * LDWIN + NPROJ);
#pragma unroll
        for (int q = 0; q < 4; ++q) { const f32x4 w = src[q];
            *(LAS unsigned short*)(wdt + (4 * q + 0) * WDT_PITCH + 2 * k) = (unsigned short)f2bf(w.x); *(LAS unsigned short*)(wdt + (4 * q + 1) * WDT_PITCH + 2 * k) = (unsigned short)f2bf(w.y);
            *(LAS unsigned short*)(wdt + (4 * q + 2) * WDT_PITCH + 2 * k) = (unsigned short)f2bf(w.z); *(LAS unsigned short*)(wdt + (4 * q + 3) * WDT_PITCH + 2 * k) = (unsigned short)f2bf(w.w); } }
    __syncthreads();
    if (blockIdx.x < NBT) { const int b = blockIdx.x; const float* md = (const float*)(F.ws + WS_MOD) + (size_t)b * NMOD; float* A2 = (float*)(F.ws + WS_A2) + (size_t)b * DM;
        for (int c = F.tid; c < DM; c += NWAVES * 64) A2[c] = F.in[IN_NW2][c] * (1.0f + md[4 * DM + c]); }
    const int gw = F.vcu * NWAVES + F.wave;
    for (int w = gw; w < MP / 32; w += F.G * NWAVES) { norm16(F, F.in[IN_XP] + (size_t)w * 32 * DM, w * 32, w >> 7, wdt, 16); norm16(F, F.in[IN_XP] + (size_t)(w * 32 + 16) * DM, w * 32 + 16, w >> 7, wdt, 16); }
    for (int s = gw; s < MS / 4; s += F.G * NWAVES) norm16(F, F.in[IN_XS] + (size_t)s * 4 * DM, MP + s * 4, NB_P + (s >> 2), wdt, 4);
}

__device__ __forceinline__ float silu_fast(float x) { return x * __builtin_amdgcn_rcpf(1.f + __expf(-x)); }
template <int W, int NTOK>
__device__ __forceinline__ void pool_item(const bf16* PROJ, bf16* MIX, int row0, bool seq_start, const float* hist  , int c0) {
    v2u praw[W - 1], craw[NTOK]; f32x4 ph[W - 1];
    if (hist) {
#pragma unroll
        for (int i = 0; i < W - 1; ++i) ph[i] = *(const f32x4*)(hist + (size_t)(15 - (W - 1) + i) * DM + c0);
    } else if (!seq_start) {
#pragma unroll
        for (int i = 0; i < W - 1; ++i) praw[i] = *(const v2u*)(PROJ + (size_t)(row0 - (W - 1) + i) * NPROJ + c0);
    }
#pragma unroll
    for (int j = 0; j < NTOK; ++j) craw[j] = *(const v2u*)(PROJ + (size_t)(row0 + j) * NPROJ + c0);
    if (!hist) {
#pragma unroll
        for (int i = 0; i < W - 1; ++i) ph[i] = seq_start ? (f32x4){0.f, 0.f, 0.f, 0.f} : (f32x4){bflo(praw[i].x), bfhi(praw[i].x), bflo(praw[i].y), bfhi(praw[i].y)};
    }
    f32x4 s = (f32x4){0.f, 0.f, 0.f, 0.f};
#pragma unroll
    for (int i = 0; i < W - 1; ++i) s += ph[i];
#pragma unroll
    for (int j = 0; j < NTOK; ++j) {
        const f32x4 x = (f32x4){bflo(craw[j].x), bfhi(craw[j].x), bflo(craw[j].y), bfhi(craw[j].y)};
        s += x;
        const float inv = (seq_start && j + 1 < W) ? 1.0f / (float)(j + 1) : 1.0f / (float)W;
        const f32x4 o = s * inv - x;
        v2u ow; ow.x = pk2(o.x, o.y); ow.y = pk2(o.z, o.w);
        *(v2u*)(MIX + (size_t)(row0 + j) * MIXW + 1024 + c0) = ow;
        const int idx = j - (W - 1);
        if (idx < 0) s -= ph[(W - 1) + idx]; else s -= (f32x4){bflo(craw[idx].x), bfhi(craw[idx].x), bflo(craw[idx].y), bfhi(craw[idx].y)};
    }
}
template <int W>
__device__ __forceinline__ void pool_group(Frame& F, const bf16* PROJ, bf16* MIX, int blk, int c0) {
    if (blk < MP / 32) { const int row0 = blk * 32; pool_item<W, 32>(PROJ, MIX, row0, (row0 & (SEQ - 1)) == 0, nullptr, c0); }
    else { const int sb = blk - MP / 32; pool_item<W, DSEQ>(PROJ, MIX, MP + sb * DSEQ, false, F.in[IN_CPOOL] + (size_t)sb * 15 * DM, c0); }
}
__device__ __forceinline__ void p3_pool(Frame& F) {
    const bf16* PROJ = (const bf16*)(F.ws + WS_PROJ); bf16* MIX = (bf16*)(F.ws + WS_MIX);
    const int gw = F.vcu * NWAVES + F.wave, NGW = F.G * NWAVES;
    constexpr int NQ = (MP / 32 + NB_S) * 4;
    for (int q = gw; q < NQ; q += NGW) {
        int blk, g; if (q < NB_S * 4) { blk = MP / 32 + (q >> 2); g = q & 3; } else { const int qq = q - NB_S * 4; blk = qq >> 2; g = qq & 3; }
        const int c0 = g * 256 + 4 * F.lane;
        if (g == 0) pool_group<2>(F, PROJ, MIX, blk, c0); else if (g == 1) pool_group<4>(F, PROJ, MIX, blk, c0); else if (g == 2) pool_group<8>(F, PROJ, MIX, blk, c0); else pool_group<16>(F, PROJ, MIX, blk, c0);
    }
}
__device__ __forceinline__ void conv_rows8(const bf16* src  , bf16* dst, const f32x4 (&wv)[4][2], const f32x4 (&bv)[2], f32x4 (&h)[3][2]) {
    v4u raw[8];
#pragma unroll
    for (int j = 0; j < 8; ++j) raw[j] = *(const v4u*)(src + (size_t)j * NPROJ);
#pragma unroll
    for (int j = 0; j < 8; ++j) {
        const f32x4 x0 = (f32x4){bflo(raw[j].x), bfhi(raw[j].x), bflo(raw[j].y), bfhi(raw[j].y)}, x1 = (f32x4){bflo(raw[j].z), bfhi(raw[j].z), bflo(raw[j].w), bfhi(raw[j].w)};
        const f32x4 o0 = bv[0] + wv[0][0] * h[0][0] + wv[1][0] * h[1][0] + wv[2][0] * h[2][0] + wv[3][0] * x0;
        const f32x4 o1 = bv[1] + wv[0][1] * h[0][1] + wv[1][1] * h[1][1] + wv[2][1] * h[2][1] + wv[3][1] * x1;
        v4u ow; ow.x = pk2(silu_fast(o0.x), silu_fast(o0.y)); ow.y = pk2(silu_fast(o0.z), silu_fast(o0.w)); ow.z = pk2(silu_fast(o1.x), silu_fast(o1.y)); ow.w = pk2(silu_fast(o1.z), silu_fast(o1.w));
        *(v4u*)(dst + (size_t)j * CONVD) = ow;
        h[0][0] = h[1][0]; h[0][1] = h[1][1]; h[1][0] = h[2][0]; h[1][1] = h[2][1]; h[2][0] = x0; h[2][1] = x1;
    }
}
__device__ __forceinline__ void p3_conv(Frame& F) {
    const bf16* PROJ = (const bf16*)(F.ws + WS_PROJ); bf16* XB = (bf16*)(F.out + O_Y);
    const float* cw = F.in[IN_CONVW]; const float* cb = F.in[IN_CONVB];
    const int gw = F.vcu * NWAVES + F.wave, NGW = F.G * NWAVES;
    constexpr int NQ_S = NB_S * 2 * 3, NQ = NQ_S + (MP / 32) * 3;
    for (int q = gw; q < NQ; q += NGW) {
        int row0, nb8, strip; bool zero_hist = false; const float* hist = nullptr;
        if (q < NQ_S) { const int sh = q / 3; strip = q - sh * 3; const int sb = sh >> 1, half = sh & 1; row0 = MP + sb * DSEQ + 8 * half; nb8 = 1; if (!half) hist = F.in[IN_CCONV] + (size_t)sb * 3 * CONVD; }
        else { const int qq = q - NQ_S, blk = qq / 3; strip = qq - blk * 3; row0 = blk * 32; nb8 = 4; zero_hist = (row0 & (SEQ - 1)) == 0; }
        const int c0 = strip * 512 + 8 * F.lane;
        f32x4 wv[4][2], bv[2], h[3][2];
#pragma unroll
        for (int k = 0; k < 4; ++k) { wv[k][0] = *(const f32x4*)(cw + k * CONVD + c0); wv[k][1] = *(const f32x4*)(cw + k * CONVD + c0 + 4); }
        bv[0] = *(const f32x4*)(cb + c0); bv[1] = *(const f32x4*)(cb + c0 + 4);
#pragma unroll
        for (int i = 0; i < 3; ++i) {
            if (hist) { h[i][0] = *(const f32x4*)(hist + (size_t)i * CONVD + c0); h[i][1] = *(const f32x4*)(hist + (size_t)i * CONVD + c0 + 4); }
            else if (zero_hist) { h[i][0] = (f32x4){0.f, 0.f, 0.f, 0.f}; h[i][1] = h[i][0]; }
            else { const v4u r = *(const v4u*)(PROJ + (size_t)(row0 - 3 + i) * NPROJ + 2048 + c0); h[i][0] = (f32x4){bflo(r.x), bfhi(r.x), bflo(r.y), bfhi(r.y)}; h[i][1] = (f32x4){bflo(r.z), bfhi(r.z), bflo(r.w), bfhi(r.w)}; } }
        for (int b8 = 0; b8 < nb8; ++b8) conv_rows8(PROJ + (size_t)(row0 + 8 * b8) * NPROJ + 2048 + c0, XB + (size_t)(row0 + 8 * b8) * CONVD + c0, wv, bv, h);
    }
}

__device__ __forceinline__ unsigned offb(unsigned row, unsigned ch) { return 256u * row + 16u * (ch ^ (((row & 3u) << 2) | ((row >> 2) & 3u))); }
__device__ __forceinline__ bf16x8 frag_row(LAS unsigned char* img, int lane, int rb, int s) { return *(const LAS bf16x8*)(img + offb((unsigned)((lane & 15) + 16 * rb), (unsigned)(4 * s + (lane >> 4)))); }
__device__ __forceinline__ bf16x8 frag_tr(LAS unsigned char* img, int lane, int c, int ks) {
    const unsigned g = (unsigned)lane >> 4, q = ((unsigned)lane & 15u) >> 2, p = (unsigned)lane & 3u;
    const s16x4 t0 = __builtin_amdgcn_ds_read_tr16_b64_v4i16((LAS s16x4*)(img + offb(32u * ks + 8u * g + q, 2u * c + (p >> 1)) + 8u * (p & 1u)));
    const s16x4 t1 = __builtin_amdgcn_ds_read_tr16_b64_v4i16((LAS s16x4*)(img + offb(32u * ks + 8u * g + 4u + q, 2u * c + (p >> 1)) + 8u * (p & 1u)));
    return (bf16x8){t0[0], t0[1], t0[2], t0[3], t1[0], t1[1], t1[2], t1[3]};
}
__device__ __forceinline__ void p4_ssd(Frame& F) {
    const bf16* XB = (const bf16*)(F.out + O_Y); const bf16* PROJ = (const bf16*)(F.ws + WS_PROJ); bf16* MIX = (bf16*)(F.ws + WS_MIX);
    const float* DT = (const float*)(F.ws + WS_DT); float* SSQ = (float*)(F.ws + WS_SSQ);
    LAS unsigned char* Bs = F.lds + RING_OFF; LAS unsigned char* Cs = Bs + 16384; LAS unsigned char* Hs = Bs + 32768; LAS unsigned char* Xs = Bs + 49152; LAS unsigned char* Xd = Bs + 65536; LAS unsigned char* Ms = Bs + 81920;
    LAS float* Ys = (LAS float*)(Bs + 98304);
    LAS float* accs = Ys + 64 * 68; LAS float* dts = accs + 64;
    const int tid = F.tid, lane = F.lane, w = F.wave, l15 = lane & 15, l4 = lane >> 4;
    const int xj = tid >> 3, xch = tid & 7;
    for (int it = blockIdx.x; it < NB_P * NH + NB_S * NH; it += F.G) {
        int rowbase, L, h; float* sout; f32x4 st[4];
        if (it < NB_P * NH) { const int b = it >> 4; h = it & 15; rowbase = b * SEQ; L = SEQ; sout = F.out + O_SP + (size_t)it * HD * NST;
#pragma unroll
            for (int pt = 0; pt < 4; ++pt) st[pt] = (f32x4){0.f, 0.f, 0.f, 0.f}; }
        else { const int s = it - NB_P * NH, sb = s >> 4; h = s & 15; rowbase = MP + sb * DSEQ; L = DSEQ; sout = F.out + O_SS + (size_t)s * HD * NST;
            const float* sin = F.in[IN_SSM] + (size_t)s * HD * NST;
#pragma unroll
            for (int pt = 0; pt < 4; ++pt) st[pt] = *(const f32x4*)(sin + (size_t)(16 * pt + l15) * NST + 16 * w + 4 * l4); }
        const int g = h >> 3; const float Ah = -expf(F.in[IN_ALOG][h]), Dh = F.in[IN_DSKIP][h];
        v4u xw, bw[2], cw[2]; float dtr = 0.f;
        { const int nt0 = L < 64 ? L : 64;
          xw = (v4u){0u, 0u, 0u, 0u}; if (xj < nt0) xw = *(const v4u*)(XB + (size_t)(rowbase + xj) * CONVD + h * HD + 8 * xch);
#pragma unroll
          for (int rep = 0; rep < 2; ++rep) { const int tt = (tid >> 4) + 32 * rep; bw[rep] = (v4u){0u, 0u, 0u, 0u}; cw[rep] = (v4u){0u, 0u, 0u, 0u};
              if (tt < nt0) { const bf16* rp = XB + (size_t)(rowbase + tt) * CONVD + 1024 + g * NST + 8 * (tid & 15); bw[rep] = *(const v4u*)rp; cw[rep] = *(const v4u*)(rp + 256); } }
          if (w == 0 && lane < nt0) dtr = DT[(size_t)(rowbase + lane) * 16 + h]; }
        for (int t0 = 0; t0 < L; t0 += 64) {
            const int nt = (L - t0) < 64 ? (L - t0) : 64;
            if (w == 0) { float d = 0.f; if (lane < nt) d = dtr;
                float c = d * Ah;
#pragma unroll
                for (int o = 1; o < 64; o <<= 1) { const float v = __shfl_up(c, o); if (lane >= o) c += v; }
                accs[lane] = c; dts[lane] = d; }
#pragma unroll
            for (int pt = 0; pt < 4; ++pt) { v2u o; o.x = pk2(st[pt].x, st[pt].y); o.y = pk2(st[pt].z, st[pt].w);
                *(LAS v2u*)(Hs + offb((unsigned)(16 * pt + l15), (unsigned)(2 * w + (lane >> 5))) + 8u * (l4 & 1)) = o; }
            __syncthreads();
            const float acs63 = accs[63];
#pragma unroll
            for (int rep = 0; rep < 2; ++rep) { const unsigned tt = (unsigned)(tid >> 4) + 32u * rep, ch = (unsigned)tid & 15u;
                *(LAS v4u*)(Bs + offb(tt, ch)) = bw[rep]; *(LAS v4u*)(Cs + offb(tt, ch)) = cw[rep]; }
            const v4u xkeep = xw;
            { const float d = dts[xj], dec = __expf(acs63 - accs[xj]);
              const float x0 = bflo(xw.x) * d, x1 = bfhi(xw.x) * d, x2 = bflo(xw.y) * d, x3 = bfhi(xw.y) * d, x4 = bflo(xw.z) * d, x5 = bfhi(xw.z) * d, x6 = bflo(xw.w) * d, x7 = bfhi(xw.w) * d;
              v4u a; a.x = pk2(x0, x1); a.y = pk2(x2, x3); a.z = pk2(x4, x5); a.w = pk2(x6, x7);
              v4u b; b.x = pk2(x0 * dec, x1 * dec); b.y = pk2(x2 * dec, x3 * dec); b.z = pk2(x4 * dec, x5 * dec); b.w = pk2(x6 * dec, x7 * dec);
              *(LAS v4u*)(Xs + offb((unsigned)xj, (unsigned)xch)) = a; *(LAS v4u*)(Xd + offb((unsigned)xj, (unsigned)xch)) = b; }
            v4u zw = (v4u){0u, 0u, 0u, 0u}; if (xj < nt) zw = *(const v4u*)(PROJ + (size_t)(rowbase + t0 + xj) * NPROJ + 1024 + h * HD + 8 * xch);
            if (t0 + 64 < L) { const int r1 = rowbase + t0 + 64;
                xw = *(const v4u*)(XB + (size_t)(r1 + xj) * CONVD + h * HD + 8 * xch);
#pragma unroll
                for (int rep = 0; rep < 2; ++rep) { const int tt = (tid >> 4) + 32 * rep; const bf16* rp = XB + (size_t)(r1 + tt) * CONVD + 1024 + g * NST + 8 * (tid & 15); bw[rep] = *(const v4u*)rp; cw[rep] = *(const v4u*)(rp + 256); }
                if (w == 0) dtr = DT[(size_t)(r1 + lane) * 16 + h]; }
            __syncthreads();
            { const int itile = w >> 1, jt0 = 2 * (w & 1);
              f32x4 g0 = (f32x4){0.f, 0.f, 0.f, 0.f}, g1 = g0;
#pragma unroll
              for (int ks = 0; ks < 4; ++ks) { const bf16x8 bC = frag_row(Cs, lane, itile, ks), a0 = frag_row(Bs, lane, jt0, ks), a1 = frag_row(Bs, lane, jt0 + 1, ks);
                  g0 = MFMA16(a0, bC, g0); g1 = MFMA16(a1, bC, g1); }
              const int i = 16 * itile + l15; const float ai = accs[i];
#pragma unroll
              for (int jj = 0; jj < 2; ++jj) { const int j0 = 16 * (jt0 + jj) + 4 * l4; const f32x4 aj = *(const LAS f32x4*)(accs + j0); const f32x4 gv = jj ? g1 : g0;
                  float m[4];
#pragma unroll
                  for (int r = 0; r < 4; ++r) m[r] = (j0 + r <= i) ? gv[r] * __expf(ai - aj[r]) : 0.f;
                  v2u o; o.x = pk2(m[0], m[1]); o.y = pk2(m[2], m[3]);
                  *(LAS v2u*)(Ms + offb((unsigned)i, (unsigned)(2 * (jt0 + jj) + (lane >> 5))) + 8u * (l4 & 1)) = o; } }
            __syncthreads();
            { const int itile = w >> 1, pt0 = 2 * (w & 1);
              f32x4 yd0 = (f32x4){0.f, 0.f, 0.f, 0.f}, yd1 = yd0, yo0 = yd0, yo1 = yd0;
#pragma unroll
              for (int ks = 0; ks < 2; ++ks) { const bf16x8 aM = frag_row(Ms, lane, itile, ks), b0 = frag_tr(Xs, lane, pt0, ks), b1 = frag_tr(Xs, lane, pt0 + 1, ks);
                  yd0 = MFMA16(aM, b0, yd0); yd1 = MFMA16(aM, b1, yd1); }
#pragma unroll
              for (int ks = 0; ks < 4; ++ks) { const bf16x8 aC = frag_row(Cs, lane, itile, ks), b0 = frag_row(Hs, lane, pt0, ks), b1 = frag_row(Hs, lane, pt0 + 1, ks);
                  yo0 = MFMA16(aC, b0, yo0); yo1 = MFMA16(aC, b1, yo1); }
              const int i0 = 16 * itile + 4 * l4; const f32x4 av = *(const LAS f32x4*)(accs + i0);
#pragma unroll
              for (int r = 0; r < 4; ++r) { const float e = __expf(av[r]);
                  Ys[(i0 + r) * 68 + 16 * pt0 + l15] = yd0[r] + e * yo0[r]; Ys[(i0 + r) * 68 + 16 * (pt0 + 1) + l15] = yd1[r] + e * yo1[r]; } }
            { const float cd = __expf(acs63);
#pragma unroll
              for (int pt = 0; pt < 4; ++pt) st[pt] = st[pt] * cd;
#pragma unroll
              for (int ks = 0; ks < 2; ++ks) { const bf16x8 aB = frag_tr(Bs, lane, w, ks);
#pragma unroll
                  for (int pt = 0; pt < 4; ++pt) { const bf16x8 bX = frag_tr(Xd, lane, pt, ks); st[pt] = MFMA16(aB, bX, st[pt]); } } }
            __syncthreads();
            if (xj < nt) { const size_t row = (size_t)(rowbase + t0 + xj);
                const f32x4 y0 = *(const LAS f32x4*)(Ys + xj * 68 + 8 * xch), y1 = *(const LAS f32x4*)(Ys + xj * 68 + 8 * xch + 4);
                const float xv[8] = {bflo(xkeep.x), bfhi(xkeep.x), bflo(xkeep.y), bfhi(xkeep.y), bflo(xkeep.z), bfhi(xkeep.z), bflo(xkeep.w), bfhi(xkeep.w)};
                const float z[8] = {bflo(zw.x), bfhi(zw.x), bflo(zw.y), bfhi(zw.y), bflo(zw.z), bfhi(zw.z), bflo(zw.w), bfhi(zw.w)};
                float o[8]; float ss = 0.f;
#pragma unroll
                for (int i = 0; i < 4; ++i) { o[i] = (y0[i] + Dh * xv[i]) * silu_f(z[i]); o[4 + i] = (y1[i] + Dh * xv[4 + i]) * silu_f(z[4 + i]); }
#pragma unroll
                for (int i = 0; i < 8; ++i) ss += o[i] * o[i];
                ss += __shfl_xor(ss, 1); ss += __shfl_xor(ss, 2); ss += __shfl_xor(ss, 4);
                if (xch == 0) SSQ[row * 16 + h] = ss;
                v4u ow; ow.x = pk2(o[0], o[1]); ow.y = pk2(o[2], o[3]); ow.z = pk2(o[4], o[5]); ow.w = pk2(o[6], o[7]);
                *(v4u*)(MIX + row * MIXW + h * HD + 8 * xch) = ow; }
        }
#pragma unroll
        for (int pt = 0; pt < 4; ++pt) *(f32x4*)(sout + (size_t)(16 * pt + l15) * NST + 16 * w + 4 * l4) = st[pt];
        __syncthreads();
    }
}
__device__ __forceinline__ void p4b_gnorm(Frame& F) {
    bf16* MIX = (bf16*)(F.ws + WS_MIX); const float* SSQ = (const float*)(F.ws + WS_SSQ);
    const int gw = F.vcu * NWAVES + F.wave, NGW = F.G * NWAVES, lane = F.lane;
    for (int row = gw; row < MT; row += NGW) {
        float s = SSQ[(size_t)row * 16 + (lane & 15)];
        s += __shfl_xor(s, 1); s += __shfl_xor(s, 2); s += __shfl_xor(s, 4);
        const float sg = __shfl(s, (lane >> 5) * 8);
        const float rs = 1.0f / sqrtf(sg * (1.f / 512.f) + EPS);
        v4u* p = (v4u*)(MIX + (size_t)row * MIXW + 1024 + 16 * lane);
#pragma unroll
        for (int q = 0; q < 2; ++q) { v4u w = p[q];
            w.x = pk2(bflo(w.x) * rs, bfhi(w.x) * rs); w.y = pk2(bflo(w.y) * rs, bfhi(w.y) * rs); w.z = pk2(bflo(w.z) * rs, bfhi(w.z) * rs); w.w = pk2(bflo(w.w) * rs, bfhi(w.w) * rs);
            p[q] = w; }
    }
}
__device__ __forceinline__ void p9_final(Frame& F) {
    const float* fw = F.in[IN_FNW]; const int gw = F.vcu * NWAVES + F.wave, NGW = F.G * NWAVES, lane = F.lane;
    f32x4 w[4];
#pragma unroll
    for (int j = 0; j < 4; ++j) w[j] = *(const f32x4*)(fw + 256 * j + 4 * lane);
    for (int row = gw; row < MT; row += NGW) {
        GAS f32x4* xr = (GAS f32x4*)(F.out + O_Y + (size_t)row * DM) + lane;
        f32x4 v[4]; float ss = 0.f;
#pragma unroll
        for (int j = 0; j < 4; ++j) { v[j] = xr[64 * j]; ss += (v[j].x * v[j].x + v[j].y * v[j].y) + (v[j].z * v[j].z + v[j].w * v[j].w); }
        const float rs = 1.0f / sqrtf(wave_sum(ss) * (1.f / DM) + EPS);
#pragma unroll
        for (int j = 0; j < 4; ++j) xr[64 * j] = v[j] * rs * w[j];
    }
}

constexpr int N_PHASES = 8;
struct Args { const float* in[27]; float* out; unsigned char* ws; int ph_lo, ph_hi; };
__global__ void __launch_bounds__(NWAVES * 64, 2) hymba_fwd(Args args) {
    extern __shared__ __attribute__((aligned(16))) unsigned char lds[];
    Frame F;
    F.lds = (LAS unsigned char*)lds;
    F.tid = threadIdx.x; F.lane = F.tid & 63; F.wave = __builtin_amdgcn_readfirstlane(F.tid >> 6);
    F.G = gridDim.x; { const int bx = blockIdx.x; F.vcu = (F.G % 8 == 0) ? (bx % 8) * (F.G / 8) + bx / 8 : bx; }
#pragma unroll
    for (int i = 0; i < 27; ++i) F.in[i] = args.in[i];
    F.out = args.out; F.ws = args.ws;
    const int lo = args.ph_lo, hi = args.ph_hi;
    for (int u = F.tid; u < (LDS_BYTES - LDSCTL_OFF) / 4; u += NWAVES * 64) ((LAS unsigned*)(F.lds + LDSCTL_OFF))[u] = 0u;
    __syncthreads();
    XcdBarrier bar; bar.bar = (unsigned*)(F.ws + WS_CTL) + CW_BAR; bar.x = 0; bar.st = nullptr;
    if (hi - lo > 1) bar = xcd_barrier_post((unsigned*)(F.ws + WS_CTL) + CW_BAR, (volatile LAS unsigned*)(F.lds + MISC_OFF) + 8);
#ifndef PHASE_MASK
#define PHASE_MASK 0xff
#endif
#define IN(k) (((PHASE_MASK >> (k)) & 1) && lo <= (k) && (k) < hi)
#ifndef DOUBLE_MASK
#define DOUBLE_MASK 0
#endif
#define REPS(k) for (int rep_ = 0; rep_ < 1 + ((DOUBLE_MASK >> (k)) & 1); ++rep_)
#define SEAM(k) do { if (IN(k) && IN((k) + 1)) { xcd_barrier(bar); } } while (0)
    bf16* Hb = (bf16*)(F.ws + WS_H); bf16* PROJ = (bf16*)(F.ws + WS_PROJ); bf16* MIX = (bf16*)(F.ws + WS_MIX); bf16* HMID = (bf16*)(F.ws + WS_HMID);
    const float* mod = (const float*)(F.ws + WS_MOD);

    if (IN(0)) REPS(0) { p0_mod(F); p0_weights(F); } SEAM(0);
    if (IN(1)) REPS(1) { p_norm(F); } SEAM(1);
    if (IN(2)) REPS(2) {
        pg8::Gemm g{Hb, (const bf16*)(F.ws + WS_WIN), MT, NPROJ, DM}; pg8::StaticOrder S; S.init(MT, NPROJ, F.G, (int)blockIdx.x);
        pg8::EpiProj E{PROJ, F.out, O_PP, O_CP, O_PS, O_CS};
        pg8::gemm_phase<pg8::EpiProj, pg8::StaticOrder, true, true>(F.lds + RING_OFF, g, S, E);
    } SEAM(2);
    if (IN(3)) REPS(3) { p3_pool(F); p3_conv(F); } SEAM(3);
    if (IN(4)) REPS(4) { p4_ssd(F); } SEAM(4);
    if (IN(5)) {
        pg8::Gemm g{MIX, (const bf16*)(F.ws + WS_WOUT), MT, DM, MIXW}; pg8::PanelOrder S; S.init(MT, F.G, F.vcu);
        pg8::EpiResNorm<0> E{F.in[IN_XP], F.in[IN_XS], F.out + O_Y, (const float*)(F.ws + WS_BIASA), mod + 2 * DM,
                             (unsigned*)(F.ws + WS_XSL), (unsigned*)(F.ws + WS_CTL) + CW_SEAM, F.lds + LDSX_OFF,
                             Hb, (const float*)(F.ws + WS_A2), mod + 3 * DM, (const float*)(F.ws + WS_SSQ), nullptr};
        pg8::gemm_phase<pg8::EpiResNorm<0>, pg8::PanelOrder, true, true>(F.lds + RING_OFF, g, S, E);
    } SEAM(5);
    if (IN(6)) REPS(6) {
        pg8::Gemm g{Hb, (const bf16*)(F.ws + WS_W1), MT, DFF, DM}; pg8::StaticOrder S; S.init(MT, DFF, F.G, (int)blockIdx.x);
        pg8::EpiRelu2 E{HMID, F.in[IN_B1]};
        pg8::gemm_phase<pg8::EpiRelu2, pg8::StaticOrder, true, true>(F.lds + RING_OFF, g, S, E);
    } SEAM(6);
    if (IN(7)) {
        pg8::Gemm g{HMID, (const bf16*)(F.ws + WS_W2), MT, DM, DFF}; pg8::PanelOrder S; S.init(MT, F.G, F.vcu);
        pg8::EpiResNorm<1> E{F.out + O_Y, F.out + O_Y + (size_t)MP * DM, F.out + O_Y, F.in[IN_B2], mod + 5 * DM,
                             (unsigned*)(F.ws + WS_XSL) + (size_t)MT * 4, (unsigned*)(F.ws + WS_CTL) + CW_SEAM + SEAM_BANK, F.lds + LDSX_OFF,
                             nullptr, nullptr, nullptr, nullptr, F.in[IN_FNW]};
        pg8::gemm_phase<pg8::EpiResNorm<1>, pg8::PanelOrder, true, true>(F.lds + RING_OFF, g, S, E);
    }
#undef IN
#undef SEAM
}

#ifndef MK_ONE_LAUNCH
#define MK_ONE_LAUNCH 1
#endif
extern "C" void kernel_launch(void* const* d_in, const int* in_sizes, int n_in, void* d_out, int out_size, void* d_ws, size_t ws_size, hipStream_t stream) {
    static int grid = 0;
    if (grid == 0) {
        if (n_in != 27 || in_sizes[0] != MP * DM || (size_t)out_size != O_END || ws_size < WS_END) {
            fprintf(stderr, "kernel_launch: shape mismatch: n_in %d in0 %d out %d ws %zu (need %zu)\n", n_in, n_in > 0 ? in_sizes[0] : -1, out_size, ws_size, (size_t)WS_END); grid = -1; return; }
        int dev = 0, cus = 0, per_cu = 0;
        if (hipGetDevice(&dev) != hipSuccess || hipDeviceGetAttribute(&cus, hipDeviceAttributeMultiprocessorCount, dev) != hipSuccess) { grid = -1; return; }
        if (hipFuncSetAttribute((const void*)hymba_fwd, hipFuncAttributeMaxDynamicSharedMemorySize, LDS_BYTES) != hipSuccess) { fprintf(stderr, "kernel_launch: hipFuncSetAttribute failed\n"); grid = -1; return; }
        if (hipOccupancyMaxActiveBlocksPerMultiprocessor(&per_cu, (const void*)hymba_fwd, NWAVES * 64, LDS_BYTES) != hipSuccess || per_cu < 1) { fprintf(stderr, "kernel_launch: occupancy query says %d blocks per CU\n", per_cu); per_cu = 1; }
        (void)hipGetLastError();
        grid = cus;
        if (grid > cus * per_cu) grid = cus * per_cu;
    }
    if (grid < 0) return;
    Args a{};
    for (int i = 0; i < 27; ++i) a.in[i] = (const float*)d_in[i];
    a.out = (float*)d_out; a.ws = (unsigned char*)d_ws;
#if MK_ONE_LAUNCH
    a.ph_lo = 0; a.ph_hi = N_PHASES;
    if (hipMemsetAsync((char*)d_ws + WS_CTL, 0, CTL_ZERO_BYTES, stream) != hipSuccess) { fprintf(stderr, "kernel_launch: hipMemsetAsync failed\n"); return; }
    hipLaunchKernelGGL(hymba_fwd, dim3(grid), dim3(NWAVES * 64), LDS_BYTES, stream, a);
    { const hipError_t le = hipPeekAtLastError(); if (le != hipSuccess) fprintf(stderr, "kernel_launch: launch failed: %s (grid %d)\n", hipGetErrorName(le), grid); }
#else
    for (int p = 0; p < N_PHASES; ++p) { a.ph_lo = p; a.ph_hi = p + 1;
        hipLaunchKernelGGL(hymba_fwd, dim3(grid), dim3(NWAVES * 64), LDS_BYTES, stream, a);
        const hipError_t le = hipPeekAtLastError(); if (le != hipSuccess) { fprintf(stderr, "kernel_launch: launch %d failed: %s\n", p, hipGetErrorName(le)); break; } }
#endif
}
```

```cpp
#include <hip/hip_runtime.h>
#include <hip/hip_cooperative_groups.h>
#include <cstdio>
#include <cstdint>
#include <type_traits>
namespace cg = cooperative_groups;

constexpr int DM = 1024, NB_P = 16, SEQ = 4096, NB_S = 32, DSEQ = 16;
constexpr int MP = NB_P * SEQ, MS = NB_S * DSEQ, MT = MP + MS, NBT = NB_P + NB_S;
constexpr int NPROJ = 3584, LDWIN = 3600, DFF = 4096, MIXW = 2048, CONVD = 1536, NH = 16, HD = 64, NST = 128, NMOD = 6 * DM;
constexpr float EPS = 1e-6f;
constexpr size_t O_Y = 0, O_PP = (size_t)MT * DM, O_CP = O_PP + (size_t)NB_P * 15 * DM, O_SP = O_CP + (size_t)NB_P * 3 * CONVD,
                 O_PS = O_SP + (size_t)NB_P * NH * HD * NST, O_CS = O_PS + (size_t)NB_S * 15 * DM, O_SS = O_CS + (size_t)NB_S * 3 * CONVD,
                 O_END = O_SS + (size_t)NB_S * NH * HD * NST;
namespace pg8 {
#define PG8_LAS __attribute__((address_space(3)))
typedef unsigned short bf16_t;
typedef short bf16x8 __attribute__((ext_vector_type(8)));
typedef float f32x4 __attribute__((ext_vector_type(4)));
typedef unsigned u32x4 __attribute__((ext_vector_type(4)));
constexpr int BM = 256, BK = 64, HALF = 128, HTB = HALF * BK * 2  , STAGE_BYTES = 8 * HTB, NXCD = 8, WGM = 8;

__host__ __device__ __forceinline__ int lds_byte(int r, int c) { const int st = (r >> 4) * 2 + (c >> 5), rr = r & 15, cc = c & 31, ob = rr * 64 + cc * 2; return st * 1024 + (ob ^ (((ob >> 9) & 1) << 5)); }
__host__ __device__ __forceinline__ void stage_rc(int b, int& R, int& C) { const int st = b / 1024, sb = b % 1024, swz = sb ^ (((sb >> 9) & 1) << 5); R = (st >> 1) * 16 + swz / 64; C = (st & 1) * 32 + (swz % 64) / 2; }
__host__ __device__ __forceinline__ int perm32(int rho) { const int n = rho >> 4, i = rho & 15; return 8 * (i >> 2) + 4 * n + (i & 3); }

struct Unit { int pm, pn; };
struct Gemm { const bf16_t* A; const bf16_t* Bt; int M, N, K; };

struct StaticOrder {
    int nM, nN, nwg, G, c;
    __host__ __device__ void init(int M, int N, int G_, int c_) { nM = M / BM; nN = N / BM; nwg = nM * nN; G = G_; c = c_; }
    __host__ __device__ bool next(int i, Unit& u) const {
        const long L = (long)i * G + c; if (L >= nwg) return false;
        int wgid = (int)L; { const int q = nwg / NXCD, r = nwg % NXCD, xcd = wgid % NXCD, off = wgid / NXCD; wgid = (xcd < r ? xcd * (q + 1) : r * (q + 1) + (xcd - r) * q) + off; }
        const int nig = WGM * nN, gid = wgid / nig, fm = gid * WGM, gsz = (nM - fm) < WGM ? (nM - fm) : WGM;
        u.pm = fm + ((wgid % nig) % gsz); u.pn = (wgid % nig) / gsz; return true;
    }
    __device__ __forceinline__ void a_ready(const Unit&) const {}
    __device__ __forceinline__ void done(const Unit&) const {}
};
__device__ __forceinline__ unsigned cvt_pk_bf16(float lo, float hi) { unsigned r; asm volatile("v_cvt_pk_bf16_f32 %0, %1, %2" : "=v"(r) : "v"(lo), "v"(hi)); return r; }
typedef unsigned u32x2 __attribute__((ext_vector_type(2)));
typedef float f32x2e __attribute__((ext_vector_type(2)));
#ifndef EPI_CONV
#define EPI_CONV 1
#endif
#ifndef EPI_POOL
#define EPI_POOL 1
#endif
struct EpiProj {
    static constexpr bool PERM = true, AFTER_DRAIN = false, KHOOK = false, PREFETCH = false; static constexpr int KH0 = -1, KH1 = -1;
    bf16_t* O; float* out;
    size_t o_pp, o_cp, o_ps, o_cs;
    bf16_t* XB; const float* convw; const float* convb;
#define EPI_TAP0(K, cur_) __builtin_bit_cast(float, __builtin_amdgcn_mov_dpp(__builtin_bit_cast(int, (cur_)), 0x110 + (K), 0xf, 0xf, true))
#define EPI_TAP(K, cur_, prv_) __builtin_bit_cast(float, __builtin_amdgcn_update_dpp(__builtin_amdgcn_mov_dpp(__builtin_bit_cast(int, (prv_)), 0x100 + 16 - (K), 0xf, 0xf, true), __builtin_bit_cast(int, (cur_)), 0x110 + (K), 0xf, 0xf, false))
    __device__ __forceinline__ void conv_tile(const f32x4 (&acc)[2][2][4][2], const Unit& u, int wr, int wc, int fr_, int fq_) const {
        int fr = fr_, fq = fq_; asm volatile("" : "+v"(fr), "+v"(fq));
        const int ch0 = (u.pn - 8) * BM + wc * 32 + 8 * fq;
        const int row0 = u.pm * BM + wr * 64 + fr;
#pragma unroll
        for (int bj = 0; bj < 2; ++bj) {
            f32x4 wv[4][2], bv[2];
#pragma unroll
            for (int n = 0; n < 2; ++n) { bv[n] = *(const f32x4*)(convb + ch0 + bj * HALF + 4 * n);
#pragma unroll
                for (int k = 0; k < 4; ++k) wv[k][n] = *(const f32x4*)(convw + k * 1536 + ch0 + bj * HALF + 4 * n); }
#pragma unroll
            for (int ai = 0; ai < 2; ++ai)
#pragma unroll
                for (int m = 0; m < 4; ++m) { unsigned pk[4];
#pragma unroll
                    for (int n = 0; n < 2; ++n) {
                        const f32x4 X = acc[ai][bj][m][n]; f32x4 T1, T2, T3;
#pragma unroll
                        for (int j = 0; j < 4; ++j) { const float x0 = X[j];
                            if (m > 0) { const float xp = acc[ai][bj][m > 0 ? m - 1 : 0][n][j]; T1[j] = EPI_TAP(1, x0, xp); T2[j] = EPI_TAP(2, x0, xp); T3[j] = EPI_TAP(3, x0, xp); }
                            else { T1[j] = EPI_TAP0(1, x0); T2[j] = EPI_TAP0(2, x0); T3[j] = EPI_TAP0(3, x0); } }
                        const f32x4 v = wv[0][n] * T3 + (wv[1][n] * T2 + (wv[2][n] * T1 + (wv[3][n] * X + bv[n])));
                        const f32x4 t = v * -1.4426950408889634f;
                        const f32x4 dn = (f32x4){__builtin_amdgcn_exp2f(t.x), __builtin_amdgcn_exp2f(t.y), __builtin_amdgcn_exp2f(t.z), __builtin_amdgcn_exp2f(t.w)} + 1.0f;
                        const f32x4 o = v * (f32x4){__builtin_amdgcn_rcpf(dn.x), __builtin_amdgcn_rcpf(dn.y), __builtin_amdgcn_rcpf(dn.z), __builtin_amdgcn_rcpf(dn.w)};
                        pk[2 * n] = cvt_pk_bf16(o.x, o.y); pk[2 * n + 1] = cvt_pk_bf16(o.z, o.w); }
                    u32x4 w; w.x = pk[0]; w.y = pk[1]; w.z = pk[2]; w.w = pk[3];
                    *(u32x4*)(XB + (size_t)(row0 + ai * HALF + m * 16) * 1536 + ch0 + bj * HALF) = w;
                    if ((m == 0 && fr < 3) || (m == 3 && fr >= 13)) { const f32x4 v0 = acc[ai][bj][m][0], v1 = acc[ai][bj][m][1];
                        u32x4 r; r.x = cvt_pk_bf16(v0[0], v0[1]); r.y = cvt_pk_bf16(v0[2], v0[3]); r.z = cvt_pk_bf16(v1[0], v1[1]); r.w = cvt_pk_bf16(v1[2], v1[3]);
                        *(u32x4*)(O + (size_t)(row0 + ai * HALF + m * 16) * 3584 + 2048 + ch0 + bj * HALF) = r; } }
        }
    }
    bf16_t* MX;
    template <int W>
    __device__ __forceinline__ void pool_tile(const f32x4 (&acc)[2][2][4][2], const Unit& u, int wr, int wc, int fr_, int fq_) const {
        int fr = fr_, fq = fq_; asm volatile("" : "+v"(fr), "+v"(fq));
        const int ch0 = u.pn * BM + wc * 32 + 8 * fq, row0 = u.pm * BM + wr * 64 + fr;
        constexpr float INV = 1.0f / (float)W;
#pragma unroll
        for (int bj = 0; bj < 2; ++bj)
#pragma unroll
            for (int ai = 0; ai < 2; ++ai) { float o[4][8];
#pragma unroll
                for (int n = 0; n < 2; ++n)
#pragma unroll
                    for (int j = 0; j < 4; ++j) { float s[4];
#pragma unroll
                        for (int m = 0; m < 4; ++m) s[m] = acc[ai][bj][m][n][j];
                        { float t[4];
#pragma unroll
                          for (int m = 0; m < 4; ++m) t[m] = s[m] + (m > 0 ? EPI_TAP(1, s[m], s[m > 0 ? m - 1 : 0]) : EPI_TAP0(1, s[m]));
#pragma unroll
                          for (int m = 0; m < 4; ++m) s[m] = t[m]; }
                        if constexpr (W >= 4) { float t[4];
#pragma unroll
                          for (int m = 0; m < 4; ++m) t[m] = s[m] + (m > 0 ? EPI_TAP(2, s[m], s[m > 0 ? m - 1 : 0]) : EPI_TAP0(2, s[m]));
#pragma unroll
                          for (int m = 0; m < 4; ++m) s[m] = t[m]; }
                        if constexpr (W >= 8) { float t[4];
#pragma unroll
                          for (int m = 0; m < 4; ++m) t[m] = s[m] + (m > 0 ? EPI_TAP(4, s[m], s[m > 0 ? m - 1 : 0]) : EPI_TAP0(4, s[m]));
#pragma unroll
                          for (int m = 0; m < 4; ++m) s[m] = t[m]; }
                        if constexpr (W >= 16) { float t[4];
#pragma unroll
                          for (int m = 0; m < 4; ++m) t[m] = s[m] + (m > 0 ? EPI_TAP(8, s[m], s[m > 0 ? m - 1 : 0]) : EPI_TAP0(8, s[m]));
#pragma unroll
                          for (int m = 0; m < 4; ++m) s[m] = t[m]; }
#pragma unroll
                        for (int m = 0; m < 4; ++m) o[m][4 * n + j] = s[m] * INV - acc[ai][bj][m][n][j]; }
#pragma unroll
                for (int m = 0; m < 4; ++m) { u32x4 w; w.x = cvt_pk_bf16(o[m][0], o[m][1]); w.y = cvt_pk_bf16(o[m][2], o[m][3]); w.z = cvt_pk_bf16(o[m][4], o[m][5]); w.w = cvt_pk_bf16(o[m][6], o[m][7]);
                    *(u32x4*)(MX + (size_t)(row0 + ai * HALF + m * 16) * 2048 + 1024 + ch0 + bj * HALF) = w;
                    if ((m == 0 && fr < W - 1) || (m == 3 && fr >= 17 - W)) { const f32x4 v0 = acc[ai][bj][m][0], v1 = acc[ai][bj][m][1];
                        u32x4 r; r.x = cvt_pk_bf16(v0[0], v0[1]); r.y = cvt_pk_bf16(v0[2], v0[3]); r.z = cvt_pk_bf16(v1[0], v1[1]); r.w = cvt_pk_bf16(v1[2], v1[3]);
                        *(u32x4*)(O + (size_t)(row0 + ai * HALF + m * 16) * 3584 + ch0 + bj * HALF) = r; } }
            }
    }
    __device__ __forceinline__ void operator()(const f32x4 (&acc)[2][2][4][2], const Unit& u, int wr, int wc, int fr, int fq) const {
        const int row0 = u.pm * BM + wr * 64 + fr, col0 = u.pn * BM + wc * 32 + 8 * fq;
        if (EPI_CONV && u.pn >= 8) conv_tile(acc, u, wr, wc, fr, fq);
        else if (EPI_POOL && u.pn == 0) pool_tile<2>(acc, u, wr, wc, fr, fq);
        else if (EPI_POOL && u.pn == 1) pool_tile<4>(acc, u, wr, wc, fr, fq);
        else if (EPI_POOL && u.pn == 2) pool_tile<8>(acc, u, wr, wc, fr, fq);
        else if (EPI_POOL && u.pn == 3) pool_tile<16>(acc, u, wr, wc, fr, fq);
        else {
#pragma unroll
        for (int ai = 0; ai < 2; ++ai)
#pragma unroll
            for (int m = 0; m < 4; ++m) { bf16_t* rowp = O + (size_t)(row0 + ai * HALF + m * 16) * 3584 + col0;
#pragma unroll
                for (int bj = 0; bj < 2; ++bj) { const f32x4 v0 = acc[ai][bj][m][0], v1 = acc[ai][bj][m][1];
                    u32x4 w; w.x = cvt_pk_bf16(v0[0], v0[1]); w.y = cvt_pk_bf16(v0[2], v0[3]); w.z = cvt_pk_bf16(v1[0], v1[1]); w.w = cvt_pk_bf16(v1[2], v1[3]);
                    *(u32x4*)(rowp + bj * HALF) = w; } }
        }
        const bool is_u = u.pn < 4, is_c = u.pn >= 8;
        if (!(is_u || is_c)) return;
        if (u.pm < 256) {
            if ((u.pm & 15) != 15 || wr != 1) return;
            const int b = u.pm >> 4, lr = 240 + fr;
            if (is_u) { if (fr >= 1) { float* dst = out + o_pp + ((size_t)(b * 15 + (fr - 1)) * 1024 + col0);
#pragma unroll
                    for (int bj = 0; bj < 2; ++bj) { *(f32x4*)(dst + bj * HALF) = acc[1][bj][3][0]; *(f32x4*)(dst + bj * HALF + 4) = acc[1][bj][3][1]; } } }
            else { if (fr >= 13) { float* dst = out + o_cp + ((size_t)(b * 3 + (fr - 13)) * 1536 + (col0 - 2048));
#pragma unroll
                    for (int bj = 0; bj < 2; ++bj) { *(f32x4*)(dst + bj * HALF) = acc[1][bj][3][0]; *(f32x4*)(dst + bj * HALF + 4) = acc[1][bj][3][1]; } } }
            (void)lr;
        } else {
#pragma unroll
            for (int ai = 0; ai < 2; ++ai)
#pragma unroll
                for (int m = 0; m < 4; ++m) { const int sb = (u.pm - 256) * 16 + 8 * ai + 4 * wr + m;
                    if (is_u) { if (fr >= 1) { float* dst = out + o_ps + ((size_t)(sb * 15 + (fr - 1)) * 1024 + col0);
#pragma unroll
                            for (int bj = 0; bj < 2; ++bj) { *(f32x4*)(dst + bj * HALF) = acc[ai][bj][m][0]; *(f32x4*)(dst + bj * HALF + 4) = acc[ai][bj][m][1]; } } }
                    else { if (fr >= 13) { float* dst = out + o_cs + ((size_t)(sb * 3 + (fr - 13)) * 1536 + (col0 - 2048));
#pragma unroll
                            for (int bj = 0; bj < 2; ++bj) { *(f32x4*)(dst + bj * HALF) = acc[ai][bj][m][0]; *(f32x4*)(dst + bj * HALF + 4) = acc[ai][bj][m][1]; } } } }
        }
    }
};
struct EpiRelu2 {
    static constexpr bool PERM = true, AFTER_DRAIN = false, KHOOK = false, PREFETCH = false; static constexpr int KH0 = -1, KH1 = -1;
    bf16_t* O; const float* bias;
    __device__ __forceinline__ void operator()(const f32x4 (&acc)[2][2][4][2], const Unit& u, int wr, int wc, int fr, int fq) const {
        const int row0 = u.pm * BM + wr * 64 + fr, col0 = u.pn * BM + wc * 32 + 8 * fq;
        f32x4 bv[2][2];
#pragma unroll
        for (int bj = 0; bj < 2; ++bj)
#pragma unroll
            for (int n = 0; n < 2; ++n) bv[bj][n] = *(const f32x4*)(bias + col0 + bj * HALF + 4 * n);
#pragma unroll
        for (int ai = 0; ai < 2; ++ai)
#pragma unroll
            for (int m = 0; m < 4; ++m) { bf16_t* rowp = O + (size_t)(row0 + ai * HALF + m * 16) * 4096 + col0;
#pragma unroll
                for (int bj = 0; bj < 2; ++bj) { f32x4 v0 = acc[ai][bj][m][0] + bv[bj][0], v1 = acc[ai][bj][m][1] + bv[bj][1];
#pragma unroll
                    for (int j = 0; j < 4; j += 2) { f32x2e a = (f32x2e){fmaxf(v0[j], 0.f), fmaxf(v0[j + 1], 0.f)}, b = (f32x2e){fmaxf(v1[j], 0.f), fmaxf(v1[j + 1], 0.f)}; a = a * a; b = b * b;
                        v0[j] = a.x; v0[j + 1] = a.y; v1[j] = b.x; v1[j + 1] = b.y; }
                    u32x4 w; w.x = cvt_pk_bf16(v0[0], v0[1]); w.y = cvt_pk_bf16(v0[2], v0[3]); w.z = cvt_pk_bf16(v1[0], v1[1]); w.w = cvt_pk_bf16(v1[2], v1[3]);
                    *(u32x4*)(rowp + bj * HALF) = w; } }
    }
};
struct EpiRes {
    static constexpr bool PERM = false, AFTER_DRAIN = false, KHOOK = false, PREFETCH = false; static constexpr int KH0 = -1, KH1 = -1;
    const float* baseP; const float* baseS;
    float* out;
    const float* bias;
    const float* gate;
    __device__ __forceinline__ void operator()(const f32x4 (&acc)[2][2][4][2], const Unit& u, int wr, int wc, int fr, int fq) const {
        const bool smp = u.pm >= 256;
        const float* bp = smp ? baseS + (size_t)(u.pm - 256) * BM * 1024 : baseP + (size_t)u.pm * BM * 1024;
        float* op = out + (size_t)u.pm * BM * 1024;
        const int col0 = u.pn * BM + wc * 32 + 4 * fq;
        f32x4 bv[2][2];
#pragma unroll
        for (int bj = 0; bj < 2; ++bj)
#pragma unroll
            for (int n = 0; n < 2; ++n) bv[bj][n] = *(const f32x4*)(bias + col0 + bj * HALF + n * 16);
#pragma unroll
        for (int ai = 0; ai < 2; ++ai)
#pragma unroll
            for (int m = 0; m < 4; ++m) { const int lr = ai * HALF + wr * 64 + m * 16 + fr;
                const int b = smp ? 16 + (u.pm - 256) * 16 + (lr >> 4) : (u.pm >> 4);
                const float* gp = gate + (size_t)b * 6144 + col0; const size_t off = (size_t)lr * 1024 + col0;
#pragma unroll
                for (int bj = 0; bj < 2; ++bj)
#pragma unroll
                    for (int n = 0; n < 2; ++n) { const f32x4 g = *(const f32x4*)(gp + bj * HALF + n * 16), x = *(const f32x4*)(bp + off + bj * HALF + n * 16);
                        *(f32x4*)(op + off + bj * HALF + n * 16) = x + g * (acc[ai][bj][m][n] + bv[bj][n]); }
                asm volatile("" ::: "memory"); }
    }
};


struct ProjOrder : StaticOrder {
    __host__ __device__ bool next(int i, Unit& u) const { if (!StaticOrder::next(i, u)) return false; if (u.pn == 2) u.pn = 3; else if (u.pn == 3) u.pn = 2; return true; }
};
struct PanelOrder {
    int nunits, G, v;
    __host__ __device__ void init(int M, int G_, int v_) { nunits = (M / BM) * 4; G = G_; v = v_; }
    __host__ __device__ bool next(int i, Unit& u) const { const int L = i * G + v; if (L >= nunits) return false; u.pm = L >> 2; u.pn = L & 3; return true; }
    __device__ __forceinline__ void a_ready(const Unit&) const {}
    __device__ __forceinline__ void done(const Unit&) const {}
};
template <int MODE> struct EpiResNorm {
    #ifdef AB_NO_KHOOK
    static constexpr bool PERM = true, AFTER_DRAIN = false, KHOOK = false, PREFETCH = false;
#else
    static constexpr bool PERM = true, AFTER_DRAIN = false, KHOOK = (MODE == 0), PREFETCH = false;
#endif
    static constexpr int KH0 = 8, KH1 = 16;
    const float* baseP; const float* baseS; float* out; const float* bias; const float* gate;
    unsigned* xslots;
    unsigned* cnt;
    PG8_LAS unsigned char* ldsx;
    bf16_t* H; const float* A2; const float* sh2;
    const float* ssq;
    const float* fw;
    bf16_t* x1b;
    __device__ __forceinline__ void prefetch(const Unit& u, int wid) const {
        int tid = threadIdx.x; asm volatile("" : "+v"(tid));
        const float* bp = (u.pm >= 256 ? baseS + (size_t)(u.pm - 256) * BM * 1024 : baseP + (size_t)u.pm * BM * 1024) + u.pn * BM;
#pragma unroll
        for (int i = 0; i < 4; ++i) { const int line = tid + 512 * i;
            __builtin_amdgcn_global_load_lds((const unsigned*)(bp + (size_t)(line >> 3) * 1024 + (line & 7) * 32), (PG8_LAS unsigned*)(ldsx + 7168 + wid * 256), 4, 0, 0); }
    }
    __device__ __forceinline__ void prep(const Unit& u) const {
        int tid = threadIdx.x; asm volatile("" : "+v"(tid));
        if (tid < 256) { const f32x4* p = (const f32x4*)(ssq + (size_t)(u.pm * BM + tid) * 16); const f32x4 a = p[0], b = p[1], c = p[2], d = p[3];
            const float s0 = ((a.x + a.y) + (a.z + a.w)) + ((b.x + b.y) + (b.z + b.w)), s1 = ((c.x + c.y) + (c.z + c.w)) + ((d.x + d.y) + (d.z + d.w));
            const float r0 = 1.0f / sqrtf(s0 * (1.f / 512.f) + 1e-6f), r1 = 1.0f / sqrtf(s1 * (1.f / 512.f) + 1e-6f);
            PG8_LAS float* t = (PG8_LAS float*)ldsx; t[tid] = r0 / r1; t[256 + tid] = r1; }
    }
    __device__ __forceinline__ void khook(f32x4 (&acc)[2][2][4][2], int t, int wr, int fr_) const {
        int fr = fr_; asm volatile("" : "+v"(fr));
        const PG8_LAS float* tb = (const PG8_LAS float*)ldsx + (t == KH0 ? 0 : 256);
#pragma unroll
        for (int ai = 0; ai < 2; ++ai)
#pragma unroll
            for (int m = 0; m < 4; ++m) { const float f = tb[ai * HALF + wr * 64 + m * 16 + fr];
#pragma unroll
                for (int bj = 0; bj < 2; ++bj)
#pragma unroll
                    for (int n = 0; n < 2; ++n) acc[ai][bj][m][n] = acc[ai][bj][m][n] * f; }
    }
    __device__ __forceinline__ void operator()(f32x4 (&acc)[2][2][4][2], const Unit& u, int wr, int wc, int fr_, int fq_) const {
        int tid = threadIdx.x, fr = fr_, fq = fq_;
        asm volatile("" : "+v"(tid), "+v"(fr), "+v"(fq));
        const int lane = tid & 63, wid = __builtin_amdgcn_readfirstlane(tid >> 6);
        const bool smp = u.pm >= 256;
        const float* bp = smp ? baseS + (size_t)(u.pm - 256) * BM * 1024 : baseP + (size_t)u.pm * BM * 1024;
        float* op = out + (size_t)u.pm * BM * 1024;
        const int col0 = u.pn * BM + wc * 32 + 8 * fq;
        PG8_LAS float* P = (PG8_LAS float*)(ldsx + 2048); PG8_LAS float* S = (PG8_LAS float*)(ldsx + 6144);
#pragma unroll
        for (int bj = 0; bj < 2; ++bj)
#pragma unroll
            for (int n = 0; n < 2; ++n) { const f32x4 bv = *(const f32x4*)(bias + col0 + bj * HALF + n * 4);
#pragma unroll
                for (int ai = 0; ai < 2; ++ai)
#pragma unroll
                    for (int m = 0; m < 4; ++m) acc[ai][bj][m][n] += bv; }
        const int b = u.pm >> 4;
        f32x4 gv[2][2];
#pragma unroll
        for (int bj = 0; bj < 2; ++bj)
#pragma unroll
            for (int n = 0; n < 2; ++n) gv[bj][n] = *(const f32x4*)(gate + (size_t)b * 6144 + col0 + bj * HALF + n * 4);
#pragma unroll
        for (int ai = 0; ai < 2; ++ai)
#pragma unroll
            for (int m = 0; m < 4; ++m) { const int lr = ai * HALF + wr * 64 + m * 16 + fr;
                const size_t off = (size_t)lr * 1024 + col0; float s = 0.f;
#pragma unroll
                for (int bj = 0; bj < 2; ++bj) { f32x4 x0, x1;
                    if constexpr (MODE == 0) { x0 = *(const f32x4*)(bp + off + bj * HALF); x1 = *(const f32x4*)(bp + off + bj * HALF + 4); }
                    else { const u32x4 xw = *(const u32x4*)(x1b + (size_t)(u.pm * BM + lr) * 2048 + col0 + bj * HALF);
                        x0 = (f32x4){__uint_as_float(xw.x << 16), __uint_as_float(xw.x & 0xffff0000u), __uint_as_float(xw.y << 16), __uint_as_float(xw.y & 0xffff0000u)};
                        x1 = (f32x4){__uint_as_float(xw.z << 16), __uint_as_float(xw.z & 0xffff0000u), __uint_as_float(xw.w << 16), __uint_as_float(xw.w & 0xffff0000u)}; }
                    const f32x4 g0 = gv[bj][0], g1 = gv[bj][1];
                    const f32x4 v0 = x0 + g0 * acc[ai][bj][m][0], v1 = x1 + g1 * acc[ai][bj][m][1]; acc[ai][bj][m][0] = v0; acc[ai][bj][m][1] = v1;
                    { const f32x4 q = v0 * v0 + v1 * v1; s += (q.x + q.y) + (q.z + q.w); } }
                s += __shfl_xor(s, 16); s += __shfl_xor(s, 32);
                if (fq == 0) P[lr * 4 + wc] = s;
                asm volatile("" : "+v"(acc[ai][0][m][0]), "+v"(acc[ai][0][m][1]), "+v"(acc[ai][1][m][0]), "+v"(acc[ai][1][m][1]));
                if (m == 3 && MODE == 0) asm volatile("" ::: "memory"); }
        asm volatile("s_waitcnt lgkmcnt(0)" ::: "memory"); __builtin_amdgcn_s_barrier(); asm volatile("" ::: "memory");
        if (tid < 256) { const f32x4 p4 = *(const PG8_LAS f32x4*)(P + tid * 4); const float t = (p4.x + p4.y) + (p4.z + p4.w);
            __hip_atomic_store(xslots + ((size_t)(u.pm * BM + tid) * 4 + u.pn), __float_as_uint(t), __ATOMIC_RELAXED, __HIP_MEMORY_SCOPE_AGENT); }
        asm volatile("s_waitcnt vmcnt(0)" ::: "memory");
        if (wid < 4 && lane == 0) __hip_atomic_fetch_add(cnt + 64 * u.pm, 1u, __ATOMIC_RELAXED, __HIP_MEMORY_SCOPE_AGENT);
        if (wid == 0) { unsigned sp = 0;
            while ((unsigned)__builtin_amdgcn_readfirstlane(__hip_atomic_load(cnt + 64 * u.pm, __ATOMIC_RELAXED, __HIP_MEMORY_SCOPE_AGENT)) < 16u) { __builtin_amdgcn_s_sleep(2); if (++sp > (1u << 22)) break; }
            }
        asm volatile("s_waitcnt vmcnt(0) lgkmcnt(0)" ::: "memory"); __builtin_amdgcn_s_barrier(); asm volatile("" ::: "memory");
        if (tid < 256) { const unsigned* sl = xslots + (size_t)(u.pm * BM + tid) * 4; float t = 0.f;
#pragma unroll
            for (int q = 0; q < 4; ++q) t += __uint_as_float(__hip_atomic_load(sl + q, __ATOMIC_RELAXED, __HIP_MEMORY_SCOPE_AGENT));
            S[tid] = 1.0f / sqrtf(t * (1.f / 1024.f) + 1e-6f); }
        asm volatile("s_waitcnt lgkmcnt(0)" ::: "memory"); __builtin_amdgcn_s_barrier(); asm volatile("" ::: "memory");
        f32x4 pa[2][2], pb[2][2];
#pragma unroll
        for (int bj = 0; bj < 2; ++bj)
#pragma unroll
            for (int n = 0; n < 2; ++n) {
                if constexpr (MODE == 0) { pa[bj][n] = *(const f32x4*)(A2 + (size_t)b * 1024 + col0 + bj * HALF + n * 4); pb[bj][n] = *(const f32x4*)(sh2 + (size_t)b * 6144 + col0 + bj * HALF + n * 4); }
                else { pa[bj][n] = *(const f32x4*)(fw + col0 + bj * HALF + n * 4); pb[bj][n] = pa[bj][n]; } }
#pragma unroll
        for (int ai = 0; ai < 2; ++ai)
#pragma unroll
            for (int m = 0; m < 4; ++m) { const int lr = ai * HALF + wr * 64 + m * 16 + fr; const float rs = S[lr]; const size_t off = (size_t)lr * 1024 + col0;
                if constexpr (MODE == 0) {
                    bf16_t* hp = H + (size_t)(u.pm * BM + lr) * 1024 + col0;
#pragma unroll
                    for (int bj = 0; bj < 2; ++bj) { const f32x4 v0 = acc[ai][bj][m][0], v1 = acc[ai][bj][m][1];
                        { u32x4 xw; xw.x = cvt_pk_bf16(v0.x, v0.y); xw.y = cvt_pk_bf16(v0.z, v0.w); xw.z = cvt_pk_bf16(v1.x, v1.y); xw.w = cvt_pk_bf16(v1.z, v1.w); *(u32x4*)(x1b + (size_t)(u.pm * BM + lr) * 2048 + col0 + bj * HALF) = xw; }
                        const f32x4 h0 = v0 * rs * pa[bj][0] + pb[bj][0], h1 = v1 * rs * pa[bj][1] + pb[bj][1];
                        u32x4 w; w.x = cvt_pk_bf16(h0.x, h0.y); w.y = cvt_pk_bf16(h0.z, h0.w); w.z = cvt_pk_bf16(h1.x, h1.y); w.w = cvt_pk_bf16(h1.z, h1.w); *(u32x4*)(hp + bj * HALF) = w; }
                } else {
#pragma unroll
                    for (int bj = 0; bj < 2; ++bj)
#pragma unroll
                        for (int n = 0; n < 2; ++n) *(f32x4*)(op + off + bj * HALF + n * 4) = acc[ai][bj][m][n] * rs * pa[bj][n];
                }
                asm volatile("" ::: "memory"); }
    }
};

struct TwiceOrder : StaticOrder {
    int R;
    __host__ __device__ void init2(int M, int N, int G_, int c_) { init(M, N, G_, c_); R = (nwg + G - 1) / G; }
    __host__ __device__ bool next(int i, Unit& u) const { if (i >= 2 * R) return false; return StaticOrder::next(i % R, u) ? true : StaticOrder::next(0, u); }
};
template <class Epi, class Sched, bool ALIGN_EPI = false, bool SP2 = false>
__device__ __forceinline__ void gemm_phase(PG8_LAS unsigned char* lds, const Gemm g, const Sched& S, const Epi& E) {
    const int tid = threadIdx.x, wid = __builtin_amdgcn_readfirstlane(tid >> 6), lane = tid & 63, wr = wid >> 2, wc = wid & 3, fr = lane & 15, fq = lane >> 4;
    const int K = g.K, nt = K / BK;
    unsigned voffA[2], voffB[2];
#pragma unroll
    for (int i = 0; i < 2; ++i) { int R, C; stage_rc(tid * 16 + i * 8192, R, C); const int Rb = Epi::PERM ? ((R & ~31) + perm32(R & 31)) : R;
        voffA[i] = (unsigned)(R * K + C) * 2u; voffB[i] = (unsigned)(Rb * K + C) * 2u; }
    const size_t kstep = (size_t)(BK * 2);
    const size_t hstep = (size_t)HALF * K * 2;
    const size_t tstep = 2 * hstep;
    const unsigned ldsw = (unsigned)wid * 1024u;
    const int aoff = lds_byte(wr * 64 + fr, fq * 8), boff = lds_byte(wc * 32 + fr, fq * 8);
#define PG8_SA(b, h) (((b) * 2 + (h)) * HTB)
#define PG8_SB(b, h) ((4 + (b) * 2 + (h)) * HTB)
#define PG8_STAGE(bufoff, gbase, voff) do { _Pragma("unroll") for (int _i = 0; _i < 2; ++_i) \
        __builtin_amdgcn_global_load_lds((const unsigned*)((const char*)(gbase) + (voff)[_i]), (PG8_LAS unsigned*)(lds + (bufoff) + ldsw + _i * 8192), 16, 0, 0); } while (0)
#define PG8_LDA(dst, b, h) do { _Pragma("unroll") for (int m = 0; m < 4; ++m) _Pragma("unroll") for (int k = 0; k < 2; ++k) dst[m][k] = *(const PG8_LAS bf16x8*)(lds + PG8_SA(b, h) + aoff + m * 2048 + k * 1024); } while (0)
#define PG8_LDB(dst, b, h) do { _Pragma("unroll") for (int n = 0; n < 2; ++n) _Pragma("unroll") for (int k = 0; k < 2; ++k) dst[n][k] = *(const PG8_LAS bf16x8*)(lds + PG8_SB(b, h) + boff + n * 2048 + k * 1024); } while (0)
#define PG8_MMA(ai, bj, At, Bt) do { __builtin_amdgcn_s_setprio(1); _Pragma("unroll") for (int m = 0; m < 4; ++m) _Pragma("unroll") for (int n = 0; n < 2; ++n) _Pragma("unroll") for (int k = 0; k < 2; ++k) \
        acc[ai][bj][m][n] = __builtin_amdgcn_mfma_f32_16x16x32_bf16(Bt[n][k], At[m][k], acc[ai][bj][m][n], 0, 0, 0); __builtin_amdgcn_s_setprio(0); } while (0)
#define PG8_WAIT_V(n) asm volatile("s_waitcnt vmcnt(" #n ")" ::: "memory")
#define PG8_WAIT_L(n) asm volatile("s_waitcnt lgkmcnt(" #n ")" ::: "memory")
#define PG8_BAR __builtin_amdgcn_s_barrier()
#define PG8_SCHED __builtin_amdgcn_sched_barrier(0)
    Unit cur, nxt; int ui = 0;
    if (!S.next(0, cur)) return;
    f32x4 acc[2][2][4][2];
#pragma unroll
    for (int a = 0; a < 2; ++a)
#pragma unroll
        for (int b = 0; b < 2; ++b)
#pragma unroll
            for (int m = 0; m < 4; ++m)
#pragma unroll
                for (int n = 0; n < 2; ++n) acc[a][b][m][n] = (f32x4){0.f, 0.f, 0.f, 0.f};
    bf16x8 At[4][2], B0[2][2], B1[2][2];
    const char* cA = (const char*)g.A + (size_t)cur.pm * tstep; const char* cB = (const char*)g.Bt + (size_t)cur.pn * tstep;
    S.a_ready(cur);
    if constexpr (Epi::KHOOK) E.prep(cur);
    if constexpr (SP2) {
        PG8_STAGE(PG8_SB(0, 0), cB, voffB); PG8_STAGE(PG8_SB(0, 1), cB + hstep, voffB); PG8_STAGE(PG8_SA(0, 0), cA, voffA); PG8_STAGE(PG8_SA(0, 1), cA + hstep, voffA);
        if (wr == 1) PG8_BAR;
        PG8_WAIT_V(2); PG8_BAR;
        PG8_STAGE(PG8_SB(1, 0), cB + kstep, voffB); PG8_STAGE(PG8_SA(1, 0), cA + kstep, voffA); PG8_STAGE(PG8_SB(1, 1), cB + hstep + kstep, voffB);
        PG8_WAIT_V(6); PG8_BAR;
    } else {
        PG8_STAGE(PG8_SB(0, 0), cB, voffB); PG8_STAGE(PG8_SA(0, 0), cA, voffA); PG8_STAGE(PG8_SB(0, 1), cB + hstep, voffB); PG8_STAGE(PG8_SA(0, 1), cA + hstep, voffA);
        if (wr == 1) PG8_BAR;
        PG8_WAIT_V(4); PG8_BAR;
        PG8_STAGE(PG8_SB(1, 0), cB + kstep, voffB); PG8_STAGE(PG8_SA(1, 0), cA + kstep, voffA); PG8_STAGE(PG8_SB(1, 1), cB + hstep + kstep, voffB);
        PG8_WAIT_V(6); PG8_BAR;
    }
    for (;;) {
        const bool has_next = S.next(ui + 1, nxt);
        const char* nA = has_next ? (const char*)g.A + (size_t)nxt.pm * tstep : cA; const char* nB = has_next ? (const char*)g.Bt + (size_t)nxt.pn * tstep : cB;
        for (int t = 0; t < nt; t += 2) {
            const bool last = (t == nt - 2);
            const char* a1 = cA + (size_t)(t + 1) * kstep;
            const char* a2 = last ? nA : cA + (size_t)(t + 2) * kstep; const char* b2 = last ? nB : cB + (size_t)(t + 2) * kstep;
            const char* a3 = a2 + kstep; const char* b3 = b2 + kstep;
            if (last && has_next) S.a_ready(nxt);
            if constexpr (Epi::KHOOK) { if (t == Epi::KH0 || t == Epi::KH1) E.khook(acc, t, wr, fr); }
            if constexpr (Epi::PREFETCH) { if (t == nt - 4) E.prefetch(cur, wid); }
            if constexpr (SP2) {
            PG8_LDB(B0, 0, 0); PG8_LDB(B1, 0, 1); PG8_SCHED; PG8_LDA(At, 0, 0); PG8_STAGE(PG8_SA(1, 1), a1 + hstep, voffA);
            PG8_WAIT_V(8); PG8_WAIT_L(0); PG8_BAR; PG8_MMA(0, 0, At, B0); PG8_MMA(0, 1, At, B1); PG8_BAR; PG8_SCHED;
            PG8_LDA(At, 0, 1); PG8_STAGE(PG8_SB(0, 0), b2, voffB); PG8_STAGE(PG8_SB(0, 1), b2 + hstep, voffB); PG8_STAGE(PG8_SA(0, 0), a2, voffA);
            PG8_WAIT_V(8); PG8_WAIT_L(0); PG8_BAR; PG8_MMA(1, 0, At, B0); PG8_MMA(1, 1, At, B1); PG8_BAR; PG8_SCHED;
            PG8_LDB(B0, 1, 0); PG8_LDB(B1, 1, 1); PG8_SCHED; PG8_LDA(At, 1, 0); PG8_STAGE(PG8_SA(0, 1), a2 + hstep, voffA);
            PG8_WAIT_V(8); PG8_WAIT_L(0); PG8_BAR; PG8_MMA(0, 0, At, B0); PG8_MMA(0, 1, At, B1); PG8_BAR; PG8_SCHED;
            PG8_LDA(At, 1, 1); PG8_STAGE(PG8_SB(1, 0), b3, voffB); PG8_STAGE(PG8_SB(1, 1), b3 + hstep, voffB); PG8_STAGE(PG8_SA(1, 0), a3, voffA);
            PG8_WAIT_V(8); PG8_WAIT_L(0); PG8_BAR; PG8_MMA(1, 0, At, B0); PG8_MMA(1, 1, At, B1); PG8_BAR; PG8_SCHED;
            } else {
            PG8_LDB(B0, 0, 0); PG8_SCHED; PG8_LDA(At, 0, 0); PG8_STAGE(PG8_SA(1, 1), a1 + hstep, voffA);
            PG8_WAIT_L(8); PG8_BAR; PG8_WAIT_L(0); PG8_MMA(0, 0, At, B0); PG8_BAR; PG8_SCHED;
            PG8_LDB(B1, 0, 1); PG8_STAGE(PG8_SB(0, 0), b2, voffB);
            PG8_BAR; PG8_WAIT_L(0); PG8_MMA(0, 1, At, B1); PG8_BAR;
            PG8_LDA(At, 0, 1); PG8_STAGE(PG8_SA(0, 0), a2, voffA);
            PG8_BAR; PG8_WAIT_L(0); PG8_MMA(1, 0, At, B0); PG8_BAR; PG8_SCHED;
            PG8_STAGE(PG8_SB(0, 1), b2 + hstep, voffB);
            PG8_WAIT_V(6); PG8_BAR; PG8_MMA(1, 1, At, B1); PG8_BAR;
            PG8_LDB(B0, 1, 0); PG8_SCHED; PG8_LDA(At, 1, 0); PG8_STAGE(PG8_SA(0, 1), a2 + hstep, voffA);
            PG8_WAIT_L(8); PG8_BAR; PG8_WAIT_L(0); PG8_MMA(0, 0, At, B0); PG8_BAR; PG8_SCHED;
            PG8_LDB(B1, 1, 1); PG8_STAGE(PG8_SB(1, 0), b3, voffB);
            PG8_BAR; PG8_WAIT_L(0); PG8_MMA(0, 1, At, B1); PG8_BAR;
            PG8_LDA(At, 1, 1); PG8_STAGE(PG8_SA(1, 0), a3, voffA);
            PG8_BAR; PG8_WAIT_L(0); PG8_MMA(1, 0, At, B0); PG8_BAR; PG8_SCHED;
            PG8_STAGE(PG8_SB(1, 1), b3 + hstep, voffB);
            PG8_WAIT_V(6); PG8_BAR; PG8_MMA(1, 1, At, B1); PG8_BAR;
            }
        }
        if constexpr (ALIGN_EPI) { if (wr == 0) PG8_BAR; }
        if constexpr (!Epi::AFTER_DRAIN) { E(acc, cur, wr, wc, fr, fq); S.done(cur); }
        if constexpr (Epi::KHOOK) { if (has_next) E.prep(nxt); }
        if (!has_next) break;
#pragma unroll
        for (int a = 0; a < 2; ++a)
#pragma unroll
            for (int b = 0; b < 2; ++b)
#pragma unroll
                for (int m = 0; m < 4; ++m)
#pragma unroll
                    for (int n = 0; n < 2; ++n) acc[a][b][m][n] = (f32x4){0.f, 0.f, 0.f, 0.f};
        cur = nxt; cA = nA; cB = nB; ++ui;
        if constexpr (ALIGN_EPI) { if (wr == 1) PG8_BAR; }
    }
    PG8_WAIT_V(0);
    if constexpr (!ALIGN_EPI) { if (wr == 0) PG8_BAR; }
    PG8_BAR;
    if constexpr (Epi::AFTER_DRAIN) { E.fused(acc, cur, wr, wc, fr, fq, lds, wid, lane); S.done(cur); }
#undef PG8_SA
#undef PG8_SB
#undef PG8_STAGE
#undef PG8_LDA
#undef PG8_LDB
#undef PG8_MMA
#undef PG8_WAIT_V
#undef PG8_WAIT_L
#undef PG8_BAR
#undef PG8_SCHED
}
}
constexpr size_t MiB = 1u << 20;
constexpr size_t WS_CTL = 0, CTL_ZERO_BYTES = 448 * 1024;
constexpr size_t WS_MOD = 1 * MiB;
constexpr size_t WS_BIASA = 2 * MiB + 512 * 1024;
constexpr size_t WS_A2 = 2 * MiB + 640 * 1024;
constexpr size_t WS_XSL = 944 * MiB;
constexpr size_t WS_WIN = 3 * MiB, WS_WOUT = 10 * MiB, WS_W1 = 14 * MiB, WS_W2 = 22 * MiB;
constexpr size_t WS_H = 32 * MiB;
constexpr size_t WS_PROJ = 161 * MiB;
constexpr size_t WS_DT = 613 * MiB;
constexpr size_t WS_MIX = 680 * MiB;
constexpr size_t WS_SSQ = 938 * MiB;
constexpr size_t WS_HMID = 161 * MiB;
constexpr size_t WS_END = 952 * MiB;
static_assert(WS_H + (size_t)MT * DM * 2 <= WS_PROJ && WS_PROJ + (size_t)MT * NPROJ * 2 <= WS_DT && WS_DT + (size_t)MT * 16 * 4 <= WS_MIX && WS_MIX + (size_t)MT * MIXW * 2 <= WS_SSQ
              && WS_SSQ + (size_t)MT * 16 * 4 <= WS_XSL && WS_HMID + (size_t)MT * DFF * 2 <= WS_MIX && WS_XSL + (size_t)6 * MT * 16 <= WS_END && WS_MOD + (size_t)NBT * NMOD * 4 <= WS_BIASA && WS_W2 + (size_t)DM * DFF * 2 <= WS_H, "d_ws map");

constexpr int NWAVES = 8;
constexpr int RING_OFF = 0, RING_BYTES = 131072;
constexpr int LDS_BYTES = 147456;

#define GAS __attribute__((address_space(1)))
#define LAS __attribute__((address_space(3)))
typedef unsigned short bf16;
typedef unsigned v4u __attribute__((ext_vector_type(4)));
typedef unsigned v2u __attribute__((ext_vector_type(2)));
typedef float f32x4 __attribute__((ext_vector_type(4)));
typedef float f32x2v __attribute__((ext_vector_type(2)));
#define LDS_WAIT() asm volatile("s_waitcnt lgkmcnt(0)" ::: "memory")
__device__ __forceinline__ unsigned f2bf(float f) { unsigned u = __builtin_bit_cast(unsigned, f); return (u + 0x7fffu + ((u >> 16) & 1u)) >> 16; }
__device__ __forceinline__ unsigned pk2(float lo, float hi) { unsigned r; asm("v_cvt_pk_bf16_f32 %0, %1, %2" : "=v"(r) : "v"(lo), "v"(hi)); return r; }
__device__ __forceinline__ float bflo(unsigned w) { return __builtin_bit_cast(float, w << 16); }
__device__ __forceinline__ float bfhi(unsigned w) { return __builtin_bit_cast(float, w & 0xffff0000u); }
__device__ __forceinline__ float wave_sum(float v) {
#pragma unroll
    for (int o = 1; o < 64; o <<= 1) v += __shfl_xor(v, o);
    return v;
}
__device__ __forceinline__ float silu_f(float x) { return x / (1.f + __expf(-x)); }
#define DPP_F(v, ctrl, rmask) __builtin_bit_cast(float, __builtin_amdgcn_update_dpp(0, __builtin_bit_cast(int, (v)), (ctrl), (rmask), 0xf, false))
__device__ __forceinline__ float wave_scan_incl(float v) {
    v += DPP_F(v, 0x111, 0xf); v += DPP_F(v, 0x112, 0xf); v += DPP_F(v, 0x114, 0xf); v += DPP_F(v, 0x118, 0xf);
    v += DPP_F(v, 0x142, 0xa);
    v += DPP_F(v, 0x143, 0xc);
    return v;
}
__device__ __forceinline__ float ex2(float x) { return __builtin_amdgcn_exp2f(x); }
__device__ __forceinline__ float silu_fast(float x) { return x * __builtin_amdgcn_rcpf(1.f + __expf(-x)); }

typedef GAS unsigned gu32;
typedef GAS unsigned long long gu64;
#define RLX_AGENT __ATOMIC_RELAXED, __HIP_MEMORY_SCOPE_AGENT
constexpr int CW_TMO = 0, CW_CODE = 1, CW_BAR = 4096, CW_SEAM = 16384, SEAM_BANK = 320 * 64;
constexpr int LDSX_OFF = RING_BYTES + 512;
static_assert((size_t)(CW_SEAM + 4 * SEAM_BANK + 2 * 8 * 64) * 4 <= CTL_ZERO_BYTES, "every polled word is inside the per-call memset");
constexpr int LDSCTL_OFF = RING_BYTES, MISC_OFF = LDSCTL_OFF + 320;
#define XB_TMO      128
#define XB_XCNT(j)  (256  + 64 * (j))
#define XB_XSUB(j)  (1280 + 64 * (j))
#define XB_XGEN(j)  (2304 + 64 * (j))
#define XB_TOP      3328
#define XB_TOPGEN   3392
#define XCD_BAR_WORDS 3456
#define XB_SPIN_CAP (1u << 18)

__device__ __forceinline__ unsigned xb_ld(unsigned* p)              { return __hip_atomic_load(p, __ATOMIC_RELAXED, __HIP_MEMORY_SCOPE_AGENT); }
__device__ __forceinline__ unsigned xb_add(unsigned* p, unsigned v) { return __hip_atomic_fetch_add(p, v, __ATOMIC_RELAXED, __HIP_MEMORY_SCOPE_AGENT); }
__device__ __forceinline__ unsigned xb_xcc_id() { return (unsigned)__builtin_amdgcn_s_getreg((3 << 11) | 20) & 0xFu; }
#define XB_SPIN(cond, bar) do { unsigned _sp = 0; while (cond) { __builtin_amdgcn_s_sleep(1); \
    if ((++_sp & 255u) == 0u) { if (xb_ld(&(bar)[XB_TMO])) break; if (_sp > XB_SPIN_CAP) { atomicAdd(&(bar)[XB_TMO], 1u); break; } } } } while (0)

struct XcdBarrier {
    unsigned* bar; unsigned x;
    volatile LAS unsigned* st;
};

__device__ __forceinline__ XcdBarrier xcd_barrier_post(unsigned* bar, volatile LAS unsigned* st) {
    XcdBarrier b; b.bar = bar; b.x = xb_xcc_id(); b.st = st;
    if (threadIdx.x == 0) (void)xb_add(&bar[XB_XCNT(b.x)], 1u);
    return b;
}
__device__ __forceinline__ void xcd_barrier_complete(unsigned* bar, unsigned x, unsigned& nloc, unsigned& nx) {
    const unsigned G = gridDim.x * gridDim.y * gridDim.z;
    unsigned sum, cnt, mine, sp = 0u;
    for (;;) {
        sum = 0u; cnt = 0u; mine = 0u;
#pragma unroll
        for (unsigned j = 0; j < 16; ++j) { const unsigned c = xb_ld(&bar[XB_XCNT(j)]); sum += c; cnt += (c > 0u) ? 1u : 0u; mine = (j == x) ? c : mine; }
        if (sum == G) break;
        __builtin_amdgcn_s_sleep(1);
        if ((++sp & 255u) == 0u) { if (xb_ld(&bar[XB_TMO])) break; if (sp > XB_SPIN_CAP) { atomicAdd(&bar[XB_TMO], 1u); break; } }
    }
    nloc = mine > 0u ? mine : 1u; nx = cnt > 0u ? cnt : 1u;
}

__device__ __forceinline__ void xcd_barrier(const XcdBarrier& b) {
    asm volatile("s_waitcnt vmcnt(0)" ::: "memory");
    __syncthreads();
    if (threadIdx.x == 0) {
        unsigned* bar = b.bar;
        __builtin_amdgcn_s_waitcnt(0);
        unsigned nloc = b.st[0], nx = b.st[1];
        if (nloc == 0u) { xcd_barrier_complete(bar, b.x, nloc, nx); b.st[0] = nloc; b.st[1] = nx; }
        const unsigned old = xb_add(&bar[XB_XSUB(b.x)], 1u);
        const unsigned gen = old / nloc;
        if (old + 1u == (gen + 1u) * nloc) {
            __builtin_amdgcn_fence(__ATOMIC_RELEASE, "agent");
            asm volatile("s_waitcnt vmcnt(0)" ::: "memory");
            const unsigned og = xb_add(&bar[XB_TOP], 1u);
            const unsigned tg = og / nx;
            if (og + 1u == (tg + 1u) * nx) xb_add(&bar[XB_TOPGEN], 1u);
            else XB_SPIN(xb_ld(&bar[XB_TOPGEN]) == tg, bar);
            __builtin_amdgcn_fence(__ATOMIC_ACQUIRE, "agent");
            xb_add(&bar[XB_XGEN(b.x)], 1u);
            asm volatile("s_waitcnt vmcnt(0)" ::: "memory");
        } else {
            XB_SPIN(xb_ld(&bar[XB_XGEN(b.x)]) == gen, bar);
            __builtin_amdgcn_fence(__ATOMIC_ACQUIRE, "agent");
            asm volatile("s_waitcnt vmcnt(0)" ::: "memory");
        }
    }
    __syncthreads();
}

typedef short bf16x8 __attribute__((ext_vector_type(8)));
typedef short s16x4 __attribute__((ext_vector_type(4)));
#define MFMA16(a, b, c) __builtin_amdgcn_mfma_f32_16x16x32_bf16((a), (b), (c), 0, 0, 0)
__device__ __forceinline__ unsigned offb(unsigned row, unsigned ch) { return 256u * row + 16u * (ch ^ (((row & 3u) << 2) | ((row >> 2) & 3u))); }
__device__ __forceinline__ bf16x8 frag_row(LAS unsigned char* img, int lane, int rb, int s) { return *(const LAS bf16x8*)(img + offb((unsigned)((lane & 15) + 16 * rb), (unsigned)(4 * s + (lane >> 4)))); }
__device__ __forceinline__ unsigned offr(unsigned row, unsigned ch) { return 256u * row + 16u * (ch ^ (row & 15u)); }
__device__ __forceinline__ bf16x8 frag_rowr(LAS unsigned char* img, int lane, int rb, int s) { return *(const LAS bf16x8*)(img + offr((unsigned)((lane & 15) + 16 * rb), (unsigned)(4 * s + (lane >> 4)))); }
__device__ __forceinline__ bf16x8 frag_tr(LAS unsigned char* img, int lane, int c, int ks) {
    const unsigned g = (unsigned)lane >> 4, q = ((unsigned)lane & 15u) >> 2, p = (unsigned)lane & 3u;
    const s16x4 t0 = __builtin_amdgcn_ds_read_tr16_b64_v4i16((LAS s16x4*)(img + offb(32u * ks + 8u * g + q, 2u * c + (p >> 1)) + 8u * (p & 1u)));
    const s16x4 t1 = __builtin_amdgcn_ds_read_tr16_b64_v4i16((LAS s16x4*)(img + offb(32u * ks + 8u * g + 4u + q, 2u * c + (p >> 1)) + 8u * (p & 1u)));
    return (bf16x8){t0[0], t0[1], t0[2], t0[3], t1[0], t1[1], t1[2], t1[3]};
}

struct Frame {
    LAS unsigned char* lds;
    int tid, lane, wave, vcu, G;
    const float* in[27]; float* out; unsigned char* ws;
};
#define IN_XP 0
#define IN_XS 1
#define IN_CPOOL 2
#define IN_CCONV 3
#define IN_SSM 4
#define IN_CP 5
#define IN_CS 6
#define IN_NW1 7
#define IN_NW2 8
#define IN_WADA 9
#define IN_BADA 10
#define IN_WIN 11
#define IN_POOLW 12
#define IN_POOLB 13
#define IN_POOLS 14
#define IN_CONVW 15
#define IN_CONVB 16
#define IN_DTB 17
#define IN_ALOG 18
#define IN_DSKIP 19
#define IN_SNW 20
#define IN_WOUT 21
#define IN_W1 22
#define IN_B1 23
#define IN_W2 24
#define IN_B2 25
#define IN_FNW 26

typedef float f32x2 __attribute__((ext_vector_type(2)));
__device__ __forceinline__ void p0_mod_unit(Frame& F, int u) {
    const float* w_ada = F.in[IN_WADA]; const float* b_ada = F.in[IN_BADA]; float* mod = (float*)(F.ws + WS_MOD);
    LAS float* red = (LAS float*)(F.lds + RING_OFF);
    const int lane = F.lane, li = lane & 15, kq = lane >> 4, k0 = F.wave * 128, c0 = 32 * u;
    const float* cp[3]; cp[0] = F.in[IN_CP] + (size_t)li * DM; cp[1] = F.in[IN_CS] + (size_t)li * DM; cp[2] = F.in[IN_CS] + (size_t)(16 + li) * DM;
    f32x4 acc[3][2];
#pragma unroll
    for (int mt = 0; mt < 3; ++mt) { acc[mt][0] = (f32x4){0.f, 0.f, 0.f, 0.f}; acc[mt][1] = acc[mt][0]; }
#pragma unroll
    for (int hf = 0; hf < 2; ++hf) {
        f32x4 av[4][3]; f32x2 bv[4][4];
#pragma unroll
        for (int sq = 0; sq < 4; ++sq) { const int kb = k0 + 64 * hf + 16 * sq + 4 * kq;
#pragma unroll
            for (int j = 0; j < 4; ++j) bv[sq][j] = *(const f32x2*)(w_ada + (size_t)(kb + j) * NMOD + c0 + 2 * li);
#pragma unroll
            for (int mt = 0; mt < 3; ++mt) av[sq][mt] = *(const f32x4*)(cp[mt] + kb); }
#pragma unroll
        for (int sq = 0; sq < 4; ++sq)
#pragma unroll
            for (int j = 0; j < 4; ++j)
#pragma unroll
                for (int mt = 0; mt < 3; ++mt) { const float a = silu_f(av[sq][mt][j]);
                    acc[mt][0] = __builtin_amdgcn_mfma_f32_16x16x4f32(a, bv[sq][j].x, acc[mt][0], 0, 0, 0); acc[mt][1] = __builtin_amdgcn_mfma_f32_16x16x4f32(a, bv[sq][j].y, acc[mt][1], 0, 0, 0); }
    }
#pragma unroll
    for (int mt = 0; mt < 3; ++mt)
#pragma unroll
        for (int t = 0; t < 2; ++t)
#pragma unroll
            for (int r = 0; r < 4; ++r) red[(((F.wave * 3 + mt) * 2 + t) * 4 + r) * 64 + lane] = acc[mt][t][r];
    __syncthreads();
    for (int e = F.tid; e < 768; e += NWAVES * 64) { const int mt = e >> 8, r = (e >> 6) & 3, ln = e & 63; float s0 = 0.f, s1 = 0.f;
#pragma unroll
        for (int w = 0; w < 8; ++w) { s0 += red[(((w * 3 + mt) * 2 + 0) * 4 + r) * 64 + ln]; s1 += red[(((w * 3 + mt) * 2 + 1) * 4 + r) * 64 + ln]; }
        const int batch = 16 * mt + 4 * (ln >> 4) + r, c = c0 + 2 * (ln & 15);
        *(f32x2*)(mod + (size_t)batch * NMOD + c) = (f32x2){s0 + b_ada[c], s1 + b_ada[c + 1]}; }
    __syncthreads();
}
__device__ __forceinline__ void p0_bias_unit(Frame& F, int u) {
    const float* pb = F.in[IN_POOLB]; const float* ps = F.in[IN_POOLS]; const float* wo = F.in[IN_WOUT]; LAS float* red = (LAS float*)(F.lds + RING_OFF);
    const int nn = F.tid & 15, kg = F.tid >> 4, n = 16 * u + nn; float s = 0.f;
#pragma unroll 32
    for (int k = 32 * kg; k < 32 * kg + 32; ++k) s += pb[k] * ps[k] * wo[(size_t)k * DM + n];
    red[kg * 16 + nn] = s; __syncthreads();
    if (F.tid < 16) { float t = 0.f;
#pragma unroll
        for (int q = 0; q < 32; ++q) t += red[q * 16 + F.tid];
        ((float*)(F.ws + WS_BIASA))[16 * u + F.tid] = t; }
    __syncthreads();
}
__device__ __forceinline__ void p0_mod(Frame& F) {
    for (int u = blockIdx.x; u < NMOD / 32 + DM / 16; u += F.G) { if (u < NMOD / 32) p0_mod_unit(F, u); else p0_bias_unit(F, u - NMOD / 32); }
}
__device__ __forceinline__ void p0_transpose_item(const float* W, int ldw, int nblk, bf16* WT, int ldt, int kofs, const float* kscale, LAS unsigned char* img, int item, int lane) {
    const int kb = item / nblk, nb = item % nblk, k0 = 64 * kb, n0 = 128 * nb;
    f32x4 v[32];
#pragma unroll
    for (int i = 0; i < 32; ++i) v[i] = *(const f32x4*)(W + (size_t)(k0 + 2 * i + (lane >> 5)) * ldw + n0 + 4 * (lane & 31));
#pragma unroll
    for (int i = 0; i < 32; ++i) { const int kk = 2 * i + (lane >> 5); f32x4 x = v[i]; if (kscale) x = x * kscale[k0 + kk];
        v2u o; o.x = pk2(x.x, x.y); o.y = pk2(x.z, x.w);
        *(LAS v2u*)(img + offb((unsigned)kk, (unsigned)((lane & 31) >> 1)) + 8u * (lane & 1)) = o; }
    LDS_WAIT(); asm volatile("" ::: "memory");
#pragma unroll
    for (int c8 = 0; c8 < 8; ++c8)
#pragma unroll
        for (int ks = 0; ks < 2; ++ks) { const bf16x8 f = frag_tr(img, lane, c8, ks);
            *(GAS bf16x8*)(WT + (size_t)(n0 + 16 * c8 + (lane & 15)) * ldt + kofs + k0 + 32 * ks + 8 * (lane >> 4)) = f; }
    LDS_WAIT(); asm volatile("" ::: "memory");
}
__device__ __forceinline__ void p0_weights(Frame& F) {
    LAS unsigned char* scr = F.lds + RING_OFF + F.wave * 16384;
    const int gw = F.vcu * NWAVES + F.wave, NGW = F.G * NWAVES;
    bf16* Win_t = (bf16*)(F.ws + WS_WIN); bf16* Wout_t = (bf16*)(F.ws + WS_WOUT); bf16* W1_t = (bf16*)(F.ws + WS_W1); bf16* W2_t = (bf16*)(F.ws + WS_W2);
    constexpr int I_IN = (DM / 64) * (NPROJ / 128), I_OB = (DM / 64) * (DM / 128), I_1 = (DM / 64) * (DFF / 128), I_2 = (DFF / 64) * (DM / 128);
    constexpr int NITEMS = I_IN + I_OB + I_1 + I_2;
    for (int it = gw; it < NITEMS; it += NGW) {
        int r = it;
        if (r < I_IN) { p0_transpose_item(F.in[IN_WIN], LDWIN, NPROJ / 128, Win_t, DM, 0, nullptr, scr, r, F.lane); continue; } r -= I_IN;
        if (r < I_OB) { p0_transpose_item(F.in[IN_WOUT] + (size_t)DM * DM, DM, DM / 128, Wout_t, MIXW, 0, F.in[IN_SNW], scr, r, F.lane); continue; } r -= I_OB;
        if (r < I_1) { p0_transpose_item(F.in[IN_W1], DFF, DFF / 128, W1_t, DM, 0, nullptr, scr, r, F.lane); continue; } r -= I_1;
        p0_transpose_item(F.in[IN_W2], DM, DM / 128, W2_t, DFF, 0, nullptr, scr, r, F.lane);
    }
    __syncthreads();
    { const float* pw = F.in[IN_POOLW]; const float* ps = F.in[IN_POOLS]; const float* wo = F.in[IN_WOUT];
      LAS float* As = (LAS float*)(F.lds + RING_OFF); LAS float* Bs = As + 64 * 132;
      const int li = F.lane & 15, kq = F.lane >> 4, tid = F.tid, tr = F.wave >> 1, tc = 2 * (F.wave & 1);
      for (int t = blockIdx.x; t < 256; t += F.G) { const int g = t >> 6, ti = (t >> 4) & 3, tj = t & 15;
          const float* pa = pw + (size_t)(256 * g + 64 * ti) * 256; const float* psg = ps + 256 * g; const float* pbm = wo + (size_t)(256 * g) * DM + 64 * tj;
          f32x4 acc0 = (f32x4){0.f, 0.f, 0.f, 0.f}, acc1 = acc0;
          f32x4 ra[4], rb[4], sa[4];
#pragma unroll
          for (int q = 0; q < 4; ++q) { const int idx = tid + 512 * q;
              ra[q] = *(const f32x4*)(pa + (size_t)(idx >> 5) * 256 + 4 * (idx & 31)); sa[q] = *(const f32x4*)(psg + 4 * (idx & 31)); rb[q] = *(const f32x4*)(pbm + (size_t)(idx >> 4) * DM + 4 * (idx & 15)); }
          for (int hf = 0; hf < 2; ++hf) {
              __syncthreads();
#pragma unroll
              for (int q = 0; q < 4; ++q) { const int idx = tid + 512 * q; *(LAS f32x4*)(As + (idx >> 5) * 132 + 4 * (idx & 31)) = ra[q] * sa[q]; *(LAS f32x4*)(Bs + (idx >> 4) * 68 + 4 * (idx & 15)) = rb[q]; }
              if (hf == 0) {
#pragma unroll
                  for (int q = 0; q < 4; ++q) { const int idx = tid + 512 * q;
                      ra[q] = *(const f32x4*)(pa + (size_t)(idx >> 5) * 256 + 128 + 4 * (idx & 31)); sa[q] = *(const f32x4*)(psg + 128 + 4 * (idx & 31)); rb[q] = *(const f32x4*)(pbm + (size_t)(128 + (idx >> 4)) * DM + 4 * (idx & 15)); } }
              __syncthreads();
#pragma unroll
              for (int sq = 0; sq < 8; ++sq) { const f32x4 a4 = *(const LAS f32x4*)(As + (16 * tr + li) * 132 + 16 * sq + 4 * kq);
#pragma unroll
                  for (int j = 0; j < 4; ++j) { const int d = 16 * sq + 4 * kq + j; const float b0 = Bs[d * 68 + 16 * tc + li], b1 = Bs[d * 68 + 16 * tc + 16 + li];
                      acc0 = __builtin_amdgcn_mfma_f32_16x16x4f32(a4[j], b0, acc0, 0, 0, 0); acc1 = __builtin_amdgcn_mfma_f32_16x16x4f32(a4[j], b1, acc1, 0, 0, 0); } }
          }
          bf16* Wout_t2 = (bf16*)(F.ws + WS_WOUT);
          { v2u o; o.x = pk2(acc0[0], acc0[1]); o.y = pk2(acc0[2], acc0[3]); *(GAS v2u*)(Wout_t2 + (size_t)(64 * tj + 16 * tc + li) * MIXW + 1024 + 256 * g + 64 * ti + 16 * tr + 4 * kq) = o; }
          { v2u o; o.x = pk2(acc1[0], acc1[1]); o.y = pk2(acc1[2], acc1[3]); *(GAS v2u*)(Wout_t2 + (size_t)(64 * tj + 16 * tc + 16 + li) * MIXW + 1024 + 256 * g + 64 * ti + 16 * tr + 4 * kq) = o; }
      }
      __syncthreads(); }
}

constexpr int WDT_PITCH = 2064;
__device__ __forceinline__ void norm16(Frame& F, const float* xrows, int grow0, int batch, LAS unsigned char* wdt, int nrows  ) {
    const float* mod = (const float*)(F.ws + WS_MOD) + (size_t)batch * NMOD; bf16* H = (bf16*)(F.ws + WS_H); float* DT = (float*)(F.ws + WS_DT);
    const int lane = F.lane, l15 = lane & 15, l4 = lane >> 4;
    LAS unsigned char* stage = wdt + 16 * WDT_PITCH + F.wave * (4 * WDT_PITCH);
    const float dtb = F.in[IN_DTB][l15];
    f32x4 a1[4], s1[4];
#pragma unroll
    for (int j = 0; j < 4; ++j) { const f32x4 w = *(const f32x4*)(F.in[IN_NW1] + 256 * j + 4 * lane), sc = *(const f32x4*)(mod + DM + 256 * j + 4 * lane); a1[j] = w * (sc + 1.0f); s1[j] = *(const f32x4*)(mod + 256 * j + 4 * lane); }
    f32x4 nx[4][4];
#pragma unroll
    for (int q = 0; q < 4; ++q) { const GAS f32x4* xr = (const GAS f32x4*)(xrows + (size_t)q * DM) + lane;
#pragma unroll
        for (int j = 0; j < 4; ++j) nx[q][j] = __builtin_nontemporal_load(xr + 64 * j); }
    for (int r0 = 0; r0 < nrows; r0 += 4) {
        f32x4 v[4][4];
#pragma unroll
        for (int q = 0; q < 4; ++q)
#pragma unroll
            for (int j = 0; j < 4; ++j) v[q][j] = nx[q][j];
        if (r0 + 4 < nrows) {
#pragma unroll
            for (int q = 0; q < 4; ++q) { const GAS f32x4* xr = (const GAS f32x4*)(xrows + (size_t)(r0 + 4 + q) * DM) + lane;
#pragma unroll
                for (int j = 0; j < 4; ++j) nx[q][j] = __builtin_nontemporal_load(xr + 64 * j); } }
        __builtin_amdgcn_sched_barrier(0);
        float ss[4];
#pragma unroll
        for (int q = 0; q < 4; ++q) { ss[q] = 0.f;
#pragma unroll
            for (int j = 0; j < 4; ++j) ss[q] += (v[q][j].x * v[q][j].x + v[q][j].y * v[q][j].y) + (v[q][j].z * v[q][j].z + v[q][j].w * v[q][j].w); }
#pragma unroll
        for (int o = 1; o < 64; o <<= 1) {
#pragma unroll
            for (int q = 0; q < 4; ++q) ss[q] += __shfl_xor(ss[q], o); }
#pragma unroll
        for (int q = 0; q < 4; ++q) { const float rs = 1.0f / sqrtf(ss[q] * (1.f / DM) + EPS);
            GAS unsigned long long* o8 = (GAS unsigned long long*)(H + (size_t)(grow0 + r0 + q) * DM) + lane;
#pragma unroll
            for (int j = 0; j < 4; ++j) { const f32x4 hv = v[q][j] * rs * a1[j] + s1[j]; const unsigned long long pk = (unsigned long long)pk2(hv.x, hv.y) | ((unsigned long long)pk2(hv.z, hv.w) << 32);
                o8[64 * j] = pk; *(LAS unsigned long long*)(stage + q * WDT_PITCH + 512 * j + 8 * lane) = pk; } }
        { f32x4 acc0 = (f32x4){0.f, 0.f, 0.f, 0.f}, acc1 = acc0;
          const LAS unsigned char* arow = stage + (l15 & 3) * WDT_PITCH + 16 * l4; const LAS unsigned char* brow = wdt + l15 * WDT_PITCH + 16 * l4;
#pragma unroll 8
          for (int ks = 0; ks < 32; ks += 2) { acc0 = MFMA16(*(const LAS bf16x8*)(arow + 64 * ks), *(const LAS bf16x8*)(brow + 64 * ks), acc0); acc1 = MFMA16(*(const LAS bf16x8*)(arow + 64 * ks + 64), *(const LAS bf16x8*)(brow + 64 * ks + 64), acc1); }
          if (l4 == 0) {
#pragma unroll
              for (int r = 0; r < 4; ++r) { const float raw = acc0[r] + acc1[r] + dtb; DT[(size_t)(grow0 + r0 + r) * 16 + l15] = fmaxf(raw, 0.f) + log1pf(expf(-fabsf(raw))); } } }
    }
}
__device__ __forceinline__ void p_norm(Frame& F) {
    LAS unsigned char* wdt = F.lds + RING_OFF;
    for (int k = F.tid; k < DM; k += NWAVES * 64) { const f32x4* src = (const f32x4*)(F.in[IN_WIN] + (size_t)k * LDWIN + NPROJ);
#pragma unroll
        for (int q = 0; q < 4; ++q) { const f32x4 w = src[q];
            *(LAS unsigned short*)(wdt + (4 * q + 0) * WDT_PITCH + 2 * k) = (unsigned short)f2bf(w.x); *(LAS unsigned short*)(wdt + (4 * q + 1) * WDT_PITCH + 2 * k) = (unsigned short)f2bf(w.y);
            *(LAS unsigned short*)(wdt + (4 * q + 2) * WDT_PITCH + 2 * k) = (unsigned short)f2bf(w.z); *(LAS unsigned short*)(wdt + (4 * q + 3) * WDT_PITCH + 2 * k) = (unsigned short)f2bf(w.w); } }
    __syncthreads();
    if (blockIdx.x < NBT) { const int b = blockIdx.x; const float* md = (const float*)(F.ws + WS_MOD) + (size_t)b * NMOD; float* A2 = (float*)(F.ws + WS_A2) + (size_t)b * DM;
        for (int c = F.tid; c < DM; c += NWAVES * 64) A2[c] = F.in[IN_NW2][c] * (1.0f + md[4 * DM + c]); }
    const int gw = F.vcu * NWAVES + F.wave;
    for (int w = gw; w < MP / 32; w += F.G * NWAVES) { norm16(F, F.in[IN_XP] + (size_t)w * 32 * DM, w * 32, w >> 7, wdt, 16); norm16(F, F.in[IN_XP] + (size_t)(w * 32 + 16) * DM, w * 32 + 16, w >> 7, wdt, 16); }
    for (int s = gw; s < MS / 4; s += F.G * NWAVES) norm16(F, F.in[IN_XS] + (size_t)s * 4 * DM, MP + s * 4, NB_P + (s >> 2), wdt, 4);
}

template <int W, int NTOK>
__device__ __forceinline__ void pool_item(const bf16* PROJ, bf16* MIX, int row0, bool seq_start, const float* hist  , int c0) {
    v2u praw[W - 1], craw[NTOK]; f32x4 ph[W - 1];
    if (hist) {
#pragma unroll
        for (int i = 0; i < W - 1; ++i) ph[i] = *(const f32x4*)(hist + (size_t)(15 - (W - 1) + i) * DM + c0);
    } else if (!seq_start) {
#pragma unroll
        for (int i = 0; i < W - 1; ++i) praw[i] = *(const v2u*)(PROJ + (size_t)(row0 - (W - 1) + i) * NPROJ + c0);
    }
#pragma unroll
    for (int j = 0; j < NTOK; ++j) craw[j] = __builtin_nontemporal_load((const v2u*)(PROJ + (size_t)(row0 + j) * NPROJ + c0));
    if (!hist) {
#pragma unroll
        for (int i = 0; i < W - 1; ++i) ph[i] = seq_start ? (f32x4){0.f, 0.f, 0.f, 0.f} : (f32x4){bflo(praw[i].x), bfhi(praw[i].x), bflo(praw[i].y), bfhi(praw[i].y)};
    }
    f32x4 s = (f32x4){0.f, 0.f, 0.f, 0.f};
#pragma unroll
    for (int i = 0; i < W - 1; ++i) s += ph[i];
#pragma unroll
    for (int j = 0; j < NTOK; ++j) {
        const f32x4 x = (f32x4){bflo(craw[j].x), bfhi(craw[j].x), bflo(craw[j].y), bfhi(craw[j].y)};
        s += x;
        const float inv = (seq_start && j + 1 < W) ? 1.0f / (float)(j + 1) : 1.0f / (float)W;
        const f32x4 o = s * inv - x;
        v2u ow; ow.x = pk2(o.x, o.y); ow.y = pk2(o.z, o.w);
        *(v2u*)(MIX + (size_t)(row0 + j) * MIXW + 1024 + c0) = ow;
        const int idx = j - (W - 1);
        if (idx < 0) s -= ph[(W - 1) + idx]; else s -= (f32x4){bflo(craw[idx].x), bfhi(craw[idx].x), bflo(craw[idx].y), bfhi(craw[idx].y)};
    }
}
template <int W>
__device__ __forceinline__ void pool_group(Frame& F, const bf16* PROJ, bf16* MIX, int blk, int c0) {
    if (blk < MP / 32) { const int row0 = blk * 32; pool_item<W, 32>(PROJ, MIX, row0, (row0 & (SEQ - 1)) == 0, nullptr, c0); }
    else { const int sb = blk - MP / 32; pool_item<W, DSEQ>(PROJ, MIX, MP + sb * DSEQ, false, F.in[IN_CPOOL] + (size_t)sb * 15 * DM, c0); }
}
__device__ __forceinline__ void p3_pool(Frame& F) {
    const bf16* PROJ = (const bf16*)(F.ws + WS_PROJ); bf16* MIX = (bf16*)(F.ws + WS_MIX);
    const int gw = F.vcu * NWAVES + F.wave, NGW = F.G * NWAVES;
#if EPI_POOL
    { const int g = F.vcu & 3, cntg = (F.G - g + 3) >> 2, widx = (F.vcu >> 2) * NWAVES + F.wave, stride = cntg * NWAVES, hb = F.lane >> 5, c8 = g * 256 + 8 * (F.lane & 31);
      auto items = [&](auto wc) __attribute__((always_inline)) { constexpr int W = decltype(wc)::value; constexpr int N = W - 1; constexpr float INVW = 1.0f / (float)W;
          for (int p0 = widx; p0 < MP / 128; p0 += stride) { const int blk = p0 + (MP / 128) * hb, row0 = blk * 64; const bool ss = (p0 & (SEQ / 64 - 1)) == 0;
              v4u h[N], c[N];
#pragma unroll
              for (int i = 0; i < N; ++i) { h[i] = (v4u){0u, 0u, 0u, 0u}; if (!ss) h[i] = *(const v4u*)(PROJ + (size_t)(row0 - N + i) * NPROJ + c8); c[i] = *(const v4u*)(PROJ + (size_t)(row0 + i) * NPROJ + c8); }
              f32x4 s0 = (f32x4){0.f, 0.f, 0.f, 0.f}, s1 = s0;
#pragma unroll
              for (int i = 0; i < N; ++i) { s0 += (f32x4){bflo(h[i].x), bfhi(h[i].x), bflo(h[i].y), bfhi(h[i].y)}; s1 += (f32x4){bflo(h[i].z), bfhi(h[i].z), bflo(h[i].w), bfhi(h[i].w)}; }
#pragma unroll
              for (int j = 0; j < N; ++j) { const f32x4 x0 = (f32x4){bflo(c[j].x), bfhi(c[j].x), bflo(c[j].y), bfhi(c[j].y)}, x1 = (f32x4){bflo(c[j].z), bfhi(c[j].z), bflo(c[j].w), bfhi(c[j].w)}; s0 += x0; s1 += x1;
                  const float inv = ss ? 1.0f / (float)(j + 1) : INVW; const f32x4 o0 = s0 * inv - x0, o1 = s1 * inv - x1;
                  v4u ow; ow.x = pk2(o0.x, o0.y); ow.y = pk2(o0.z, o0.w); ow.z = pk2(o1.x, o1.y); ow.w = pk2(o1.z, o1.w); *(v4u*)(MIX + (size_t)(row0 + j) * MIXW + 1024 + c8) = ow;
                  s0 -= (f32x4){bflo(h[j].x), bfhi(h[j].x), bflo(h[j].y), bfhi(h[j].y)}; s1 -= (f32x4){bflo(h[j].z), bfhi(h[j].z), bflo(h[j].w), bfhi(h[j].w)}; } }
          const int c0 = g * 256 + 4 * F.lane;
          for (int t = stride - 1 - widx; t < NB_S; t += stride) pool_group<W>(F, PROJ, MIX, MP / 32 + t, c0); };
      if (g == 0) items(std::integral_constant<int, 2>{}); else if (g == 1) items(std::integral_constant<int, 4>{}); else if (g == 2) items(std::integral_constant<int, 8>{}); else items(std::integral_constant<int, 16>{}); }
#else
    constexpr int NQ = (MP / 32 + NB_S) * 4;
    for (int q = gw; q < NQ; q += NGW) {
        int blk, g; if (q < NB_S * 4) { blk = MP / 32 + (q >> 2); g = q & 3; } else { const int qq = q - NB_S * 4; blk = qq >> 2; g = qq & 3; }
        const int c0 = g * 256 + 4 * F.lane;
        if (g == 0) pool_group<2>(F, PROJ, MIX, blk, c0); else if (g == 1) pool_group<4>(F, PROJ, MIX, blk, c0); else if (g == 2) pool_group<8>(F, PROJ, MIX, blk, c0); else pool_group<16>(F, PROJ, MIX, blk, c0);
    }
#endif
}
__device__ __forceinline__ void conv_load8(const bf16* src, v4u (&raw)[8]) {
#pragma unroll
    for (int j = 0; j < 8; ++j) raw[j] = __builtin_nontemporal_load((const v4u*)(src + (size_t)j * NPROJ));
}
__device__ __forceinline__ void conv_rows8(const v4u (&raw)[8], bf16* dst, const f32x4 (&wv)[4][2], const f32x4 (&bv)[2], f32x4 (&h)[3][2]) {
#pragma unroll
    for (int j = 0; j < 8; ++j) {
        const f32x4 x0 = (f32x4){bflo(raw[j].x), bfhi(raw[j].x), bflo(raw[j].y), bfhi(raw[j].y)}, x1 = (f32x4){bflo(raw[j].z), bfhi(raw[j].z), bflo(raw[j].w), bfhi(raw[j].w)};
        const f32x4 o0 = bv[0] + wv[0][0] * h[0][0] + wv[1][0] * h[1][0] + wv[2][0] * h[2][0] + wv[3][0] * x0;
        const f32x4 o1 = bv[1] + wv[0][1] * h[0][1] + wv[1][1] * h[1][1] + wv[2][1] * h[2][1] + wv[3][1] * x1;
        v4u ow; ow.x = pk2(silu_fast(o0.x), silu_fast(o0.y)); ow.y = pk2(silu_fast(o0.z), silu_fast(o0.w)); ow.z = pk2(silu_fast(o1.x), silu_fast(o1.y)); ow.w = pk2(silu_fast(o1.z), silu_fast(o1.w));
        *(v4u*)(dst + (size_t)j * CONVD) = ow;
        h[0][0] = h[1][0]; h[0][1] = h[1][1]; h[1][0] = h[2][0]; h[1][1] = h[2][1]; h[2][0] = x0; h[2][1] = x1;
    }
}
__device__ __forceinline__ void p3_conv(Frame& F) {
    const bf16* PROJ = (const bf16*)(F.ws + WS_PROJ); bf16* XB = (bf16*)(F.out + O_Y);
    const float* cw = F.in[IN_CONVW]; const float* cb = F.in[IN_CONVB];
    const int gw = F.vcu * NWAVES + F.wave, NGW = F.G * NWAVES;
#if EPI_CONV
    { const int strip = gw % 3, rank = gw / 3, cnt = (NGW - strip + 2) / 3, c0 = strip * 512 + 8 * F.lane;
      f32x4 wv[4][2], bv[2];
#pragma unroll
      for (int k = 0; k < 4; ++k) { wv[k][0] = *(const f32x4*)(cw + k * CONVD + c0); wv[k][1] = *(const f32x4*)(cw + k * CONVD + c0 + 4); }
      bv[0] = *(const f32x4*)(cb + c0); bv[1] = *(const f32x4*)(cb + c0 + 4);
      auto loadrows = [&](int blk, v4u (&raw)[6]) __attribute__((always_inline)) { const int row0 = blk * 64; const bool zh = (row0 & (SEQ - 1)) == 0;
#pragma unroll
          for (int i = 0; i < 6; ++i) { raw[i] = (v4u){0u, 0u, 0u, 0u}; if (!(i < 3 && zh)) raw[i] = *(const v4u*)(PROJ + (size_t)(row0 - 3 + i) * NPROJ + 2048 + c0); } };
      auto emit = [&](int blk, const v4u (&raw)[6]) __attribute__((always_inline)) { const int row0 = blk * 64; f32x4 h[6][2];
#pragma unroll
          for (int i = 0; i < 6; ++i) { h[i][0] = (f32x4){bflo(raw[i].x), bfhi(raw[i].x), bflo(raw[i].y), bfhi(raw[i].y)}; h[i][1] = (f32x4){bflo(raw[i].z), bfhi(raw[i].z), bflo(raw[i].w), bfhi(raw[i].w)}; }
#pragma unroll
          for (int j = 0; j < 3; ++j) {
              const f32x4 o0 = bv[0] + wv[0][0] * h[j][0] + wv[1][0] * h[j + 1][0] + wv[2][0] * h[j + 2][0] + wv[3][0] * h[j + 3][0];
              const f32x4 o1 = bv[1] + wv[0][1] * h[j][1] + wv[1][1] * h[j + 1][1] + wv[2][1] * h[j + 2][1] + wv[3][1] * h[j + 3][1];
              v4u ow; ow.x = pk2(silu_fast(o0.x), silu_fast(o0.y)); ow.y = pk2(silu_fast(o0.z), silu_fast(o0.w)); ow.z = pk2(silu_fast(o1.x), silu_fast(o1.y)); ow.w = pk2(silu_fast(o1.z), silu_fast(o1.w));
              *(v4u*)(XB + (size_t)(row0 + j) * CONVD + c0) = ow; } };
      for (int b0 = rank; b0 < MP / 64; b0 += 2 * cnt) { const int b1 = b0 + cnt; const bool two = b1 < MP / 64;
          v4u ra[6], rb[6]; loadrows(b0, ra); if (two) loadrows(b1, rb);
          emit(b0, ra); if (two) emit(b1, rb); }
    }
    constexpr int NQ_S = NB_S * 2 * 3, NQ = NQ_S;
#else
    constexpr int NQ_S = NB_S * 2 * 3, NQ = NQ_S + (MP / 32) * 3;
#endif
    for (int q = (EPI_CONV ? NGW - 1 - gw : gw); q < NQ; q += NGW) {
        int row0, nb8, strip; bool zero_hist = false; const float* hist = nullptr;
        if (q < NQ_S) { const int sh = q / 3; strip = q - sh * 3; const int sb = sh >> 1, half = sh & 1; row0 = MP + sb * DSEQ + 8 * half; nb8 = 1; if (!half) hist = F.in[IN_CCONV] + (size_t)sb * 3 * CONVD; }
        else { const int qq = q - NQ_S, blk = qq / 3; strip = qq - blk * 3; row0 = blk * 32; nb8 = 4; zero_hist = (row0 & (SEQ - 1)) == 0; }
        const int c0 = strip * 512 + 8 * F.lane;
        f32x4 wv[4][2], bv[2], h[3][2];
#pragma unroll
        for (int k = 0; k < 4; ++k) { wv[k][0] = *(const f32x4*)(cw + k * CONVD + c0); wv[k][1] = *(const f32x4*)(cw + k * CONVD + c0 + 4); }
        bv[0] = *(const f32x4*)(cb + c0); bv[1] = *(const f32x4*)(cb + c0 + 4);
#pragma unroll
        for (int i = 0; i < 3; ++i) {
            if (hist) { h[i][0] = *(const f32x4*)(hist + (size_t)i * CONVD + c0); h[i][1] = *(const f32x4*)(hist + (size_t)i * CONVD + c0 + 4); }
            else if (zero_hist) { h[i][0] = (f32x4){0.f, 0.f, 0.f, 0.f}; h[i][1] = h[i][0]; }
            else { const v4u r = *(const v4u*)(PROJ + (size_t)(row0 - 3 + i) * NPROJ + 2048 + c0); h[i][0] = (f32x4){bflo(r.x), bfhi(r.x), bflo(r.y), bfhi(r.y)}; h[i][1] = (f32x4){bflo(r.z), bfhi(r.z), bflo(r.w), bfhi(r.w)}; } }
        v4u rawA[8], rawB[8];
        conv_load8(PROJ + (size_t)row0 * NPROJ + 2048 + c0, rawA);
        for (int b8 = 0; b8 < nb8; b8 += 2) {
            if (b8 + 1 < nb8) conv_load8(PROJ + (size_t)(row0 + 8 * (b8 + 1)) * NPROJ + 2048 + c0, rawB);
            __builtin_amdgcn_sched_barrier(0);
            conv_rows8(rawA, XB + (size_t)(row0 + 8 * b8) * CONVD + c0, wv, bv, h);
            if (b8 + 1 < nb8) {
                if (b8 + 2 < nb8) conv_load8(PROJ + (size_t)(row0 + 8 * (b8 + 2)) * NPROJ + 2048 + c0, rawA);
                __builtin_amdgcn_sched_barrier(0);
                conv_rows8(rawB, XB + (size_t)(row0 + 8 * (b8 + 1)) * CONVD + c0, wv, bv, h); }
        }
    }
}

__device__ __forceinline__ void p4_ssd(Frame& F) {
    const bf16* XB = (const bf16*)(F.out + O_Y); const bf16* PROJ = (const bf16*)(F.ws + WS_PROJ); bf16* MIX = (bf16*)(F.ws + WS_MIX);
    const float* DT = (const float*)(F.ws + WS_DT); float* SSQ = (float*)(F.ws + WS_SSQ);
    LAS unsigned char* Bs = F.lds + RING_OFF; LAS unsigned char* Cs = Bs + 16384; LAS unsigned char* Hs = Bs + 32768; LAS unsigned char* Xs0 = Bs + 49152; LAS unsigned char* Xd = Bs + 65536; LAS unsigned char* Ms = Bs + 81920;
    LAS unsigned char* Xs1 = Bs + 98304;
    LAS float* Ys = (LAS float*)(Bs + 114688);
    const int tid = F.tid, lane = F.lane, w = F.wave, l15 = lane & 15, l4 = lane >> 4;
    const int xj = tid >> 3, xch = tid & 7;
    LAS float* tabw = (LAS float*)(F.lds + LDSX_OFF) + w * 384;
    const int itile = w >> 1, pq0 = 2 * (w & 1);
    for (int it = blockIdx.x; it < NB_P * NH + NB_S * NH; it += F.G) {
        int rowbase, L, h; float* sout; f32x4 st[4];
        if (it < NB_P * NH) { const int b = it >> 4; h = it & 15; rowbase = b * SEQ; L = SEQ; sout = F.out + O_SP + (size_t)it * HD * NST;
#pragma unroll
            for (int pt = 0; pt < 4; ++pt) st[pt] = (f32x4){0.f, 0.f, 0.f, 0.f}; }
        else { const int s = it - NB_P * NH, sb = s >> 4; h = s & 15; rowbase = MP + sb * DSEQ; L = DSEQ; sout = F.out + O_SS + (size_t)s * HD * NST;
            const float* sin = F.in[IN_SSM] + (size_t)s * HD * NST;
#pragma unroll
            for (int pt = 0; pt < 4; ++pt) st[pt] = *(const f32x4*)(sin + (size_t)(16 * pt + l15) * NST + 16 * w + 4 * l4); }
        const int g = h >> 3; const float Ah = -expf(F.in[IN_ALOG][h]) * 1.4426950408889634f, Dh = F.in[IN_DSKIP][h];
        const int nch = (L + 63) >> 6;
        v4u xw, bw[2], cw[2]; float dtr = 0.f;
        { const int nt0 = L < 64 ? L : 64;
          xw = (v4u){0u, 0u, 0u, 0u}; if (xj < nt0) xw = *(const v4u*)(XB + (size_t)(rowbase + xj) * CONVD + h * HD + 8 * xch);
#pragma unroll
          for (int rep = 0; rep < 2; ++rep) { const int tt = (tid >> 4) + 32 * rep; bw[rep] = (v4u){0u, 0u, 0u, 0u}; cw[rep] = (v4u){0u, 0u, 0u, 0u};
              if (tt < nt0) { const bf16* rp = XB + (size_t)(rowbase + tt) * CONVD + 1024 + g * NST + 8 * (tid & 15); bw[rep] = *(const v4u*)rp; cw[rep] = *(const v4u*)(rp + 256); } }
          if (lane < nt0) dtr = DT[(size_t)(rowbase + lane) * 16 + h]; }
        f32x4 yo0p = (f32x4){0.f, 0.f, 0.f, 0.f}, yo1p = yo0p; v4u zwp = (v4u){0u, 0u, 0u, 0u}; f32x2v xkp[4] = {(f32x2v){0.f, 0.f}, (f32x2v){0.f, 0.f}, (f32x2v){0.f, 0.f}, (f32x2v){0.f, 0.f}}; int rowp = 0, ntp = 0;
        auto body = [&](int ci, auto curc, auto prevc) __attribute__((always_inline)) {
            constexpr bool cur = decltype(curc)::value, prev = decltype(prevc)::value;
            const int t0 = ci * 64; const int nt = cur ? ((L - t0) < 64 ? (L - t0) : 64) : 0;
            float acs = 0.f, acs63 = 0.f; v4u zw = (v4u){0u, 0u, 0u, 0u}; f32x2v xkeep[4] = {(f32x2v){0.f, 0.f}, (f32x2v){0.f, 0.f}, (f32x2v){0.f, 0.f}, (f32x2v){0.f, 0.f}}; f32x4 yo0 = (f32x4){0.f, 0.f, 0.f, 0.f}, yo1 = yo0;
            if constexpr (cur) {
                LAS unsigned char* Xs = (ci & 1) ? Xs1 : Xs0;
                const float dtl = (lane < nt) ? dtr : 0.f;
                acs = wave_scan_incl(dtl * Ah);
                acs63 = __shfl(acs, 63);
                LAS float* tab = tabw + (ci & 1) * 192;
                tab[lane] = acs; tab[64 + lane] = dtl; tab[128 + lane] = ex2(acs);
#pragma unroll
                for (int pt = 0; pt < 4; ++pt) { v2u o; o.x = pk2(st[pt].x, st[pt].y); o.y = pk2(st[pt].z, st[pt].w);
                    *(LAS v2u*)(Hs + offr((unsigned)(16 * pt + l15), (unsigned)(2 * w + (lane >> 5))) + 8u * (l4 & 1)) = o; }
#pragma unroll
                for (int rep = 0; rep < 2; ++rep) { const unsigned tt = (unsigned)(tid >> 4) + 32u * rep, ch = (unsigned)tid & 15u;
                    *(LAS v4u*)(Bs + offb(tt, ch)) = bw[rep]; *(LAS v4u*)(Cs + offr(tt, ch)) = cw[rep]; }
                { const float d = tab[64 + xj], dec = ex2(acs63 - tab[xj]);
                  const f32x2v d2 = (f32x2v){d, d}, dd2 = (f32x2v){d * dec, d * dec};
                  const f32x2v X0 = (f32x2v){bflo(xw.x), bfhi(xw.x)}, X1 = (f32x2v){bflo(xw.y), bfhi(xw.y)}, X2 = (f32x2v){bflo(xw.z), bfhi(xw.z)}, X3 = (f32x2v){bflo(xw.w), bfhi(xw.w)};
                  xkeep[0] = X0; xkeep[1] = X1; xkeep[2] = X2; xkeep[3] = X3;
                  const f32x2v A0 = X0 * d2, A1 = X1 * d2, A2_ = X2 * d2, A3 = X3 * d2, B0 = X0 * dd2, B1 = X1 * dd2, B2 = X2 * dd2, B3 = X3 * dd2;
                  v4u a; a.x = pk2(A0.x, A0.y); a.y = pk2(A1.x, A1.y); a.z = pk2(A2_.x, A2_.y); a.w = pk2(A3.x, A3.y);
                  v4u b; b.x = pk2(B0.x, B0.y); b.y = pk2(B1.x, B1.y); b.z = pk2(B2.x, B2.y); b.w = pk2(B3.x, B3.y);
                  *(LAS v4u*)(Xs + offb((unsigned)xj, (unsigned)xch)) = a; *(LAS v4u*)(Xd + offb((unsigned)xj, (unsigned)xch)) = b; }
                if (xj < nt) zw = *(const v4u*)(PROJ + (size_t)(rowbase + t0 + xj) * NPROJ + 1024 + h * HD + 8 * xch);
                if (t0 + 64 < L) { const int r1 = rowbase + t0 + 64;
                    xw = *(const v4u*)(XB + (size_t)(r1 + xj) * CONVD + h * HD + 8 * xch);
#pragma unroll
                    for (int rep = 0; rep < 2; ++rep) { const int tt = (tid >> 4) + 32 * rep; const bf16* rp = XB + (size_t)(r1 + tt) * CONVD + 1024 + g * NST + 8 * (tid & 15); bw[rep] = *(const v4u*)rp; cw[rep] = *(const v4u*)(rp + 256); }
                    dtr = DT[(size_t)(r1 + lane) * 16 + h]; }
            }
            if constexpr (prev) {
                LAS unsigned char* Xsp = ((ci - 1) & 1) ? Xs1 : Xs0;
                f32x4 yd0 = (f32x4){0.f, 0.f, 0.f, 0.f}, yd1 = yd0;
#pragma unroll
                for (int ks = 0; ks < 2; ++ks) { const bf16x8 aM = frag_rowr(Ms, lane, itile, ks), b0 = frag_tr(Xsp, lane, pq0, ks), b1 = frag_tr(Xsp, lane, pq0 + 1, ks);
                    yd0 = MFMA16(aM, b0, yd0); yd1 = MFMA16(aM, b1, yd1); }
                const int i0 = 16 * itile + 4 * l4; const f32x4 ev = *(const LAS f32x4*)(tabw + ((ci - 1) & 1) * 192 + 128 + i0);
                const f32x4 y0v = yd0 + ev * yo0p, y1v = yd1 + ev * yo1p;
#pragma unroll
                for (int r = 0; r < 4; ++r) { Ys[(i0 + r) * 64 + ((16 * pq0 + l15 + 16 * l4) & 63)] = y0v[r]; Ys[(i0 + r) * 64 + ((16 * (pq0 + 1) + l15 + 16 * l4) & 63)] = y1v[r]; }
            }
            __syncthreads();
            if constexpr (prev) {
                if (xj < ntp) { const size_t row = (size_t)(rowp + xj); const int rot = 16 * ((xj >> 2) & 3);
                    const f32x4 y0 = *(const LAS f32x4*)(Ys + xj * 64 + ((8 * xch + rot) & 63)), y1 = *(const LAS f32x4*)(Ys + xj * 64 + ((8 * xch + rot) & 63) + 4);
                    const unsigned zr[4] = {zwp.x, zwp.y, zwp.z, zwp.w};
                    const f32x2v yv[4] = {(f32x2v){y0.x, y0.y}, (f32x2v){y0.z, y0.w}, (f32x2v){y1.x, y1.y}, (f32x2v){y1.z, y1.w}};
                    f32x2v ss2 = (f32x2v){0.f, 0.f}; unsigned opk[4];
#pragma unroll
                    for (int i = 0; i < 4; ++i) { const f32x2v X = xkp[i], Z = (f32x2v){bflo(zr[i]), bfhi(zr[i])};
                        const f32x2v t = Z * (f32x2v){-1.4426950408889634f, -1.4426950408889634f};
                        const f32x2v dn = (f32x2v){__builtin_amdgcn_exp2f(t.x), __builtin_amdgcn_exp2f(t.y)} + (f32x2v){1.f, 1.f};
                        const f32x2v sz = Z * (f32x2v){__builtin_amdgcn_rcpf(dn.x), __builtin_amdgcn_rcpf(dn.y)};
                        const f32x2v o2 = (X * (f32x2v){Dh, Dh} + yv[i]) * sz;
                        ss2 += o2 * o2; opk[i] = pk2(o2.x, o2.y); }
                    float ss = ss2.x + ss2.y;
                    ss += __shfl_xor(ss, 1); ss += __shfl_xor(ss, 2); ss += __shfl_xor(ss, 4);
                    if (xch == 0) SSQ[row * 16 + h] = ss;
                    v4u ow; ow.x = opk[0]; ow.y = opk[1]; ow.z = opk[2]; ow.w = opk[3];
                    *(v4u*)(MIX + row * MIXW + h * HD + 8 * xch) = ow; }
            }
            if constexpr (cur) {
                f32x4 g0 = (f32x4){0.f, 0.f, 0.f, 0.f}, g1 = g0;
#pragma unroll
                for (int ks = 0; ks < 4; ++ks) { const bf16x8 bC = frag_rowr(Cs, lane, itile, ks), a0 = frag_row(Bs, lane, pq0, ks), a1 = frag_row(Bs, lane, pq0 + 1, ks);
                    const bf16x8 h0 = frag_rowr(Hs, lane, pq0, ks), h1 = frag_rowr(Hs, lane, pq0 + 1, ks);
                    g0 = MFMA16(a0, bC, g0); g1 = MFMA16(a1, bC, g1); yo0 = MFMA16(bC, h0, yo0); yo1 = MFMA16(bC, h1, yo1); }
                const float cd = ex2(acs63);
#pragma unroll
                for (int pt = 0; pt < 4; ++pt) st[pt] = st[pt] * cd;
#pragma unroll
                for (int ks = 0; ks < 2; ++ks) { const bf16x8 aB = frag_tr(Bs, lane, w, ks);
#pragma unroll
                    for (int pt = 0; pt < 4; ++pt) { const bf16x8 bX = frag_tr(Xd, lane, pt, ks); st[pt] = MFMA16(aB, bX, st[pt]); } }
                const LAS float* tabc = tabw + (ci & 1) * 192;
                const int i = 16 * itile + l15; const float ai = tabc[i];
#pragma unroll
                for (int jj = 0; jj < 2; ++jj) { const int j0 = 16 * (pq0 + jj) + 4 * l4; const f32x4 gv = jj ? g1 : g0; const f32x4 ajv = *(const LAS f32x4*)(tabc + j0);
                    float m[4];
                    const f32x4 dl = (f32x4){ai, ai, ai, ai} - ajv; const f32x4 mm = gv * (f32x4){ex2(dl.x), ex2(dl.y), ex2(dl.z), ex2(dl.w)};
#pragma unroll
                    for (int r = 0; r < 4; ++r) { m[r] = (j0 + r <= i) ? mm[r] : 0.f; }
                    v2u o; o.x = pk2(m[0], m[1]); o.y = pk2(m[2], m[3]);
                    *(LAS v2u*)(Ms + offr((unsigned)i, (unsigned)(2 * (pq0 + jj) + (lane >> 5))) + 8u * (l4 & 1)) = o; }
            }
            __syncthreads();
            yo0p = yo0; yo1p = yo1; zwp = zw; xkp[0] = xkeep[0]; xkp[1] = xkeep[1]; xkp[2] = xkeep[2]; xkp[3] = xkeep[3]; rowp = rowbase + t0; ntp = nt;
        };
        body(0, std::true_type{}, std::false_type{});
        for (int ci = 1; ci < nch; ++ci) body(ci, std::true_type{}, std::true_type{});
        body(nch, std::false_type{}, std::true_type{});
#pragma unroll
        for (int pt = 0; pt < 4; ++pt) *(f32x4*)(sout + (size_t)(16 * pt + l15) * NST + 16 * w + 4 * l4) = st[pt];
    }
}
__device__ __forceinline__ void p4b_gnorm(Frame& F) {
    bf16* MIX = (bf16*)(F.ws + WS_MIX); const float* SSQ = (const float*)(F.ws + WS_SSQ);
    const int gw = F.vcu * NWAVES + F.wave, NGW = F.G * NWAVES, lane = F.lane;
    for (int row = gw; row < MT; row += NGW) {
        float s = SSQ[(size_t)row * 16 + (lane & 15)];
        s += __shfl_xor(s, 1); s += __shfl_xor(s, 2); s += __shfl_xor(s, 4);
        const float sg = __shfl(s, (lane >> 5) * 8);
        const float rs = 1.0f / sqrtf(sg * (1.f / 512.f) + EPS);
        v4u* p = (v4u*)(MIX + (size_t)row * MIXW + 16 * lane);
#pragma unroll
        for (int q = 0; q < 2; ++q) { v4u w = p[q];
            w.x = pk2(bflo(w.x) * rs, bfhi(w.x) * rs); w.y = pk2(bflo(w.y) * rs, bfhi(w.y) * rs); w.z = pk2(bflo(w.z) * rs, bfhi(w.z) * rs); w.w = pk2(bflo(w.w) * rs, bfhi(w.w) * rs);
            p[q] = w; }
    }
}
__device__ __forceinline__ void p9_final(Frame& F) {
    const float* fw = F.in[IN_FNW]; const int gw = F.vcu * NWAVES + F.wave, NGW = F.G * NWAVES, lane = F.lane;
    f32x4 w[4];
#pragma unroll
    for (int j = 0; j < 4; ++j) w[j] = *(const f32x4*)(fw + 256 * j + 4 * lane);
    for (int row = gw; row < MT; row += NGW) {
        GAS f32x4* xr = (GAS f32x4*)(F.out + O_Y + (size_t)row * DM) + lane;
        f32x4 v[4]; float ss = 0.f;
#pragma unroll
        for (int j = 0; j < 4; ++j) { v[j] = xr[64 * j]; ss += (v[j].x * v[j].x + v[j].y * v[j].y) + (v[j].z * v[j].z + v[j].w * v[j].w); }
        const float rs = 1.0f / sqrtf(wave_sum(ss) * (1.f / DM) + EPS);
#pragma unroll
        for (int j = 0; j < 4; ++j) xr[64 * j] = v[j] * rs * w[j];
    }
}

struct Thin4 { f32x4 a[4]; };
template <int NC, bool HOOK>
__device__ __forceinline__ Thin4 thin_tile(Frame& F, const bf16* A, int lda, const bf16* Bt, int ldb, int K, f32x4 fA, f32x4 fB) {
    constexpr int NB = NC / 32;
    const int tid = F.tid, lane = F.lane, w = F.wave;
    LAS unsigned char* base = F.lds + RING_OFF;
    Thin4 r;
#pragma unroll
    for (int i = 0; i < 4; ++i) r.a[i] = (f32x4){0.f, 0.f, 0.f, 0.f};
    v4u ra[2][2], rbv[2][NB];
    auto loadc = [&](int set, int kc) __attribute__((always_inline)) {
#pragma unroll
        for (int i = 0; i < 2; ++i) { const int idx = tid + 512 * i; ra[set][i] = *(const v4u*)(A + (size_t)(idx >> 4) * lda + kc + (idx & 15) * 8); }
#pragma unroll
        for (int i = 0; i < NB; ++i) { const int idx = tid + 512 * i; rbv[set][i] = *(const v4u*)(Bt + (size_t)(idx >> 4) * ldb + kc + (idx & 15) * 8); } };
    int cur = 0;
    auto step = [&](int set, int kc) __attribute__((always_inline)) {
        LAS unsigned char* Ai = base + cur * 49152; LAS unsigned char* Bi = Ai + 16384;
#pragma unroll
        for (int i = 0; i < 2; ++i) { const unsigned idx = (unsigned)(tid + 512 * i); *(LAS v4u*)(Ai + offr(idx >> 4, idx & 15u)) = ra[set][i]; }
#pragma unroll
        for (int i = 0; i < NB; ++i) { const unsigned idx = (unsigned)(tid + 512 * i); *(LAS v4u*)(Bi + offr(idx >> 4, idx & 15u)) = rbv[set][i]; }
        if (kc + 256 < K) loadc(set, kc + 256);
        __syncthreads();
        if constexpr (HOOK) { if (kc == 512) r.a[0] = r.a[0] * fA; if (kc == 1024) r.a[0] = r.a[0] * fB; }
        if constexpr (NC == 128) {
#pragma unroll
            for (int s = 0; s < 4; ++s) { const bf16x8 b = frag_rowr(Bi, lane, w, s);
#pragma unroll
                for (int i = 0; i < 4; ++i) r.a[i] = MFMA16(frag_rowr(Ai, lane, i, s), b, r.a[i]); }
        } else {
#pragma unroll
            for (int s = 0; s < 4; ++s) r.a[0] = MFMA16(frag_rowr(Ai, lane, w & 3, s), frag_rowr(Bi, lane, w >> 2, s), r.a[0]);
        }
        cur ^= 1; };
    loadc(0, 0); loadc(1, 128);
    for (int kc = 0; kc < K; kc += 256) { step(0, kc); step(1, kc + 128); }
    __syncthreads();
    return r;
}
__device__ __forceinline__ void thin_proj(Frame& F) {
    const bf16* Hb = (const bf16*)(F.ws + WS_H) + (size_t)MP * DM; bf16* PROJ = (bf16*)(F.ws + WS_PROJ) + (size_t)MP * NPROJ;
    const int lane = F.lane, w = F.wave, l15 = lane & 15, l4 = lane >> 4;
    for (int q = blockIdx.x; q < 8 * (NPROJ / 128); q += F.G) { const int rb = q / (NPROJ / 128), cb = q - rb * (NPROJ / 128);
        const Thin4 t = thin_tile<128, false>(F, Hb + (size_t)(64 * rb) * DM, DM, (const bf16*)(F.ws + WS_WIN) + (size_t)(128 * cb) * DM, DM, DM, (f32x4){0.f, 0.f, 0.f, 0.f}, (f32x4){0.f, 0.f, 0.f, 0.f});
        const int c = 128 * cb + 16 * w + l15;
#pragma unroll
        for (int i = 0; i < 4; ++i) { const int sb = 4 * rb + i;
#pragma unroll
            for (int r = 0; r < 4; ++r) { const int tok = 4 * l4 + r; const float v = t.a[i][r]; PROJ[(size_t)(16 * sb + tok) * NPROJ + c] = (bf16)f2bf(v);
                if (c < 1024) { if (tok >= 1) F.out[O_PS + ((size_t)(sb * 15 + tok - 1)) * DM + c] = v; }
                else if (c >= 2048) { if (tok >= 13) F.out[O_CS + ((size_t)(sb * 3 + tok - 13)) * CONVD + (c - 2048)] = v; } } }
    }
}
__device__ __forceinline__ void thin_ff1(Frame& F) {
    const bf16* Hb = (const bf16*)(F.ws + WS_H) + (size_t)MP * DM; bf16* HM = (bf16*)(F.ws + WS_HMID) + (size_t)MP * DFF; const float* b1 = F.in[IN_B1];
    const int lane = F.lane, w = F.wave, l15 = lane & 15, l4 = lane >> 4;
    for (int q = blockIdx.x; q < 8 * (DFF / 128); q += F.G) { const int rb = q / (DFF / 128), cb = q - rb * (DFF / 128);
        const Thin4 t = thin_tile<128, false>(F, Hb + (size_t)(64 * rb) * DM, DM, (const bf16*)(F.ws + WS_W1) + (size_t)(128 * cb) * DM, DM, DM, (f32x4){0.f, 0.f, 0.f, 0.f}, (f32x4){0.f, 0.f, 0.f, 0.f});
        const int c = 128 * cb + 16 * w + l15; const float bb = b1[c];
#pragma unroll
        for (int i = 0; i < 4; ++i)
#pragma unroll
            for (int r = 0; r < 4; ++r) { const float a = fmaxf(t.a[i][r] + bb, 0.f); HM[(size_t)(64 * rb + 16 * i + 4 * l4 + r) * DFF + c] = (bf16)f2bf(a * a); }
    }
}
template <int MODE>
__device__ __forceinline__ void thin_resnorm(Frame& F) {
    const int lane = F.lane, w = F.wave, l15 = lane & 15, l4 = lane >> 4, tid = F.tid;
    const float* mod = (const float*)(F.ws + WS_MOD);
    unsigned* slots = (unsigned*)(F.ws + WS_XSL) + (size_t)4 * MT * 4 + (size_t)MODE * MS * 32;
    unsigned* cnt = (unsigned*)(F.ws + WS_CTL) + CW_SEAM + 4 * SEAM_BANK + MODE * 8 * 64;
    LAS float* P = (LAS float*)(F.lds + LDSX_OFF); LAS float* S = P + 128;
    for (int q = F.vcu; q < 8 * 32; q += F.G) { const int rb = q >> 5, cb = q & 31, rt = w & 3, ct = w >> 2, b = NB_P + 4 * rb + rt;
        f32x4 v;
        if constexpr (MODE == 0) {
            const float* ssq = (const float*)(F.ws + WS_SSQ) + (size_t)MP * 16; f32x4 fA, fB;
#pragma unroll
            for (int r = 0; r < 4; ++r) { const f32x4* p = (const f32x4*)(ssq + (size_t)(64 * rb + 16 * rt + 4 * l4 + r) * 16); const f32x4 a = p[0], bq = p[1], cq = p[2], d = p[3];
                const float s0 = ((a.x + a.y) + (a.z + a.w)) + ((bq.x + bq.y) + (bq.z + bq.w)), s1 = ((cq.x + cq.y) + (cq.z + cq.w)) + ((d.x + d.y) + (d.z + d.w));
                const float r0 = 1.0f / sqrtf(s0 * (1.f / 512.f) + EPS), r1 = 1.0f / sqrtf(s1 * (1.f / 512.f) + EPS);
                fA[r] = r0 / r1; fB[r] = r1; }
            v = thin_tile<32, true>(F, (const bf16*)(F.ws + WS_MIX) + (size_t)(MP + 64 * rb) * MIXW, MIXW, (const bf16*)(F.ws + WS_WOUT) + (size_t)(32 * cb) * MIXW, MIXW, MIXW, fA, fB).a[0];
        } else {
            v = thin_tile<32, false>(F, (const bf16*)(F.ws + WS_HMID) + (size_t)(MP + 64 * rb) * DFF, DFF, (const bf16*)(F.ws + WS_W2) + (size_t)(32 * cb) * DFF, DFF, DFF, (f32x4){0.f, 0.f, 0.f, 0.f}, (f32x4){0.f, 0.f, 0.f, 0.f}).a[0];
        }
        const float* bias = MODE == 0 ? (const float*)(F.ws + WS_BIASA) : F.in[IN_B2];
        const float* gate = mod + (size_t)b * NMOD + (MODE == 0 ? 2 * DM : 5 * DM);
        const float* base = MODE == 0 ? F.in[IN_XS] : F.out + O_Y + (size_t)MP * DM;
        const int c = 32 * cb + 16 * ct + l15; const float bb = bias[c], gg = gate[c];
#pragma unroll
        for (int r = 0; r < 4; ++r) { const float x = base[(size_t)(64 * rb + 16 * rt + 4 * l4 + r) * DM + c]; const float t = x + gg * (v[r] + bb); v[r] = t;
            float s = t * t; s += __shfl_xor(s, 1); s += __shfl_xor(s, 2); s += __shfl_xor(s, 4); s += __shfl_xor(s, 8); if (l15 == 0) P[(16 * rt + 4 * l4 + r) * 2 + ct] = s; }
        __syncthreads();
        if (tid < 64) { const float s = P[tid * 2] + P[tid * 2 + 1];
            __hip_atomic_store(slots + ((size_t)(64 * rb + tid) * 32 + cb), __float_as_uint(s), __ATOMIC_RELAXED, __HIP_MEMORY_SCOPE_AGENT);
            asm volatile("s_waitcnt vmcnt(0)" ::: "memory");
            if (lane == 0) __hip_atomic_fetch_add(cnt + 64 * rb, 1u, __ATOMIC_RELAXED, __HIP_MEMORY_SCOPE_AGENT);
            unsigned sp = 0;
            while ((unsigned)__builtin_amdgcn_readfirstlane(__hip_atomic_load(cnt + 64 * rb, __ATOMIC_RELAXED, __HIP_MEMORY_SCOPE_AGENT)) < 32u) { __builtin_amdgcn_s_sleep(2); if (++sp > (1u << 22)) break; }
            const unsigned* sl = slots + (size_t)(64 * rb + tid) * 32; float t = 0.f;
#pragma unroll 8
            for (int i = 0; i < 32; ++i) t += __uint_as_float(__hip_atomic_load(sl + i, __ATOMIC_RELAXED, __HIP_MEMORY_SCOPE_AGENT));
            S[tid] = 1.0f / sqrtf(t * (1.f / DM) + EPS); }
        __syncthreads();
        if constexpr (MODE == 0) { const float a2 = ((const float*)(F.ws + WS_A2))[(size_t)b * DM + c], s2 = mod[(size_t)b * NMOD + 3 * DM + c];
#pragma unroll
            for (int r = 0; r < 4; ++r) { const int lr = 16 * rt + 4 * l4 + r; const size_t row = (size_t)(MP + 64 * rb + lr); F.out[O_Y + row * DM + c] = v[r]; ((bf16*)(F.ws + WS_H))[row * DM + c] = (bf16)f2bf(v[r] * S[lr] * a2 + s2); }
        } else { const float fwc = F.in[IN_FNW][c];
#pragma unroll
            for (int r = 0; r < 4; ++r) { const int lr = 16 * rt + 4 * l4 + r; const size_t row = (size_t)(MP + 64 * rb + lr); F.out[O_Y + row * DM + c] = v[r] * S[lr] * fwc; } }
        __syncthreads();
    }
}

constexpr int N_PHASES = 8;
struct Args { const float* in[27]; float* out; unsigned char* ws; int ph_lo, ph_hi; };
__global__ void __launch_bounds__(NWAVES * 64, 2) hymba_fwd(Args args) {
    extern __shared__ __attribute__((aligned(16))) unsigned char lds[];
    Frame F;
    F.lds = (LAS unsigned char*)lds;
    F.tid = threadIdx.x; F.lane = F.tid & 63; F.wave = __builtin_amdgcn_readfirstlane(F.tid >> 6);
    F.G = gridDim.x; { const int bx = blockIdx.x; F.vcu = (F.G % 8 == 0) ? (bx % 8) * (F.G / 8) + bx / 8 : bx; }
#pragma unroll
    for (int i = 0; i < 27; ++i) F.in[i] = args.in[i];
    F.out = args.out; F.ws = args.ws;
    const int lo = args.ph_lo, hi = args.ph_hi;
    for (int u = F.tid; u < (LDS_BYTES - LDSCTL_OFF) / 4; u += NWAVES * 64) ((LAS unsigned*)(F.lds + LDSCTL_OFF))[u] = 0u;
    __syncthreads();
    XcdBarrier bar; bar.bar = (unsigned*)(F.ws + WS_CTL) + CW_BAR; bar.x = 0; bar.st = nullptr;
    if (hi - lo > 1) bar = xcd_barrier_post((unsigned*)(F.ws + WS_CTL) + CW_BAR, (volatile LAS unsigned*)(F.lds + MISC_OFF) + 8);
#ifndef PHASE_MASK
#define PHASE_MASK 0xff
#endif
#define IN(k) (((PHASE_MASK >> (k)) & 1) && lo <= (k) && (k) < hi)
#ifndef DOUBLE_MASK
#define DOUBLE_MASK 0
#endif
#ifndef THIN_SPLIT
#define THIN_SPLIT 1
#endif
#ifndef STAG5
#define STAG5 0
#endif
#ifndef STAG7
#define STAG7 0
#endif
#define STAGGER(ticks) do { if ((ticks) > 0 && ((F.vcu >> 2) & 1)) { const unsigned long long t0_ = __builtin_amdgcn_s_memrealtime(); while (__builtin_amdgcn_s_memrealtime() - t0_ < (unsigned long long)(ticks)) __builtin_amdgcn_s_sleep(8); } } while (0)
#define REPS(k) for (int rep_ = 0; rep_ < 1 + ((DOUBLE_MASK >> (k)) & 1); ++rep_)
#define SEAM(k) do { if (IN(k) && IN((k) + 1)) { xcd_barrier(bar); } } while (0)
    bf16* Hb = (bf16*)(F.ws + WS_H); bf16* PROJ = (bf16*)(F.ws + WS_PROJ); bf16* MIX = (bf16*)(F.ws + WS_MIX); bf16* HMID = (bf16*)(F.ws + WS_HMID);
    const float* mod = (const float*)(F.ws + WS_MOD);
    const bool thin_first = THIN_SPLIT && ((F.vcu >> 5) & 1);

    if (IN(0)) REPS(0) { p0_mod(F); p0_weights(F); } SEAM(0);
    if (IN(1)) REPS(1) { p_norm(F); } SEAM(1);
    if (IN(2)) REPS(2) {
        pg8::Gemm g{Hb, (const bf16*)(F.ws + WS_WIN), MP, NPROJ, DM}; pg8::ProjOrder S; S.init(MP, NPROJ, F.G, (int)blockIdx.x);
        pg8::EpiProj E{PROJ, F.out, O_PP, O_CP, O_PS, O_CS, (bf16*)(F.out + O_Y), F.in[IN_CONVW], F.in[IN_CONVB], MIX};
#ifdef PROBE_TWICE_P2
        { pg8::TwiceOrder S2; S2.init2(MP, NPROJ, F.G, (int)blockIdx.x); pg8::gemm_phase<pg8::EpiProj, pg8::TwiceOrder, true, true>(F.lds + RING_OFF, g, S2, E); }
#else
        if (thin_first) thin_proj(F);
        pg8::gemm_phase<pg8::EpiProj, pg8::ProjOrder, true, true>(F.lds + RING_OFF, g, S, E);
#endif
        if (!thin_first) thin_proj(F);
#ifdef THIN_TWICE
        thin_proj(F);
#endif
    } SEAM(2);
#ifndef POOL_REPS
#define POOL_REPS 1
#endif
#ifndef CONV_REPS
#define CONV_REPS 1
#endif
    if (IN(3)) REPS(3) { for (int r_ = 0; r_ < POOL_REPS; ++r_) p3_pool(F); for (int r_ = 0; r_ < CONV_REPS; ++r_) p3_conv(F); } SEAM(3);
    if (IN(4)) REPS(4) { p4_ssd(F); }
#ifdef AB_NO_KHOOK
    if (IN(4)) { xcd_barrier(bar); p4b_gnorm(F); }
#endif
    SEAM(4);
    if (IN(5)) REPS(5) {
        pg8::Gemm g{MIX, (const bf16*)(F.ws + WS_WOUT), MP, DM, MIXW}; pg8::PanelOrder S; S.init(MP, F.G, F.vcu);
        pg8::EpiResNorm<0> E{F.in[IN_XP], F.in[IN_XS], F.out + O_Y, (const float*)(F.ws + WS_BIASA), mod + 2 * DM,
                             (unsigned*)(F.ws + WS_XSL) + (size_t)rep_ * 2 * MT * 4, (unsigned*)(F.ws + WS_CTL) + CW_SEAM + rep_ * 2 * SEAM_BANK, F.lds + LDSX_OFF,
                             Hb, (const float*)(F.ws + WS_A2), mod + 3 * DM, (const float*)(F.ws + WS_SSQ), nullptr, MIX};
        if (thin_first) thin_resnorm<0>(F);
        pg8::gemm_phase<pg8::EpiResNorm<0>, pg8::PanelOrder, true, true>(F.lds + RING_OFF, g, S, E);
        if (!thin_first) thin_resnorm<0>(F);
    } SEAM(5);
    if (IN(6)) REPS(6) {
        pg8::Gemm g{Hb, (const bf16*)(F.ws + WS_W1), MP, DFF, DM}; pg8::StaticOrder S; S.init(MP, DFF, F.G, (int)blockIdx.x);
        pg8::EpiRelu2 E{HMID, F.in[IN_B1]};
#ifdef PROBE_TWICE_P6
        { pg8::TwiceOrder S2; S2.init2(MP, DFF, F.G, (int)blockIdx.x); pg8::gemm_phase<pg8::EpiRelu2, pg8::TwiceOrder, true, true>(F.lds + RING_OFF, g, S2, E); }
#else
        if (thin_first) thin_ff1(F);
        pg8::gemm_phase<pg8::EpiRelu2, pg8::StaticOrder, true, true>(F.lds + RING_OFF, g, S, E);
#endif
        if (!thin_first) thin_ff1(F);
#ifdef THIN_TWICE
        thin_ff1(F);
#endif
    } SEAM(6);
    if (IN(7)) REPS(7) {
        pg8::Gemm g{HMID, (const bf16*)(F.ws + WS_W2), MP, DM, DFF}; pg8::PanelOrder S; S.init(MP, F.G, F.vcu);
        float* yout = F.out + O_Y;
        pg8::EpiResNorm<1> E{F.out + O_Y, F.out + O_Y + (size_t)MP * DM, yout, F.in[IN_B2], mod + 5 * DM,
                             (unsigned*)(F.ws + WS_XSL) + (size_t)(1 + 2 * rep_) * MT * 4, (unsigned*)(F.ws + WS_CTL) + CW_SEAM + (1 + 2 * rep_) * SEAM_BANK, F.lds + LDSX_OFF,
                             nullptr, nullptr, nullptr, nullptr, F.in[IN_FNW], MIX};
        if (thin_first) thin_resnorm<1>(F);
        pg8::gemm_phase<pg8::EpiResNorm<1>, pg8::PanelOrder, true, true>(F.lds + RING_OFF, g, S, E);
        if (!thin_first) thin_resnorm<1>(F);
    }
#undef IN
#undef SEAM
}

#ifndef MK_ONE_LAUNCH
#define MK_ONE_LAUNCH 1
#endif
extern "C" void kernel_launch(void* const* d_in, const int* in_sizes, int n_in, void* d_out, int out_size, void* d_ws, size_t ws_size, hipStream_t stream) {
    static int grid = 0;
    if (grid == 0) {
        if (n_in != 27 || in_sizes[0] != MP * DM || (size_t)out_size != O_END || ws_size < WS_END) {
            fprintf(stderr, "kernel_launch: shape mismatch: n_in %d in0 %d out %d ws %zu (need %zu)\n", n_in, n_in > 0 ? in_sizes[0] : -1, out_size, ws_size, (size_t)WS_END); grid = -1; return; }
        int dev = 0, cus = 0, per_cu = 0;
        if (hipGetDevice(&dev) != hipSuccess || hipDeviceGetAttribute(&cus, hipDeviceAttributeMultiprocessorCount, dev) != hipSuccess) { grid = -1; return; }
        if (hipFuncSetAttribute((const void*)hymba_fwd, hipFuncAttributeMaxDynamicSharedMemorySize, LDS_BYTES) != hipSuccess) { fprintf(stderr, "kernel_launch: hipFuncSetAttribute failed\n"); grid = -1; return; }
        if (hipOccupancyMaxActiveBlocksPerMultiprocessor(&per_cu, (const void*)hymba_fwd, NWAVES * 64, LDS_BYTES) != hipSuccess || per_cu < 1) { fprintf(stderr, "kernel_launch: occupancy query says %d blocks per CU\n", per_cu); per_cu = 1; }
        (void)hipGetLastError();
        grid = cus;
        if (grid > cus * per_cu) grid = cus * per_cu;
    }
    if (grid < 0) return;
    Args a{};
    for (int i = 0; i < 27; ++i) a.in[i] = (const float*)d_in[i];
    a.out = (float*)d_out; a.ws = (unsigned char*)d_ws;
#if MK_ONE_LAUNCH
    a.ph_lo = 0; a.ph_hi = N_PHASES;
    if (hipMemsetAsync((char*)d_ws + WS_CTL, 0, CTL_ZERO_BYTES, stream) != hipSuccess) { fprintf(stderr, "kernel_launch: hipMemsetAsync failed\n"); return; }
    hipLaunchKernelGGL(hymba_fwd, dim3(grid), dim3(NWAVES * 64), LDS_BYTES, stream, a);
    { const hipError_t le = hipPeekAtLastError(); if (le != hipSuccess) fprintf(stderr, "kernel_launch: launch failed: %s (grid %d)\n", hipGetErrorName(le), grid); }
#else
    for (int p = 0; p < N_PHASES; ++p) { a.ph_lo = p; a.ph_hi = p + 1;
        hipLaunchKernelGGL(hymba_fwd, dim3(grid), dim3(NWAVES * 64), LDS_BYTES, stream, a);
        const hipError_t le = hipPeekAtLastError(); if (le != hipSuccess) { fprintf(stderr, "kernel_launch: launch %d failed: %s\n", p, hipGetErrorName(le)); break; } }
#endif
}
```

```cpp
#include <hip/hip_runtime.h>
#include <hip/hip_cooperative_groups.h>
#include <cstdio>
#include <cstdint>
#include <type_traits>
namespace cg = cooperative_groups;

constexpr int DM = 1024, NB_P = 16, SEQ = 4096, NB_S = 32, DSEQ = 16;
constexpr int MP = NB_P * SEQ, MS = NB_S * DSEQ, MT = MP + MS, NBT = NB_P + NB_S;
constexpr int NPROJ = 3584, LDWIN = 3600, DFF = 4096, MIXW = 2048, CONVD = 1536, NH = 16, HD = 64, NST = 128, NMOD = 6 * DM;
constexpr float EPS = 1e-6f;
constexpr size_t O_Y = 0, O_PP = (size_t)MT * DM, O_CP = O_PP + (size_t)NB_P * 15 * DM, O_SP = O_CP + (size_t)NB_P * 3 * CONVD,
                 O_PS = O_SP + (size_t)NB_P * NH * HD * NST, O_CS = O_PS + (size_t)NB_S * 15 * DM, O_SS = O_CS + (size_t)NB_S * 3 * CONVD,
                 O_END = O_SS + (size_t)NB_S * NH * HD * NST;
namespace pg8 {
#define PG8_LAS __attribute__((address_space(3)))
typedef unsigned short bf16_t;
typedef short bf16x8 __attribute__((ext_vector_type(8)));
typedef float f32x4 __attribute__((ext_vector_type(4)));
typedef unsigned u32x4 __attribute__((ext_vector_type(4)));
constexpr int BM = 256, BK = 64, HALF = 128, HTB = HALF * BK * 2  , STAGE_BYTES = 8 * HTB, NXCD = 8, WGM = 8;

__host__ __device__ __forceinline__ int lds_byte(int r, int c) { const int st = (r >> 4) * 2 + (c >> 5), rr = r & 15, cc = c & 31, ob = rr * 64 + cc * 2; return st * 1024 + (ob ^ (((ob >> 9) & 1) << 5)); }
__host__ __device__ __forceinline__ void stage_rc(int b, int& R, int& C) { const int st = b / 1024, sb = b % 1024, swz = sb ^ (((sb >> 9) & 1) << 5); R = (st >> 1) * 16 + swz / 64; C = (st & 1) * 32 + (swz % 64) / 2; }
__host__ __device__ __forceinline__ int perm32(int rho) { const int n = rho >> 4, i = rho & 15; return 8 * (i >> 2) + 4 * n + (i & 3); }

struct Unit { int pm, pn; };
struct Gemm { const bf16_t* A; const bf16_t* Bt; int M, N, K; };

struct StaticOrder {
    int nM, nN, nwg, G, c;
    __host__ __device__ void init(int M, int N, int G_, int c_) { nM = M / BM; nN = N / BM; nwg = nM * nN; G = G_; c = c_; }
    __host__ __device__ bool next(int i, Unit& u) const {
        const long L = (long)i * G + c; if (L >= nwg) return false;
        int wgid = (int)L; { const int q = nwg / NXCD, r = nwg % NXCD, xcd = wgid % NXCD, off = wgid / NXCD; wgid = (xcd < r ? xcd * (q + 1) : r * (q + 1) + (xcd - r) * q) + off; }
        const int nig = WGM * nN, gid = wgid / nig, fm = gid * WGM, gsz = (nM - fm) < WGM ? (nM - fm) : WGM;
        u.pm = fm + ((wgid % nig) % gsz); u.pn = (wgid % nig) / gsz; return true;
    }
    __device__ __forceinline__ void a_ready(const Unit&) const {}
    __device__ __forceinline__ void done(const Unit&) const {}
};
__device__ __forceinline__ unsigned cvt_pk_bf16(float lo, float hi) { unsigned r; asm volatile("v_cvt_pk_bf16_f32 %0, %1, %2" : "=v"(r) : "v"(lo), "v"(hi)); return r; }
typedef unsigned u32x2 __attribute__((ext_vector_type(2)));
typedef float f32x2e __attribute__((ext_vector_type(2)));
#ifndef EPI_CONV
#define EPI_CONV 1
#endif
#ifndef EPI_POOL
#define EPI_POOL 1
#endif
struct EpiProj {
    static constexpr bool PERM = true, AFTER_DRAIN = false, KHOOK = false, PREFETCH = false; static constexpr int KH0 = -1, KH1 = -1;
    bf16_t* O; float* out;
    size_t o_pp, o_cp, o_ps, o_cs;
    bf16_t* XB; const float* convw; const float* convb;
#define EPI_TAP0(K, cur_) __builtin_bit_cast(float, __builtin_amdgcn_mov_dpp(__builtin_bit_cast(int, (cur_)), 0x110 + (K), 0xf, 0xf, true))
#define EPI_TAP(K, cur_, prv_) __builtin_bit_cast(float, __builtin_amdgcn_update_dpp(__builtin_amdgcn_mov_dpp(__builtin_bit_cast(int, (prv_)), 0x100 + 16 - (K), 0xf, 0xf, true), __builtin_bit_cast(int, (cur_)), 0x110 + (K), 0xf, 0xf, false))
    __device__ __forceinline__ void conv_tile(const f32x4 (&acc)[2][2][4][2], const Unit& u, int wr, int wc, int fr_, int fq_) const {
        int fr = fr_, fq = fq_; asm volatile("" : "+v"(fr), "+v"(fq));
        const int ch0 = (u.pn - 8) * BM + wc * 32 + 8 * fq;
        const int row0 = u.pm * BM + wr * 64 + fr;
#pragma unroll
        for (int bj = 0; bj < 2; ++bj) {
            f32x4 wv[4][2], bv[2];
#pragma unroll
            for (int n = 0; n < 2; ++n) { bv[n] = *(const f32x4*)(convb + ch0 + bj * HALF + 4 * n);
#pragma unroll
                for (int k = 0; k < 4; ++k) wv[k][n] = *(const f32x4*)(convw + k * 1536 + ch0 + bj * HALF + 4 * n); }
#pragma unroll
            for (int ai = 0; ai < 2; ++ai)
#pragma unroll
                for (int m = 0; m < 4; ++m) { unsigned pk[4];
#pragma unroll
                    for (int n = 0; n < 2; ++n) {
                        const f32x4 X = acc[ai][bj][m][n]; f32x4 T1, T2, T3;
#pragma unroll
                        for (int j = 0; j < 4; ++j) { const float x0 = X[j];
                            if (m > 0) { const float xp = acc[ai][bj][m > 0 ? m - 1 : 0][n][j]; T1[j] = EPI_TAP(1, x0, xp); T2[j] = EPI_TAP(2, x0, xp); T3[j] = EPI_TAP(3, x0, xp); }
                            else { T1[j] = EPI_TAP0(1, x0); T2[j] = EPI_TAP0(2, x0); T3[j] = EPI_TAP0(3, x0); } }
                        const f32x4 v = wv[0][n] * T3 + (wv[1][n] * T2 + (wv[2][n] * T1 + (wv[3][n] * X + bv[n])));
                        const f32x4 t = v * -1.4426950408889634f;
                        const f32x4 dn = (f32x4){__builtin_amdgcn_exp2f(t.x), __builtin_amdgcn_exp2f(t.y), __builtin_amdgcn_exp2f(t.z), __builtin_amdgcn_exp2f(t.w)} + 1.0f;
                        const f32x4 o = v * (f32x4){__builtin_amdgcn_rcpf(dn.x), __builtin_amdgcn_rcpf(dn.y), __builtin_amdgcn_rcpf(dn.z), __builtin_amdgcn_rcpf(dn.w)};
                        pk[2 * n] = cvt_pk_bf16(o.x, o.y); pk[2 * n + 1] = cvt_pk_bf16(o.z, o.w); }
                    u32x4 w; w.x = pk[0]; w.y = pk[1]; w.z = pk[2]; w.w = pk[3];
                    *(u32x4*)(XB + (size_t)(row0 + ai * HALF + m * 16) * 1536 + ch0 + bj * HALF) = w;
                    if ((m == 0 && fr < 3) || (m == 3 && fr >= 13)) { const f32x4 v0 = acc[ai][bj][m][0], v1 = acc[ai][bj][m][1];
                        u32x4 r; r.x = cvt_pk_bf16(v0[0], v0[1]); r.y = cvt_pk_bf16(v0[2], v0[3]); r.z = cvt_pk_bf16(v1[0], v1[1]); r.w = cvt_pk_bf16(v1[2], v1[3]);
                        *(u32x4*)(O + (size_t)(row0 + ai * HALF + m * 16) * 3584 + 2048 + ch0 + bj * HALF) = r; } }
        }
    }
    bf16_t* MX;
    template <int W>
    __device__ __forceinline__ void pool_tile(const f32x4 (&acc)[2][2][4][2], const Unit& u, int wr, int wc, int fr_, int fq_) const {
        int fr = fr_, fq = fq_; asm volatile("" : "+v"(fr), "+v"(fq));
        const int ch0 = u.pn * BM + wc * 32 + 8 * fq, row0 = u.pm * BM + wr * 64 + fr;
        constexpr float INV = 1.0f / (float)W;
#pragma unroll
        for (int bj = 0; bj < 2; ++bj)
#pragma unroll
            for (int ai = 0; ai < 2; ++ai) { float o[4][8];
#pragma unroll
                for (int n = 0; n < 2; ++n)
#pragma unroll
                    for (int j = 0; j < 4; ++j) { float s[4];
#pragma unroll
                        for (int m = 0; m < 4; ++m) s[m] = acc[ai][bj][m][n][j];
                        { float t[4];
#pragma unroll
                          for (int m = 0; m < 4; ++m) t[m] = s[m] + (m > 0 ? EPI_TAP(1, s[m], s[m > 0 ? m - 1 : 0]) : EPI_TAP0(1, s[m]));
#pragma unroll
                          for (int m = 0; m < 4; ++m) s[m] = t[m]; }
                        if constexpr (W >= 4) { float t[4];
#pragma unroll
                          for (int m = 0; m < 4; ++m) t[m] = s[m] + (m > 0 ? EPI_TAP(2, s[m], s[m > 0 ? m - 1 : 0]) : EPI_TAP0(2, s[m]));
#pragma unroll
                          for (int m = 0; m < 4; ++m) s[m] = t[m]; }
                        if constexpr (W >= 8) { float t[4];
#pragma unroll
                          for (int m = 0; m < 4; ++m) t[m] = s[m] + (m > 0 ? EPI_TAP(4, s[m], s[m > 0 ? m - 1 : 0]) : EPI_TAP0(4, s[m]));
#pragma unroll
                          for (int m = 0; m < 4; ++m) s[m] = t[m]; }
                        if constexpr (W >= 16) { float t[4];
#pragma unroll
                          for (int m = 0; m < 4; ++m) t[m] = s[m] + (m > 0 ? EPI_TAP(8, s[m], s[m > 0 ? m - 1 : 0]) : EPI_TAP0(8, s[m]));
#pragma unroll
                          for (int m = 0; m < 4; ++m) s[m] = t[m]; }
#pragma unroll
                        for (int m = 0; m < 4; ++m) o[m][4 * n + j] = s[m] * INV - acc[ai][bj][m][n][j]; }
#pragma unroll
                for (int m = 0; m < 4; ++m) { u32x4 w; w.x = cvt_pk_bf16(o[m][0], o[m][1]); w.y = cvt_pk_bf16(o[m][2], o[m][3]); w.z = cvt_pk_bf16(o[m][4], o[m][5]); w.w = cvt_pk_bf16(o[m][6], o[m][7]);
                    *(u32x4*)(MX + (size_t)(row0 + ai * HALF + m * 16) * 2048 + 1024 + ch0 + bj * HALF) = w;
                    if ((m == 0 && fr < W - 1) || (m == 3 && fr >= 17 - W)) { const f32x4 v0 = acc[ai][bj][m][0], v1 = acc[ai][bj][m][1];
                        u32x4 r; r.x = cvt_pk_bf16(v0[0], v0[1]); r.y = cvt_pk_bf16(v0[2], v0[3]); r.z = cvt_pk_bf16(v1[0], v1[1]); r.w = cvt_pk_bf16(v1[2], v1[3]);
                        *(u32x4*)(O + (size_t)(row0 + ai * HALF + m * 16) * 3584 + ch0 + bj * HALF) = r; } }
            }
    }
    __device__ __forceinline__ void operator()(const f32x4 (&acc)[2][2][4][2], const Unit& u, int wr, int wc, int fr, int fq) const {
        const int row0 = u.pm * BM + wr * 64 + fr, col0 = u.pn * BM + wc * 32 + 8 * fq;
        if (EPI_CONV && u.pn >= 8) conv_tile(acc, u, wr, wc, fr, fq);
        else if (EPI_POOL && u.pn == 0) pool_tile<2>(acc, u, wr, wc, fr, fq);
        else if (EPI_POOL && u.pn == 1) pool_tile<4>(acc, u, wr, wc, fr, fq);
        else if (EPI_POOL && u.pn == 2) pool_tile<8>(acc, u, wr, wc, fr, fq);
        else if (EPI_POOL && u.pn == 3) pool_tile<16>(acc, u, wr, wc, fr, fq);
        else {
#pragma unroll
        for (int ai = 0; ai < 2; ++ai)
#pragma unroll
            for (int m = 0; m < 4; ++m) { bf16_t* rowp = O + (size_t)(row0 + ai * HALF + m * 16) * 3584 + col0;
#pragma unroll
                for (int bj = 0; bj < 2; ++bj) { const f32x4 v0 = acc[ai][bj][m][0], v1 = acc[ai][bj][m][1];
                    u32x4 w; w.x = cvt_pk_bf16(v0[0], v0[1]); w.y = cvt_pk_bf16(v0[2], v0[3]); w.z = cvt_pk_bf16(v1[0], v1[1]); w.w = cvt_pk_bf16(v1[2], v1[3]);
                    *(u32x4*)(rowp + bj * HALF) = w; } }
        }
        const bool is_u = u.pn < 4, is_c = u.pn >= 8;
        if (!(is_u || is_c)) return;
        if (u.pm < 256) {
            if ((u.pm & 15) != 15 || wr != 1) return;
            const int b = u.pm >> 4, lr = 240 + fr;
            if (is_u) { if (fr >= 1) { float* dst = out + o_pp + ((size_t)(b * 15 + (fr - 1)) * 1024 + col0);
#pragma unroll
                    for (int bj = 0; bj < 2; ++bj) { *(f32x4*)(dst + bj * HALF) = acc[1][bj][3][0]; *(f32x4*)(dst + bj * HALF + 4) = acc[1][bj][3][1]; } } }
            else { if (fr >= 13) { float* dst = out + o_cp + ((size_t)(b * 3 + (fr - 13)) * 1536 + (col0 - 2048));
#pragma unroll
                    for (int bj = 0; bj < 2; ++bj) { *(f32x4*)(dst + bj * HALF) = acc[1][bj][3][0]; *(f32x4*)(dst + bj * HALF + 4) = acc[1][bj][3][1]; } } }
            (void)lr;
        } else {
#pragma unroll
            for (int ai = 0; ai < 2; ++ai)
#pragma unroll
                for (int m = 0; m < 4; ++m) { const int sb = (u.pm - 256) * 16 + 8 * ai + 4 * wr + m;
                    if (is_u) { if (fr >= 1) { float* dst = out + o_ps + ((size_t)(sb * 15 + (fr - 1)) * 1024 + col0);
#pragma unroll
                            for (int bj = 0; bj < 2; ++bj) { *(f32x4*)(dst + bj * HALF) = acc[ai][bj][m][0]; *(f32x4*)(dst + bj * HALF + 4) = acc[ai][bj][m][1]; } } }
                    else { if (fr >= 13) { float* dst = out + o_cs + ((size_t)(sb * 3 + (fr - 13)) * 1536 + (col0 - 2048));
#pragma unroll
                            for (int bj = 0; bj < 2; ++bj) { *(f32x4*)(dst + bj * HALF) = acc[ai][bj][m][0]; *(f32x4*)(dst + bj * HALF + 4) = acc[ai][bj][m][1]; } } } }
        }
    }
};
struct EpiRelu2 {
    static constexpr bool PERM = true, AFTER_DRAIN = false, KHOOK = false, PREFETCH = false; static constexpr int KH0 = -1, KH1 = -1;
    bf16_t* O; const float* bias;
    __device__ __forceinline__ void operator()(const f32x4 (&acc)[2][2][4][2], const Unit& u, int wr, int wc, int fr, int fq) const {
        const int row0 = u.pm * BM + wr * 64 + fr, col0 = u.pn * BM + wc * 32 + 8 * fq;
        f32x4 bv[2][2];
#pragma unroll
        for (int bj = 0; bj < 2; ++bj)
#pragma unroll
            for (int n = 0; n < 2; ++n) bv[bj][n] = *(const f32x4*)(bias + col0 + bj * HALF + 4 * n);
#pragma unroll
        for (int ai = 0; ai < 2; ++ai)
#pragma unroll
            for (int m = 0; m < 4; ++m) { bf16_t* rowp = O + (size_t)(row0 + ai * HALF + m * 16) * 4096 + col0;
#pragma unroll
                for (int bj = 0; bj < 2; ++bj) { f32x4 v0 = acc[ai][bj][m][0] + bv[bj][0], v1 = acc[ai][bj][m][1] + bv[bj][1];
#pragma unroll
                    for (int j = 0; j < 4; j += 2) { f32x2e a = (f32x2e){fmaxf(v0[j], 0.f), fmaxf(v0[j + 1], 0.f)}, b = (f32x2e){fmaxf(v1[j], 0.f), fmaxf(v1[j + 1], 0.f)}; a = a * a; b = b * b;
                        v0[j] = a.x; v0[j + 1] = a.y; v1[j] = b.x; v1[j + 1] = b.y; }
                    u32x4 w; w.x = cvt_pk_bf16(v0[0], v0[1]); w.y = cvt_pk_bf16(v0[2], v0[3]); w.z = cvt_pk_bf16(v1[0], v1[1]); w.w = cvt_pk_bf16(v1[2], v1[3]);
                    *(u32x4*)(rowp + bj * HALF) = w; } }
    }
};
struct EpiRes {
    static constexpr bool PERM = false, AFTER_DRAIN = false, KHOOK = false, PREFETCH = false; static constexpr int KH0 = -1, KH1 = -1;
    const float* baseP; const float* baseS;
    float* out;
    const float* bias;
    const float* gate;
    __device__ __forceinline__ void operator()(const f32x4 (&acc)[2][2][4][2], const Unit& u, int wr, int wc, int fr, int fq) const {
        const bool smp = u.pm >= 256;
        const float* bp = smp ? baseS + (size_t)(u.pm - 256) * BM * 1024 : baseP + (size_t)u.pm * BM * 1024;
        float* op = out + (size_t)u.pm * BM * 1024;
        const int col0 = u.pn * BM + wc * 32 + 4 * fq;
        f32x4 bv[2][2];
#pragma unroll
        for (int bj = 0; bj < 2; ++bj)
#pragma unroll
            for (int n = 0; n < 2; ++n) bv[bj][n] = *(const f32x4*)(bias + col0 + bj * HALF + n * 16);
#pragma unroll
        for (int ai = 0; ai < 2; ++ai)
#pragma unroll
            for (int m = 0; m < 4; ++m) { const int lr = ai * HALF + wr * 64 + m * 16 + fr;
                const int b = smp ? 16 + (u.pm - 256) * 16 + (lr >> 4) : (u.pm >> 4);
                const float* gp = gate + (size_t)b * 6144 + col0; const size_t off = (size_t)lr * 1024 + col0;
#pragma unroll
                for (int bj = 0; bj < 2; ++bj)
#pragma unroll
                    for (int n = 0; n < 2; ++n) { const f32x4 g = *(const f32x4*)(gp + bj * HALF + n * 16), x = *(const f32x4*)(bp + off + bj * HALF + n * 16);
                        *(f32x4*)(op + off + bj * HALF + n * 16) = x + g * (acc[ai][bj][m][n] + bv[bj][n]); }
                asm volatile("" ::: "memory"); }
    }
};


struct ProjOrder : StaticOrder {
    __host__ __device__ bool next(int i, Unit& u) const { if (!StaticOrder::next(i, u)) return false; if (u.pn == 2) u.pn = 3; else if (u.pn == 3) u.pn = 2; return true; }
};
struct PanelOrder {
    int nunits, G, v;
    __host__ __device__ void init(int M, int G_, int v_) { nunits = (M / BM) * 4; G = G_; v = v_; }
    __host__ __device__ bool next(int i, Unit& u) const { const int L = i * G + v; if (L >= nunits) return false; u.pm = L >> 2; u.pn = L & 3; return true; }
    __device__ __forceinline__ void a_ready(const Unit&) const {}
    __device__ __forceinline__ void done(const Unit&) const {}
};
template <int MODE> struct EpiResNorm {
    #ifdef AB_NO_KHOOK
    static constexpr bool PERM = true, AFTER_DRAIN = false, KHOOK = false, PREFETCH = false;
#else
    static constexpr bool PERM = true, AFTER_DRAIN = false, KHOOK = (MODE == 0), PREFETCH = false;
#endif
    static constexpr int KH0 = 8, KH1 = 16;
    const float* baseP; const float* baseS; float* out; const float* bias; const float* gate;
    unsigned* xslots;
    unsigned* cnt;
    PG8_LAS unsigned char* ldsx;
    bf16_t* H; const float* A2; const float* sh2;
    const float* ssq;
    const float* fw;
    bf16_t* x1b;
    __device__ __forceinline__ void prefetch(const Unit& u, int wid) const {
        int tid = threadIdx.x; asm volatile("" : "+v"(tid));
        const float* bp = (u.pm >= 256 ? baseS + (size_t)(u.pm - 256) * BM * 1024 : baseP + (size_t)u.pm * BM * 1024) + u.pn * BM;
#pragma unroll
        for (int i = 0; i < 4; ++i) { const int line = tid + 512 * i;
            __builtin_amdgcn_global_load_lds((const unsigned*)(bp + (size_t)(line >> 3) * 1024 + (line & 7) * 32), (PG8_LAS unsigned*)(ldsx + 7168 + wid * 256), 4, 0, 0); }
    }
    __device__ __forceinline__ void prep(const Unit& u) const {
        int tid = threadIdx.x; asm volatile("" : "+v"(tid));
        if (tid < 256) { const f32x4* p = (const f32x4*)(ssq + (size_t)(u.pm * BM + tid) * 16); const f32x4 a = p[0], b = p[1], c = p[2], d = p[3];
            const float s0 = ((a.x + a.y) + (a.z + a.w)) + ((b.x + b.y) + (b.z + b.w)), s1 = ((c.x + c.y) + (c.z + c.w)) + ((d.x + d.y) + (d.z + d.w));
            const float r0 = 1.0f / sqrtf(s0 * (1.f / 512.f) + 1e-6f), r1 = 1.0f / sqrtf(s1 * (1.f / 512.f) + 1e-6f);
            PG8_LAS float* t = (PG8_LAS float*)ldsx; t[tid] = r0 / r1; t[256 + tid] = r1; }
    }
    __device__ __forceinline__ void khook(f32x4 (&acc)[2][2][4][2], int t, int wr, int fr_) const {
        int fr = fr_; asm volatile("" : "+v"(fr));
        const PG8_LAS float* tb = (const PG8_LAS float*)ldsx + (t == KH0 ? 0 : 256);
#pragma unroll
        for (int ai = 0; ai < 2; ++ai)
#pragma unroll
            for (int m = 0; m < 4; ++m) { const float f = tb[ai * HALF + wr * 64 + m * 16 + fr];
#pragma unroll
                for (int bj = 0; bj < 2; ++bj)
#pragma unroll
                    for (int n = 0; n < 2; ++n) acc[ai][bj][m][n] = acc[ai][bj][m][n] * f; }
    }
    __device__ __forceinline__ void operator()(f32x4 (&acc)[2][2][4][2], const Unit& u, int wr, int wc, int fr_, int fq_) const {
        int tid = threadIdx.x, fr = fr_, fq = fq_;
        asm volatile("" : "+v"(tid), "+v"(fr), "+v"(fq));
        const int lane = tid & 63, wid = __builtin_amdgcn_readfirstlane(tid >> 6);
        const bool smp = u.pm >= 256;
        const float* bp = smp ? baseS + (size_t)(u.pm - 256) * BM * 1024 : baseP + (size_t)u.pm * BM * 1024;
        float* op = out + (size_t)u.pm * BM * 1024;
        const int col0 = u.pn * BM + wc * 32 + 8 * fq;
        PG8_LAS float* P = (PG8_LAS float*)(ldsx + 2048); PG8_LAS float* S = (PG8_LAS float*)(ldsx + 6144);
#pragma unroll
        for (int bj = 0; bj < 2; ++bj)
#pragma unroll
            for (int n = 0; n < 2; ++n) { const f32x4 bv = *(const f32x4*)(bias + col0 + bj * HALF + n * 4);
#pragma unroll
                for (int ai = 0; ai < 2; ++ai)
#pragma unroll
                    for (int m = 0; m < 4; ++m) acc[ai][bj][m][n] += bv; }
        const int b = u.pm >> 4;
        f32x4 gv[2][2];
#pragma unroll
        for (int bj = 0; bj < 2; ++bj)
#pragma unroll
            for (int n = 0; n < 2; ++n) gv[bj][n] = *(const f32x4*)(gate + (size_t)b * 6144 + col0 + bj * HALF + n * 4);
#pragma unroll
        for (int ai = 0; ai < 2; ++ai)
#pragma unroll
            for (int m = 0; m < 4; ++m) { const int lr = ai * HALF + wr * 64 + m * 16 + fr;
                const size_t off = (size_t)lr * 1024 + col0; float s = 0.f;
#pragma unroll
                for (int bj = 0; bj < 2; ++bj) { f32x4 x0, x1;
                    if constexpr (MODE == 0) { x0 = *(const f32x4*)(bp + off + bj * HALF); x1 = *(const f32x4*)(bp + off + bj * HALF + 4); }
                    else { const u32x4 xw = *(const u32x4*)(x1b + (size_t)(u.pm * BM + lr) * 2048 + col0 + bj * HALF);
                        x0 = (f32x4){__uint_as_float(xw.x << 16), __uint_as_float(xw.x & 0xffff0000u), __uint_as_float(xw.y << 16), __uint_as_float(xw.y & 0xffff0000u)};
                        x1 = (f32x4){__uint_as_float(xw.z << 16), __uint_as_float(xw.z & 0xffff0000u), __uint_as_float(xw.w << 16), __uint_as_float(xw.w & 0xffff0000u)}; }
                    const f32x4 g0 = gv[bj][0], g1 = gv[bj][1];
                    const f32x4 v0 = x0 + g0 * acc[ai][bj][m][0], v1 = x1 + g1 * acc[ai][bj][m][1]; acc[ai][bj][m][0] = v0; acc[ai][bj][m][1] = v1;
                    { const f32x4 q = v0 * v0 + v1 * v1; s += (q.x + q.y) + (q.z + q.w); } }
                s += __shfl_xor(s, 16); s += __shfl_xor(s, 32);
                if (fq == 0) P[lr * 4 + wc] = s;
                asm volatile("" : "+v"(acc[ai][0][m][0]), "+v"(acc[ai][0][m][1]), "+v"(acc[ai][1][m][0]), "+v"(acc[ai][1][m][1]));
                if (m == 3 && MODE == 0) asm volatile("" ::: "memory"); }
        asm volatile("s_waitcnt lgkmcnt(0)" ::: "memory"); __builtin_amdgcn_s_barrier(); asm volatile("" ::: "memory");
        if (tid < 256) { const f32x4 p4 = *(const PG8_LAS f32x4*)(P + tid * 4); const float t = (p4.x + p4.y) + (p4.z + p4.w);
            __hip_atomic_store(xslots + ((size_t)(u.pm * BM + tid) * 4 + u.pn), __float_as_uint(t), __ATOMIC_RELAXED, __HIP_MEMORY_SCOPE_AGENT); }
        asm volatile("s_waitcnt vmcnt(0)" ::: "memory");
        if (wid < 4 && lane == 0) __hip_atomic_fetch_add(cnt + 64 * u.pm, 1u, __ATOMIC_RELAXED, __HIP_MEMORY_SCOPE_AGENT);
        if (wid == 0) { unsigned sp = 0;
            while ((unsigned)__builtin_amdgcn_readfirstlane(__hip_atomic_load(cnt + 64 * u.pm, __ATOMIC_RELAXED, __HIP_MEMORY_SCOPE_AGENT)) < 16u) { __builtin_amdgcn_s_sleep(2); if (++sp > (1u << 22)) break; }
            }
        asm volatile("s_waitcnt vmcnt(0) lgkmcnt(0)" ::: "memory"); __builtin_amdgcn_s_barrier(); asm volatile("" ::: "memory");
        if (tid < 256) { const unsigned* sl = xslots + (size_t)(u.pm * BM + tid) * 4; float t = 0.f;
#pragma unroll
            for (int q = 0; q < 4; ++q) t += __uint_as_float(__hip_atomic_load(sl + q, __ATOMIC_RELAXED, __HIP_MEMORY_SCOPE_AGENT));
            S[tid] = 1.0f / sqrtf(t * (1.f / 1024.f) + 1e-6f); }
        asm volatile("s_waitcnt lgkmcnt(0)" ::: "memory"); __builtin_amdgcn_s_barrier(); asm volatile("" ::: "memory");
        f32x4 pa[2][2], pb[2][2];
#pragma unroll
        for (int bj = 0; bj < 2; ++bj)
#pragma unroll
            for (int n = 0; n < 2; ++n) {
                if constexpr (MODE == 0) { pa[bj][n] = *(const f32x4*)(A2 + (size_t)b * 1024 + col0 + bj * HALF + n * 4); pb[bj][n] = *(const f32x4*)(sh2 + (size_t)b * 6144 + col0 + bj * HALF + n * 4); }
                else { pa[bj][n] = *(const f32x4*)(fw + col0 + bj * HALF + n * 4); pb[bj][n] = pa[bj][n]; } }
#pragma unroll
        for (int ai = 0; ai < 2; ++ai)
#pragma unroll
            for (int m = 0; m < 4; ++m) { const int lr = ai * HALF + wr * 64 + m * 16 + fr; const float rs = S[lr]; const size_t off = (size_t)lr * 1024 + col0;
                if constexpr (MODE == 0) {
                    bf16_t* hp = H + (size_t)(u.pm * BM + lr) * 1024 + col0;
#pragma unroll
                    for (int bj = 0; bj < 2; ++bj) { const f32x4 v0 = acc[ai][bj][m][0], v1 = acc[ai][bj][m][1];
                        { u32x4 xw; xw.x = cvt_pk_bf16(v0.x, v0.y); xw.y = cvt_pk_bf16(v0.z, v0.w); xw.z = cvt_pk_bf16(v1.x, v1.y); xw.w = cvt_pk_bf16(v1.z, v1.w); *(u32x4*)(x1b + (size_t)(u.pm * BM + lr) * 2048 + col0 + bj * HALF) = xw; }
                        const f32x4 h0 = v0 * rs * pa[bj][0] + pb[bj][0], h1 = v1 * rs * pa[bj][1] + pb[bj][1];
                        u32x4 w; w.x = cvt_pk_bf16(h0.x, h0.y); w.y = cvt_pk_bf16(h0.z, h0.w); w.z = cvt_pk_bf16(h1.x, h1.y); w.w = cvt_pk_bf16(h1.z, h1.w); *(u32x4*)(hp + bj * HALF) = w; }
                } else {
#pragma unroll
                    for (int bj = 0; bj < 2; ++bj)
#pragma unroll
                        for (int n = 0; n < 2; ++n) *(f32x4*)(op + off + bj * HALF + n * 4) = acc[ai][bj][m][n] * rs * pa[bj][n];
                }
                asm volatile("" ::: "memory"); }
    }
};

struct TwiceOrder : StaticOrder {
    int R;
    __host__ __device__ void init2(int M, int N, int G_, int c_) { init(M, N, G_, c_); R = (nwg + G - 1) / G; }
    __host__ __device__ bool next(int i, Unit& u) const { if (i >= 2 * R) return false; return StaticOrder::next(i % R, u) ? true : StaticOrder::next(0, u); }
};
template <class Epi, class Sched, bool ALIGN_EPI = false, bool SP2 = false>
__device__ __forceinline__ void gemm_phase(PG8_LAS unsigned char* lds, const Gemm g, const Sched& S, const Epi& E) {
    const int tid = threadIdx.x, wid = __builtin_amdgcn_readfirstlane(tid >> 6), lane = tid & 63, wr = wid >> 2, wc = wid & 3, fr = lane & 15, fq = lane >> 4;
    const int K = g.K, nt = K / BK;
    unsigned voffA[2], voffB[2];
#pragma unroll
    for (int i = 0; i < 2; ++i) { int R, C; stage_rc(tid * 16 + i * 8192, R, C); const int Rb = Epi::PERM ? ((R & ~31) + perm32(R & 31)) : R;
        voffA[i] = (unsigned)(R * K + C) * 2u; voffB[i] = (unsigned)(Rb * K + C) * 2u; }
    const size_t kstep = (size_t)(BK * 2);
    const size_t hstep = (size_t)HALF * K * 2;
    const size_t tstep = 2 * hstep;
    const unsigned ldsw = (unsigned)wid * 1024u;
    const int aoff = lds_byte(wr * 64 + fr, fq * 8), boff = lds_byte(wc * 32 + fr, fq * 8);
#define PG8_SA(b, h) (((b) * 2 + (h)) * HTB)
#define PG8_SB(b, h) ((4 + (b) * 2 + (h)) * HTB)
#define PG8_STAGE(bufoff, gbase, voff) do { _Pragma("unroll") for (int _i = 0; _i < 2; ++_i) \
        __builtin_amdgcn_global_load_lds((const unsigned*)((const char*)(gbase) + (voff)[_i]), (PG8_LAS unsigned*)(lds + (bufoff) + ldsw + _i * 8192), 16, 0, 0); } while (0)
#define PG8_LDA(dst, b, h) do { _Pragma("unroll") for (int m = 0; m < 4; ++m) _Pragma("unroll") for (int k = 0; k < 2; ++k) dst[m][k] = *(const PG8_LAS bf16x8*)(lds + PG8_SA(b, h) + aoff + m * 2048 + k * 1024); } while (0)
#define PG8_LDB(dst, b, h) do { _Pragma("unroll") for (int n = 0; n < 2; ++n) _Pragma("unroll") for (int k = 0; k < 2; ++k) dst[n][k] = *(const PG8_LAS bf16x8*)(lds + PG8_SB(b, h) + boff + n * 2048 + k * 1024); } while (0)
#define PG8_MMA(ai, bj, At, Bt) do { __builtin_amdgcn_s_setprio(1); _Pragma("unroll") for (int m = 0; m < 4; ++m) _Pragma("unroll") for (int n = 0; n < 2; ++n) _Pragma("unroll") for (int k = 0; k < 2; ++k) \
        acc[ai][bj][m][n] = __builtin_amdgcn_mfma_f32_16x16x32_bf16(Bt[n][k], At[m][k], acc[ai][bj][m][n], 0, 0, 0); __builtin_amdgcn_s_setprio(0); } while (0)
#define PG8_WAIT_V(n) asm volatile("s_waitcnt vmcnt(" #n ")" ::: "memory")
#define PG8_WAIT_L(n) asm volatile("s_waitcnt lgkmcnt(" #n ")" ::: "memory")
#define PG8_BAR __builtin_amdgcn_s_barrier()
#define PG8_SCHED __builtin_amdgcn_sched_barrier(0)
    Unit cur, nxt; int ui = 0;
    if (!S.next(0, cur)) return;
    f32x4 acc[2][2][4][2];
#pragma unroll
    for (int a = 0; a < 2; ++a)
#pragma unroll
        for (int b = 0; b < 2; ++b)
#pragma unroll
            for (int m = 0; m < 4; ++m)
#pragma unroll
                for (int n = 0; n < 2; ++n) acc[a][b][m][n] = (f32x4){0.f, 0.f, 0.f, 0.f};
    bf16x8 At[4][2], B0[2][2], B1[2][2];
    const char* cA = (const char*)g.A + (size_t)cur.pm * tstep; const char* cB = (const char*)g.Bt + (size_t)cur.pn * tstep;
    S.a_ready(cur);
    if constexpr (Epi::KHOOK) E.prep(cur);
    if constexpr (SP2) {
        PG8_STAGE(PG8_SB(0, 0), cB, voffB); PG8_STAGE(PG8_SB(0, 1), cB + hstep, voffB); PG8_STAGE(PG8_SA(0, 0), cA, voffA); PG8_STAGE(PG8_SA(0, 1), cA + hstep, voffA);
        if (wr == 1) PG8_BAR;
        PG8_WAIT_V(2); PG8_BAR;
        PG8_STAGE(PG8_SB(1, 0), cB + kstep, voffB); PG8_STAGE(PG8_SA(1, 0), cA + kstep, voffA); PG8_STAGE(PG8_SB(1, 1), cB + hstep + kstep, voffB);
        PG8_WAIT_V(6); PG8_BAR;
    } else {
        PG8_STAGE(PG8_SB(0, 0), cB, voffB); PG8_STAGE(PG8_SA(0, 0), cA, voffA); PG8_STAGE(PG8_SB(0, 1), cB + hstep, voffB); PG8_STAGE(PG8_SA(0, 1), cA + hstep, voffA);
        if (wr == 1) PG8_BAR;
        PG8_WAIT_V(4); PG8_BAR;
        PG8_STAGE(PG8_SB(1, 0), cB + kstep, voffB); PG8_STAGE(PG8_SA(1, 0), cA + kstep, voffA); PG8_STAGE(PG8_SB(1, 1), cB + hstep + kstep, voffB);
        PG8_WAIT_V(6); PG8_BAR;
    }
    for (;;) {
        const bool has_next = S.next(ui + 1, nxt);
        const char* nA = has_next ? (const char*)g.A + (size_t)nxt.pm * tstep : cA; const char* nB = has_next ? (const char*)g.Bt + (size_t)nxt.pn * tstep : cB;
        for (int t = 0; t < nt; t += 2) {
            const bool last = (t == nt - 2);
            const char* a1 = cA + (size_t)(t + 1) * kstep;
            const char* a2 = last ? nA : cA + (size_t)(t + 2) * kstep; const char* b2 = last ? nB : cB + (size_t)(t + 2) * kstep;
            const char* a3 = a2 + kstep; const char* b3 = b2 + kstep;
            if (last && has_next) S.a_ready(nxt);
            if constexpr (Epi::KHOOK) { if (t == Epi::KH0 || t == Epi::KH1) E.khook(acc, t, wr, fr); }
            if constexpr (Epi::PREFETCH) { if (t == nt - 4) E.prefetch(cur, wid); }
            if constexpr (SP2) {
            PG8_LDB(B0, 0, 0); PG8_LDB(B1, 0, 1); PG8_SCHED; PG8_LDA(At, 0, 0); PG8_STAGE(PG8_SA(1, 1), a1 + hstep, voffA);
            PG8_WAIT_V(8); PG8_WAIT_L(0); PG8_BAR; PG8_MMA(0, 0, At, B0); PG8_MMA(0, 1, At, B1); PG8_BAR; PG8_SCHED;
            PG8_LDA(At, 0, 1); PG8_STAGE(PG8_SB(0, 0), b2, voffB); PG8_STAGE(PG8_SB(0, 1), b2 + hstep, voffB); PG8_STAGE(PG8_SA(0, 0), a2, voffA);
            PG8_WAIT_V(8); PG8_WAIT_L(0); PG8_BAR; PG8_MMA(1, 0, At, B0); PG8_MMA(1, 1, At, B1); PG8_BAR; PG8_SCHED;
            PG8_LDB(B0, 1, 0); PG8_LDB(B1, 1, 1); PG8_SCHED; PG8_LDA(At, 1, 0); PG8_STAGE(PG8_SA(0, 1), a2 + hstep, voffA);
            PG8_WAIT_V(8); PG8_WAIT_L(0); PG8_BAR; PG8_MMA(0, 0, At, B0); PG8_MMA(0, 1, At, B1); PG8_BAR; PG8_SCHED;
            PG8_LDA(At, 1, 1); PG8_STAGE(PG8_SB(1, 0), b3, voffB); PG8_STAGE(PG8_SB(1, 1), b3 + hstep, voffB); PG8_STAGE(PG8_SA(1, 0), a3, voffA);
            PG8_WAIT_V(8); PG8_WAIT_L(0); PG8_BAR; PG8_MMA(1, 0, At, B0); PG8_MMA(1, 1, At, B1); PG8_BAR; PG8_SCHED;
            } else {
            PG8_LDB(B0, 0, 0); PG8_SCHED; PG8_LDA(At, 0, 0); PG8_STAGE(PG8_SA(1, 1), a1 + hstep, voffA);
            PG8_WAIT_L(8); PG8_BAR; PG8_WAIT_L(0); PG8_MMA(0, 0, At, B0); PG8_BAR; PG8_SCHED;
            PG8_LDB(B1, 0, 1); PG8_STAGE(PG8_SB(0, 0), b2, voffB);
            PG8_BAR; PG8_WAIT_L(0); PG8_MMA(0, 1, At, B1); PG8_BAR;
            PG8_LDA(At, 0, 1); PG8_STAGE(PG8_SA(0, 0), a2, voffA);
            PG8_BAR; PG8_WAIT_L(0); PG8_MMA(1, 0, At, B0); PG8_BAR; PG8_SCHED;
            PG8_STAGE(PG8_SB(0, 1), b2 + hstep, voffB);
            PG8_WAIT_V(6); PG8_BAR; PG8_MMA(1, 1, At, B1); PG8_BAR;
            PG8_LDB(B0, 1, 0); PG8_SCHED; PG8_LDA(At, 1, 0); PG8_STAGE(PG8_SA(0, 1), a2 + hstep, voffA);
            PG8_WAIT_L(8); PG8_BAR; PG8_WAIT_L(0); PG8_MMA(0, 0, At, B0); PG8_BAR; PG8_SCHED;
            PG8_LDB(B1, 1, 1); PG8_STAGE(PG8_SB(1, 0), b3, voffB);
            PG8_BAR; PG8_WAIT_L(0); PG8_MMA(0, 1, At, B1); PG8_BAR;
            PG8_LDA(At, 1, 1); PG8_STAGE(PG8_SA(1, 0), a3, voffA);
            PG8_BAR; PG8_WAIT_L(0); PG8_MMA(1, 0, At, B0); PG8_BAR; PG8_SCHED;
            PG8_STAGE(PG8_SB(1, 1), b3 + hstep, voffB);
            PG8_WAIT_V(6); PG8_BAR; PG8_MMA(1, 1, At, B1); PG8_BAR;
            }
        }
        if constexpr (ALIGN_EPI) { if (wr == 0) PG8_BAR; }
        if constexpr (!Epi::AFTER_DRAIN) { E(acc, cur, wr, wc, fr, fq); S.done(cur); }
        if constexpr (Epi::KHOOK) { if (has_next) E.prep(nxt); }
        if (!has_next) break;
#pragma unroll
        for (int a = 0; a < 2; ++a)
#pragma unroll
            for (int b = 0; b < 2; ++b)
#pragma unroll
                for (int m = 0; m < 4; ++m)
#pragma unroll
                    for (int n = 0; n < 2; ++n) acc[a][b][m][n] = (f32x4){0.f, 0.f, 0.f, 0.f};
        cur = nxt; cA = nA; cB = nB; ++ui;
        if constexpr (ALIGN_EPI) { if (wr == 1) PG8_BAR; }
    }
    PG8_WAIT_V(0);
    if constexpr (!ALIGN_EPI) { if (wr == 0) PG8_BAR; }
    PG8_BAR;
    if constexpr (Epi::AFTER_DRAIN) { E.fused(acc, cur, wr, wc, fr, fq, lds, wid, lane); S.done(cur); }
#undef PG8_SA
#undef PG8_SB
#undef PG8_STAGE
#undef PG8_LDA
#undef PG8_LDB
#undef PG8_MMA
#undef PG8_WAIT_V
#undef PG8_WAIT_L
#undef PG8_BAR
#undef PG8_SCHED
}
}
constexpr size_t MiB = 1u << 20;
constexpr size_t WS_CTL = 0, CTL_ZERO_BYTES = 448 * 1024;
constexpr size_t WS_MOD = 1 * MiB;
constexpr size_t WS_BIASA = 2 * MiB + 512 * 1024;
constexpr size_t WS_A2 = 2 * MiB + 640 * 1024;
constexpr size_t WS_XSL = 944 * MiB;
constexpr size_t WS_WIN = 3 * MiB, WS_WOUT = 10 * MiB, WS_W1 = 14 * MiB, WS_W2 = 22 * MiB;
constexpr size_t WS_H = 32 * MiB;
constexpr size_t WS_PROJ = 161 * MiB;
constexpr size_t WS_DT = 613 * MiB;
constexpr size_t WS_MIX = 680 * MiB;
constexpr size_t WS_SSQ = 938 * MiB;
constexpr size_t WS_HMID = 161 * MiB;
constexpr size_t WS_END = 952 * MiB;
static_assert(WS_H + (size_t)MT * DM * 2 <= WS_PROJ && WS_PROJ + (size_t)MT * NPROJ * 2 <= WS_DT && WS_DT + (size_t)MT * 16 * 4 <= WS_MIX && WS_MIX + (size_t)MT * MIXW * 2 <= WS_SSQ
              && WS_SSQ + (size_t)MT * 16 * 4 <= WS_XSL && WS_HMID + (size_t)MT * DFF * 2 <= WS_MIX && WS_XSL + (size_t)6 * MT * 16 <= WS_END && WS_MOD + (size_t)NBT * NMOD * 4 <= WS_BIASA && WS_W2 + (size_t)DM * DFF * 2 <= WS_H, "d_ws map");

constexpr int NWAVES = 8;
constexpr int RING_OFF = 0, RING_BYTES = 131072;
constexpr int LDS_BYTES = 147456;

#define GAS __attribute__((address_space(1)))
#define LAS __attribute__((address_space(3)))
typedef unsigned short bf16;
typedef unsigned v4u __attribute__((ext_vector_type(4)));
typedef unsigned v2u __attribute__((ext_vector_type(2)));
typedef float f32x4 __attribute__((ext_vector_type(4)));
typedef float f32x2v __attribute__((ext_vector_type(2)));
#define LDS_WAIT() asm volatile("s_waitcnt lgkmcnt(0)" ::: "memory")
__device__ __forceinline__ unsigned f2bf(float f) { unsigned u = __builtin_bit_cast(unsigned, f); return (u + 0x7fffu + ((u >> 16) & 1u)) >> 16; }
__device__ __forceinline__ unsigned pk2(float lo, float hi) { unsigned r; asm("v_cvt_pk_bf16_f32 %0, %1, %2" : "=v"(r) : "v"(lo), "v"(hi)); return r; }
__device__ __forceinline__ float bflo(unsigned w) { return __builtin_bit_cast(float, w << 16); }
__device__ __forceinline__ float bfhi(unsigned w) { return __builtin_bit_cast(float, w & 0xffff0000u); }
__device__ __forceinline__ float wave_sum(float v) {
#pragma unroll
    for (int o = 1; o < 64; o <<= 1) v += __shfl_xor(v, o);
    return v;
}
__device__ __forceinline__ float silu_f(float x) { return x / (1.f + __expf(-x)); }
#define DPP_F(v, ctrl, rmask) __builtin_bit_cast(float, __builtin_amdgcn_update_dpp(0, __builtin_bit_cast(int, (v)), (ctrl), (rmask), 0xf, false))
__device__ __forceinline__ float wave_scan_incl(float v) {
    v += DPP_F(v, 0x111, 0xf); v += DPP_F(v, 0x112, 0xf); v += DPP_F(v, 0x114, 0xf); v += DPP_F(v, 0x118, 0xf);
    v += DPP_F(v, 0x142, 0xa);
    v += DPP_F(v, 0x143, 0xc);
    return v;
}
__device__ __forceinline__ float ex2(float x) { return __builtin_amdgcn_exp2f(x); }
__device__ __forceinline__ float silu_fast(float x) { return x * __builtin_amdgcn_rcpf(1.f + __expf(-x)); }

typedef GAS unsigned gu32;
typedef GAS unsigned long long gu64;
#define RLX_AGENT __ATOMIC_RELAXED, __HIP_MEMORY_SCOPE_AGENT
constexpr int CW_TMO = 0, CW_CODE = 1, CW_BAR = 4096, CW_SEAM = 16384, SEAM_BANK = 320 * 64;
constexpr int LDSX_OFF = RING_BYTES + 512;
static_assert((size_t)(CW_SEAM + 4 * SEAM_BANK + 2 * 8 * 64) * 4 <= CTL_ZERO_BYTES, "every polled word is inside the per-call memset");
constexpr int LDSCTL_OFF = RING_BYTES, MISC_OFF = LDSCTL_OFF + 320;
#define XB_TMO      128
#define XB_XCNT(j)  (256  + 64 * (j))
#define XB_XSUB(j)  (1280 + 64 * (j))
#define XB_XGEN(j)  (2304 + 64 * (j))
#define XB_TOP      3328
#define XB_TOPGEN   3392
#define XCD_BAR_WORDS 3456
#define XB_SPIN_CAP (1u << 18)

__device__ __forceinline__ unsigned xb_ld(unsigned* p)              { return __hip_atomic_load(p, __ATOMIC_RELAXED, __HIP_MEMORY_SCOPE_AGENT); }
__device__ __forceinline__ unsigned xb_add(unsigned* p, unsigned v) { return __hip_atomic_fetch_add(p, v, __ATOMIC_RELAXED, __HIP_MEMORY_SCOPE_AGENT); }
__device__ __forceinline__ unsigned xb_xcc_id() { return (unsigned)__builtin_amdgcn_s_getreg((3 << 11) | 20) & 0xFu; }
#define XB_SPIN(cond, bar) do { unsigned _sp = 0; while (cond) { __builtin_amdgcn_s_sleep(1); \
    if ((++_sp & 255u) == 0u) { if (xb_ld(&(bar)[XB_TMO])) break; if (_sp > XB_SPIN_CAP) { atomicAdd(&(bar)[XB_TMO], 1u); break; } } } } while (0)

struct XcdBarrier {
    unsigned* bar; unsigned x;
    volatile LAS unsigned* st;
};

__device__ __forceinline__ XcdBarrier xcd_barrier_post(unsigned* bar, volatile LAS unsigned* st) {
    XcdBarrier b; b.bar = bar; b.x = xb_xcc_id(); b.st = st;
    if (threadIdx.x == 0) (void)xb_add(&bar[XB_XCNT(b.x)], 1u);
    return b;
}
__device__ __forceinline__ void xcd_barrier_complete(unsigned* bar, unsigned x, unsigned& nloc, unsigned& nx) {
    const unsigned G = gridDim.x * gridDim.y * gridDim.z;
    unsigned sum, cnt, mine, sp = 0u;
    for (;;) {
        sum = 0u; cnt = 0u; mine = 0u;
#pragma unroll
        for (unsigned j = 0; j < 16; ++j) { const unsigned c = xb_ld(&bar[XB_XCNT(j)]); sum += c; cnt += (c > 0u) ? 1u : 0u; mine = (j == x) ? c : mine; }
        if (sum == G) break;
        __builtin_amdgcn_s_sleep(1);
        if ((++sp & 255u) == 0u) { if (xb_ld(&bar[XB_TMO])) break; if (sp > XB_SPIN_CAP) { atomicAdd(&bar[XB_TMO], 1u); break; } }
    }
    nloc = mine > 0u ? mine : 1u; nx = cnt > 0u ? cnt : 1u;
}

__device__ __forceinline__ void xcd_barrier(const XcdBarrier& b) {
    asm volatile("s_waitcnt vmcnt(0)" ::: "memory");
    __syncthreads();
    if (threadIdx.x == 0) {
        unsigned* bar = b.bar;
        __builtin_amdgcn_s_waitcnt(0);
        unsigned nloc = b.st[0], nx = b.st[1];
        if (nloc == 0u) { xcd_barrier_complete(bar, b.x, nloc, nx); b.st[0] = nloc; b.st[1] = nx; }
        const unsigned old = xb_add(&bar[XB_XSUB(b.x)], 1u);
        const unsigned gen = old / nloc;
        if (old + 1u == (gen + 1u) * nloc) {
            __builtin_amdgcn_fence(__ATOMIC_RELEASE, "agent");
            asm volatile("s_waitcnt vmcnt(0)" ::: "memory");
            const unsigned og = xb_add(&bar[XB_TOP], 1u);
            const unsigned tg = og / nx;
            if (og + 1u == (tg + 1u) * nx) xb_add(&bar[XB_TOPGEN], 1u);
            else XB_SPIN(xb_ld(&bar[XB_TOPGEN]) == tg, bar);
            __builtin_amdgcn_fence(__ATOMIC_ACQUIRE, "agent");
            xb_add(&bar[XB_XGEN(b.x)], 1u);
            asm volatile("s_waitcnt vmcnt(0)" ::: "memory");
        } else {
            XB_SPIN(xb_ld(&bar[XB_XGEN(b.x)]) == gen, bar);
            __builtin_amdgcn_fence(__ATOMIC_ACQUIRE, "agent");
            asm volatile("s_waitcnt vmcnt(0)" ::: "memory");
        }
    }
    __syncthreads();
}

typedef short bf16x8 __attribute__((ext_vector_type(8)));
typedef short s16x4 __attribute__((ext_vector_type(4)));
#define MFMA16(a, b, c) __builtin_amdgcn_mfma_f32_16x16x32_bf16((a), (b), (c), 0, 0, 0)
__device__ __forceinline__ unsigned offb(unsigned row, unsigned ch) { return 256u * row + 16u * (ch ^ (((row & 3u) << 2) | ((row >> 2) & 3u))); }
__device__ __forceinline__ bf16x8 frag_row(LAS unsigned char* img, int lane, int rb, int s) { return *(const LAS bf16x8*)(img + offb((unsigned)((lane & 15) + 16 * rb), (unsigned)(4 * s + (lane >> 4)))); }
__device__ __forceinline__ unsigned offr(unsigned row, unsigned ch) { return 256u * row + 16u * (ch ^ (row & 15u)); }
__device__ __forceinline__ bf16x8 frag_rowr(LAS unsigned char* img, int lane, int rb, int s) { return *(const LAS bf16x8*)(img + offr((unsigned)((lane & 15) + 16 * rb), (unsigned)(4 * s + (lane >> 4)))); }
__device__ __forceinline__ bf16x8 frag_tr(LAS unsigned char* img, int lane, int c, int ks) {
    const unsigned g = (unsigned)lane >> 4, q = ((unsigned)lane & 15u) >> 2, p = (unsigned)lane & 3u;
    const s16x4 t0 = __builtin_amdgcn_ds_read_tr16_b64_v4i16((LAS s16x4*)(img + offb(32u * ks + 8u * g + q, 2u * c + (p >> 1)) + 8u * (p & 1u)));
    const s16x4 t1 = __builtin_amdgcn_ds_read_tr16_b64_v4i16((LAS s16x4*)(img + offb(32u * ks + 8u * g + 4u + q, 2u * c + (p >> 1)) + 8u * (p & 1u)));
    return (bf16x8){t0[0], t0[1], t0[2], t0[3], t1[0], t1[1], t1[2], t1[3]};
}

struct Frame {
    LAS unsigned char* lds;
    int tid, lane, wave, vcu, G;
    const float* in[27]; float* out; unsigned char* ws;
};
#define IN_XP 0
#define IN_XS 1
#define IN_CPOOL 2
#define IN_CCONV 3
#define IN_SSM 4
#define IN_CP 5
#define IN_CS 6
#define IN_NW1 7
#define IN_NW2 8
#define IN_WADA 9
#define IN_BADA 10
#define IN_WIN 11
#define IN_POOLW 12
#define IN_POOLB 13
#define IN_POOLS 14
#define IN_CONVW 15
#define IN_CONVB 16
#define IN_DTB 17
#define IN_ALOG 18
#define IN_DSKIP 19
#define IN_SNW 20
#define IN_WOUT 21
#define IN_W1 22
#define IN_B1 23
#define IN_W2 24
#define IN_B2 25
#define IN_FNW 26

typedef float f32x2 __attribute__((ext_vector_type(2)));
__device__ __forceinline__ void p0_mod_unit(Frame& F, int u) {
    const float* w_ada = F.in[IN_WADA]; const float* b_ada = F.in[IN_BADA]; float* mod = (float*)(F.ws + WS_MOD);
    LAS float* red = (LAS float*)(F.lds + RING_OFF);
    const int lane = F.lane, li = lane & 15, kq = lane >> 4, k0 = F.wave * 128, c0 = 32 * u;
    const float* cp[3]; cp[0] = F.in[IN_CP] + (size_t)li * DM; cp[1] = F.in[IN_CS] + (size_t)li * DM; cp[2] = F.in[IN_CS] + (size_t)(16 + li) * DM;
    f32x4 acc[3][2];
#pragma unroll
    for (int mt = 0; mt < 3; ++mt) { acc[mt][0] = (f32x4){0.f, 0.f, 0.f, 0.f}; acc[mt][1] = acc[mt][0]; }
#pragma unroll
    for (int hf = 0; hf < 2; ++hf) {
        f32x4 av[4][3]; f32x2 bv[4][4];
#pragma unroll
        for (int sq = 0; sq < 4; ++sq) { const int kb = k0 + 64 * hf + 16 * sq + 4 * kq;
#pragma unroll
            for (int j = 0; j < 4; ++j) bv[sq][j] = *(const f32x2*)(w_ada + (size_t)(kb + j) * NMOD + c0 + 2 * li);
#pragma unroll
            for (int mt = 0; mt < 3; ++mt) av[sq][mt] = *(const f32x4*)(cp[mt] + kb); }
#pragma unroll
        for (int sq = 0; sq < 4; ++sq)
#pragma unroll
            for (int j = 0; j < 4; ++j)
#pragma unroll
                for (int mt = 0; mt < 3; ++mt) { const float a = silu_f(av[sq][mt][j]);
                    acc[mt][0] = __builtin_amdgcn_mfma_f32_16x16x4f32(a, bv[sq][j].x, acc[mt][0], 0, 0, 0); acc[mt][1] = __builtin_amdgcn_mfma_f32_16x16x4f32(a, bv[sq][j].y, acc[mt][1], 0, 0, 0); }
    }
#pragma unroll
    for (int mt = 0; mt < 3; ++mt)
#pragma unroll
        for (int t = 0; t < 2; ++t)
#pragma unroll
            for (int r = 0; r < 4; ++r) red[(((F.wave * 3 + mt) * 2 + t) * 4 + r) * 64 + lane] = acc[mt][t][r];
    __syncthreads();
    for (int e = F.tid; e < 768; e += NWAVES * 64) { const int mt = e >> 8, r = (e >> 6) & 3, ln = e & 63; float s0 = 0.f, s1 = 0.f;
#pragma unroll
        for (int w = 0; w < 8; ++w) { s0 += red[(((w * 3 + mt) * 2 + 0) * 4 + r) * 64 + ln]; s1 += red[(((w * 3 + mt) * 2 + 1) * 4 + r) * 64 + ln]; }
        const int batch = 16 * mt + 4 * (ln >> 4) + r, c = c0 + 2 * (ln & 15);
        *(f32x2*)(mod + (size_t)batch * NMOD + c) = (f32x2){s0 + b_ada[c], s1 + b_ada[c + 1]}; }
    __syncthreads();
}
__device__ __forceinline__ void p0_bias_unit(Frame& F, int u) {
    const float* pb = F.in[IN_POOLB]; const float* ps = F.in[IN_POOLS]; const float* wo = F.in[IN_WOUT]; LAS float* red = (LAS float*)(F.lds + RING_OFF);
    const int nn = F.tid & 15, kg = F.tid >> 4, n = 16 * u + nn; float s = 0.f;
#pragma unroll 32
    for (int k = 32 * kg; k < 32 * kg + 32; ++k) s += pb[k] * ps[k] * wo[(size_t)k * DM + n];
    red[kg * 16 + nn] = s; __syncthreads();
    if (F.tid < 16) { float t = 0.f;
#pragma unroll
        for (int q = 0; q < 32; ++q) t += red[q * 16 + F.tid];
        ((float*)(F.ws + WS_BIASA))[16 * u + F.tid] = t; }
    __syncthreads();
}
__device__ __forceinline__ void p0_mod(Frame& F) {
    for (int u = blockIdx.x; u < NMOD / 32 + DM / 16; u += F.G) { if (u < NMOD / 32) p0_mod_unit(F, u); else p0_bias_unit(F, u - NMOD / 32); }
}
__device__ __forceinline__ void p0_transpose_item(const float* W, int ldw, int nblk, bf16* WT, int ldt, int kofs, const float* kscale, LAS unsigned char* img, int item, int lane) {
    const int kb = item / nblk, nb = item % nblk, k0 = 64 * kb, n0 = 128 * nb;
    f32x4 v[32];
#pragma unroll
    for (int i = 0; i < 32; ++i) v[i] = *(const f32x4*)(W + (size_t)(k0 + 2 * i + (lane >> 5)) * ldw + n0 + 4 * (lane & 31));
#pragma unroll
    for (int i = 0; i < 32; ++i) { const int kk = 2 * i + (lane >> 5); f32x4 x = v[i]; if (kscale) x = x * kscale[k0 + kk];
        v2u o; o.x = pk2(x.x, x.y); o.y = pk2(x.z, x.w);
        *(LAS v2u*)(img + offb((unsigned)kk, (unsigned)((lane & 31) >> 1)) + 8u * (lane & 1)) = o; }
    LDS_WAIT(); asm volatile("" ::: "memory");
#pragma unroll
    for (int c8 = 0; c8 < 8; ++c8)
#pragma unroll
        for (int ks = 0; ks < 2; ++ks) { const bf16x8 f = frag_tr(img, lane, c8, ks);
            *(GAS bf16x8*)(WT + (size_t)(n0 + 16 * c8 + (lane & 15)) * ldt + kofs + k0 + 32 * ks + 8 * (lane >> 4)) = f; }
    LDS_WAIT(); asm volatile("" ::: "memory");
}
__device__ __forceinline__ void p0_weights(Frame& F) {
    LAS unsigned char* scr = F.lds + RING_OFF + F.wave * 16384;
    const int gw = F.vcu * NWAVES + F.wave, NGW = F.G * NWAVES;
    bf16* Win_t = (bf16*)(F.ws + WS_WIN); bf16* Wout_t = (bf16*)(F.ws + WS_WOUT); bf16* W1_t = (bf16*)(F.ws + WS_W1); bf16* W2_t = (bf16*)(F.ws + WS_W2);
    constexpr int I_IN = (DM / 64) * (NPROJ / 128), I_OB = (DM / 64) * (DM / 128), I_1 = (DM / 64) * (DFF / 128), I_2 = (DFF / 64) * (DM / 128);
    constexpr int NITEMS = I_IN + I_OB + I_1 + I_2;
    for (int it = gw; it < NITEMS; it += NGW) {
        int r = it;
        if (r < I_IN) { p0_transpose_item(F.in[IN_WIN], LDWIN, NPROJ / 128, Win_t, DM, 0, nullptr, scr, r, F.lane); continue; } r -= I_IN;
        if (r < I_OB) { p0_transpose_item(F.in[IN_WOUT] + (size_t)DM * DM, DM, DM / 128, Wout_t, MIXW, 0, F.in[IN_SNW], scr, r, F.lane); continue; } r -= I_OB;
        if (r < I_1) { p0_transpose_item(F.in[IN_W1], DFF, DFF / 128, W1_t, DM, 0, nullptr, scr, r, F.lane); continue; } r -= I_1;
        p0_transpose_item(F.in[IN_W2], DM, DM / 128, W2_t, DFF, 0, nullptr, scr, r, F.lane);
    }
    __syncthreads();
    { const float* pw = F.in[IN_POOLW]; const float* ps = F.in[IN_POOLS]; const float* wo = F.in[IN_WOUT];
      LAS float* As = (LAS float*)(F.lds + RING_OFF); LAS float* Bs = As + 64 * 132;
      const int li = F.lane & 15, kq = F.lane >> 4, tid = F.tid, tr = F.wave >> 1, tc = 2 * (F.wave & 1);
      for (int t = blockIdx.x; t < 256; t += F.G) { const int g = t >> 6, ti = (t >> 4) & 3, tj = t & 15;
          const float* pa = pw + (size_t)(256 * g + 64 * ti) * 256; const float* psg = ps + 256 * g; const float* pbm = wo + (size_t)(256 * g) * DM + 64 * tj;
          f32x4 acc0 = (f32x4){0.f, 0.f, 0.f, 0.f}, acc1 = acc0;
          f32x4 ra[4], rb[4], sa[4];
#pragma unroll
          for (int q = 0; q < 4; ++q) { const int idx = tid + 512 * q;
              ra[q] = *(const f32x4*)(pa + (size_t)(idx >> 5) * 256 + 4 * (idx & 31)); sa[q] = *(const f32x4*)(psg + 4 * (idx & 31)); rb[q] = *(const f32x4*)(pbm + (size_t)(idx >> 4) * DM + 4 * (idx & 15)); }
          for (int hf = 0; hf < 2; ++hf) {
              __syncthreads();
#pragma unroll
              for (int q = 0; q < 4; ++q) { const int idx = tid + 512 * q; *(LAS f32x4*)(As + (idx >> 5) * 132 + 4 * (idx & 31)) = ra[q] * sa[q]; *(LAS f32x4*)(Bs + (idx >> 4) * 68 + 4 * (idx & 15)) = rb[q]; }
              if (hf == 0) {
#pragma unroll
                  for (int q = 0; q < 4; ++q) { const int idx = tid + 512 * q;
                      ra[q] = *(const f32x4*)(pa + (size_t)(idx >> 5) * 256 + 128 + 4 * (idx & 31)); sa[q] = *(const f32x4*)(psg + 128 + 4 * (idx & 31)); rb[q] = *(const f32x4*)(pbm + (size_t)(128 + (idx >> 4)) * DM + 4 * (idx & 15)); } }
              __syncthreads();
#pragma unroll
              for (int sq = 0; sq < 8; ++sq) { const f32x4 a4 = *(const LAS f32x4*)(As + (16 * tr + li) * 132 + 16 * sq + 4 * kq);
#pragma unroll
                  for (int j = 0; j < 4; ++j) { const int d = 16 * sq + 4 * kq + j; const float b0 = Bs[d * 68 + 16 * tc + li], b1 = Bs[d * 68 + 16 * tc + 16 + li];
                      acc0 = __builtin_amdgcn_mfma_f32_16x16x4f32(a4[j], b0, acc0, 0, 0, 0); acc1 = __builtin_amdgcn_mfma_f32_16x16x4f32(a4[j], b1, acc1, 0, 0, 0); } }
          }
          bf16* Wout_t2 = (bf16*)(F.ws + WS_WOUT);
          { v2u o; o.x = pk2(acc0[0], acc0[1]); o.y = pk2(acc0[2], acc0[3]); *(GAS v2u*)(Wout_t2 + (size_t)(64 * tj + 16 * tc + li) * MIXW + 1024 + 256 * g + 64 * ti + 16 * tr + 4 * kq) = o; }
          { v2u o; o.x = pk2(acc1[0], acc1[1]); o.y = pk2(acc1[2], acc1[3]); *(GAS v2u*)(Wout_t2 + (size_t)(64 * tj + 16 * tc + 16 + li) * MIXW + 1024 + 256 * g + 64 * ti + 16 * tr + 4 * kq) = o; }
      }
      __syncthreads(); }
}

constexpr int WDT_PITCH = 2064;
__device__ __forceinline__ void norm16(Frame& F, const float* xrows, int grow0, int batch, LAS unsigned char* wdt, int nrows  ) {
    const float* mod = (const float*)(F.ws + WS_MOD) + (size_t)batch * NMOD; bf16* H = (bf16*)(F.ws + WS_H); float* DT = (float*)(F.ws + WS_DT);
    const int lane = F.lane, l15 = lane & 15, l4 = lane >> 4;
    LAS unsigned char* stage = wdt + 16 * WDT_PITCH + F.wave * (4 * WDT_PITCH);
    const float dtb = F.in[IN_DTB][l15];
    f32x4 a1[4], s1[4];
#pragma unroll
    for (int j = 0; j < 4; ++j) { const f32x4 w = *(const f32x4*)(F.in[IN_NW1] + 256 * j + 4 * lane), sc = *(const f32x4*)(mod + DM + 256 * j + 4 * lane); a1[j] = w * (sc + 1.0f); s1[j] = *(const f32x4*)(mod + 256 * j + 4 * lane); }
    f32x4 nx[4][4];
#pragma unroll
    for (int q = 0; q < 4; ++q) { const GAS f32x4* xr = (const GAS f32x4*)(xrows + (size_t)q * DM) + lane;
#pragma unroll
        for (int j = 0; j < 4; ++j) nx[q][j] = __builtin_nontemporal_load(xr + 64 * j); }
    for (int r0 = 0; r0 < nrows; r0 += 4) {
        f32x4 v[4][4];
#pragma unroll
        for (int q = 0; q < 4; ++q)
#pragma unroll
            for (int j = 0; j < 4; ++j) v[q][j] = nx[q][j];
        if (r0 + 4 < nrows) {
#pragma unroll
            for (int q = 0; q < 4; ++q) { const GAS f32x4* xr = (const GAS f32x4*)(xrows + (size_t)(r0 + 4 + q) * DM) + lane;
#pragma unroll
                for (int j = 0; j < 4; ++j) nx[q][j] = __builtin_nontemporal_load(xr + 64 * j); } }
        __builtin_amdgcn_sched_barrier(0);
        float ss[4];
#pragma unroll
        for (int q = 0; q < 4; ++q) { ss[q] = 0.f;
#pragma unroll
            for (int j = 0; j < 4; ++j) ss[q] += (v[q][j].x * v[q][j].x + v[q][j].y * v[q][j].y) + (v[q][j].z * v[q][j].z + v[q][j].w * v[q][j].w); }
#pragma unroll
        for (int o = 1; o < 64; o <<= 1) {
#pragma unroll
            for (int q = 0; q < 4; ++q) ss[q] += __shfl_xor(ss[q], o); }
#pragma unroll
        for (int q = 0; q < 4; ++q) { const float rs = 1.0f / sqrtf(ss[q] * (1.f / DM) + EPS);
            GAS unsigned long long* o8 = (GAS unsigned long long*)(H + (size_t)(grow0 + r0 + q) * DM) + lane;
#pragma unroll
            for (int j = 0; j < 4; ++j) { const f32x4 hv = v[q][j] * rs * a1[j] + s1[j]; const unsigned long long pk = (unsigned long long)pk2(hv.x, hv.y) | ((unsigned long long)pk2(hv.z, hv.w) << 32);
                o8[64 * j] = pk; *(LAS unsigned long long*)(stage + q * WDT_PITCH + 512 * j + 8 * lane) = pk; } }
        { f32x4 acc0 = (f32x4){0.f, 0.f, 0.f, 0.f}, acc1 = acc0;
          const LAS unsigned char* arow = stage + (l15 & 3) * WDT_PITCH + 16 * l4; const LAS unsigned char* brow = wdt + l15 * WDT_PITCH + 16 * l4;
#pragma unroll 8
          for (int ks = 0; ks < 32; ks += 2) { acc0 = MFMA16(*(const LAS bf16x8*)(arow + 64 * ks), *(const LAS bf16x8*)(brow + 64 * ks), acc0); acc1 = MFMA16(*(const LAS bf16x8*)(arow + 64 * ks + 64), *(const LAS bf16x8*)(brow + 64 * ks + 64), acc1); }
          if (l4 == 0) {
#pragma unroll
              for (int r = 0; r < 4; ++r) { const float raw = acc0[r] + acc1[r] + dtb; DT[(size_t)(grow0 + r0 + r) * 16 + l15] = fmaxf(raw, 0.f) + log1pf(expf(-fabsf(raw))); } } }
    }
}
__device__ __forceinline__ void p_norm(Frame& F) {
    LAS unsigned char* wdt = F.lds + RING_OFF;
    for (int k = F.tid; k < DM; k += NWAVES * 64) { const f32x4* src = (const f32x4*)(F.in[IN_WIN] + (size_t)k * LDWIN + NPROJ);
#pragma unroll
        for (int q = 0; q < 4; ++q) { const f32x4 w = src[q];
            *(LAS unsigned short*)(wdt + (4 * q + 0) * WDT_PITCH + 2 * k) = (unsigned short)f2bf(w.x); *(LAS unsigned short*)(wdt + (4 * q + 1) * WDT_PITCH + 2 * k) = (unsigned short)f2bf(w.y);
            *(LAS unsigned short*)(wdt + (4 * q + 2) * WDT_PITCH + 2 * k) = (unsigned short)f2bf(w.z); *(LAS unsigned short*)(wdt + (4 * q + 3) * WDT_PITCH + 2 * k) = (unsigned short)f2bf(w.w); } }
    __syncthreads();
    if (blockIdx.x < NBT) { const int b = blockIdx.x; const float* md = (const float*)(F.ws + WS_MOD) + (size_t)b * NMOD; float* A2 = (float*)(F.ws + WS_A2) + (size_t)b * DM;
        for (int c = F.tid; c < DM; c += NWAVES * 64) A2[c] = F.in[IN_NW2][c] * (1.0f + md[4 * DM + c]); }
    const int gw = F.vcu * NWAVES + F.wave;
    for (int w = gw; w < MP / 32; w += F.G * NWAVES) { norm16(F, F.in[IN_XP] + (size_t)w * 32 * DM, w * 32, w >> 7, wdt, 16); norm16(F, F.in[IN_XP] + (size_t)(w * 32 + 16) * DM, w * 32 + 16, w >> 7, wdt, 16); }
    for (int s = gw; s < MS / 4; s += F.G * NWAVES) norm16(F, F.in[IN_XS] + (size_t)s * 4 * DM, MP + s * 4, NB_P + (s >> 2), wdt, 4);
}

template <int W, int NTOK>
__device__ __forceinline__ void pool_item(const bf16* PROJ, bf16* MIX, int row0, bool seq_start, const float* hist  , int c0) {
    v2u praw[W - 1], craw[NTOK]; f32x4 ph[W - 1];
    if (hist) {
#pragma unroll
        for (int i = 0; i < W - 1; ++i) ph[i] = *(const f32x4*)(hist + (size_t)(15 - (W - 1) + i) * DM + c0);
    } else if (!seq_start) {
#pragma unroll
        for (int i = 0; i < W - 1; ++i) praw[i] = *(const v2u*)(PROJ + (size_t)(row0 - (W - 1) + i) * NPROJ + c0);
    }
#pragma unroll
    for (int j = 0; j < NTOK; ++j) craw[j] = __builtin_nontemporal_load((const v2u*)(PROJ + (size_t)(row0 + j) * NPROJ + c0));
    if (!hist) {
#pragma unroll
        for (int i = 0; i < W - 1; ++i) ph[i] = seq_start ? (f32x4){0.f, 0.f, 0.f, 0.f} : (f32x4){bflo(praw[i].x), bfhi(praw[i].x), bflo(praw[i].y), bfhi(praw[i].y)};
    }
    f32x4 s = (f32x4){0.f, 0.f, 0.f, 0.f};
#pragma unroll
    for (int i = 0; i < W - 1; ++i) s += ph[i];
#pragma unroll
    for (int j = 0; j < NTOK; ++j) {
        const f32x4 x = (f32x4){bflo(craw[j].x), bfhi(craw[j].x), bflo(craw[j].y), bfhi(craw[j].y)};
        s += x;
        const float inv = (seq_start && j + 1 < W) ? 1.0f / (float)(j + 1) : 1.0f / (float)W;
        const f32x4 o = s * inv - x;
        v2u ow; ow.x = pk2(o.x, o.y); ow.y = pk2(o.z, o.w);
        *(v2u*)(MIX + (size_t)(row0 + j) * MIXW + 1024 + c0) = ow;
        const int idx = j - (W - 1);
        if (idx < 0) s -= ph[(W - 1) + idx]; else s -= (f32x4){bflo(craw[idx].x), bfhi(craw[idx].x), bflo(craw[idx].y), bfhi(craw[idx].y)};
    }
}
template <int W>
__device__ __forceinline__ void pool_group(Frame& F, const bf16* PROJ, bf16* MIX, int blk, int c0) {
    if (blk < MP / 32) { const int row0 = blk * 32; pool_item<W, 32>(PROJ, MIX, row0, (row0 & (SEQ - 1)) == 0, nullptr, c0); }
    else { const int sb = blk - MP / 32; pool_item<W, DSEQ>(PROJ, MIX, MP + sb * DSEQ, false, F.in[IN_CPOOL] + (size_t)sb * 15 * DM, c0); }
}
__device__ __forceinline__ void p3_pool(Frame& F) {
    const bf16* PROJ = (const bf16*)(F.ws + WS_PROJ); bf16* MIX = (bf16*)(F.ws + WS_MIX);
    const int gw = F.vcu * NWAVES + F.wave, NGW = F.G * NWAVES;
#if EPI_POOL
    { const int g = F.vcu & 3, cntg = (F.G - g + 3) >> 2, widx = (F.vcu >> 2) * NWAVES + F.wave, stride = cntg * NWAVES, hb = F.lane >> 5, c8 = g * 256 + 8 * (F.lane & 31);
      auto items = [&](auto wc) __attribute__((always_inline)) { constexpr int W = decltype(wc)::value; constexpr int N = W - 1; constexpr float INVW = 1.0f / (float)W;
          for (int p0 = widx; p0 < MP / 128; p0 += stride) { const int blk = p0 + (MP / 128) * hb, row0 = blk * 64; const bool ss = (p0 & (SEQ / 64 - 1)) == 0;
              v4u h[N], c[N];
#pragma unroll
              for (int i = 0; i < N; ++i) { h[i] = (v4u){0u, 0u, 0u, 0u}; if (!ss) h[i] = *(const v4u*)(PROJ + (size_t)(row0 - N + i) * NPROJ + c8); c[i] = *(const v4u*)(PROJ + (size_t)(row0 + i) * NPROJ + c8); }
              f32x4 s0 = (f32x4){0.f, 0.f, 0.f, 0.f}, s1 = s0;
#pragma unroll
              for (int i = 0; i < N; ++i) { s0 += (f32x4){bflo(h[i].x), bfhi(h[i].x), bflo(h[i].y), bfhi(h[i].y)}; s1 += (f32x4){bflo(h[i].z), bfhi(h[i].z), bflo(h[i].w), bfhi(h[i].w)}; }
#pragma unroll
              for (int j = 0; j < N; ++j) { const f32x4 x0 = (f32x4){bflo(c[j].x), bfhi(c[j].x), bflo(c[j].y), bfhi(c[j].y)}, x1 = (f32x4){bflo(c[j].z), bfhi(c[j].z), bflo(c[j].w), bfhi(c[j].w)}; s0 += x0; s1 += x1;
                  const float inv = ss ? 1.0f / (float)(j + 1) : INVW; const f32x4 o0 = s0 * inv - x0, o1 = s1 * inv - x1;
                  v4u ow; ow.x = pk2(o0.x, o0.y); ow.y = pk2(o0.z, o0.w); ow.z = pk2(o1.x, o1.y); ow.w = pk2(o1.z, o1.w); *(v4u*)(MIX + (size_t)(row0 + j) * MIXW + 1024 + c8) = ow;
                  s0 -= (f32x4){bflo(h[j].x), bfhi(h[j].x), bflo(h[j].y), bfhi(h[j].y)}; s1 -= (f32x4){bflo(h[j].z), bfhi(h[j].z), bflo(h[j].w), bfhi(h[j].w)}; } }
          const int c0 = g * 256 + 4 * F.lane;
          for (int t = stride - 1 - widx; t < NB_S; t += stride) pool_group<W>(F, PROJ, MIX, MP / 32 + t, c0); };
      if (g == 0) items(std::integral_constant<int, 2>{}); else if (g == 1) items(std::integral_constant<int, 4>{}); else if (g == 2) items(std::integral_constant<int, 8>{}); else items(std::integral_constant<int, 16>{}); }
#else
    constexpr int NQ = (MP / 32 + NB_S) * 4;
    for (int q = gw; q < NQ; q += NGW) {
        int blk, g; if (q < NB_S * 4) { blk = MP / 32 + (q >> 2); g = q & 3; } else { const int qq = q - NB_S * 4; blk = qq >> 2; g = qq & 3; }
        const int c0 = g * 256 + 4 * F.lane;
        if (g == 0) pool_group<2>(F, PROJ, MIX, blk, c0); else if (g == 1) pool_group<4>(F, PROJ, MIX, blk, c0); else if (g == 2) pool_group<8>(F, PROJ, MIX, blk, c0); else pool_group<16>(F, PROJ, MIX, blk, c0);
    }
#endif
}
__device__ __forceinline__ void conv_load8(const bf16* src, v4u (&raw)[8]) {
#pragma unroll
    for (int j = 0; j < 8; ++j) raw[j] = __builtin_nontemporal_load((const v4u*)(src + (size_t)j * NPROJ));
}
__device__ __forceinline__ void conv_rows8(const v4u (&raw)[8], bf16* dst, const f32x4 (&wv)[4][2], const f32x4 (&bv)[2], f32x4 (&h)[3][2]) {
#pragma unroll
    for (int j = 0; j < 8; ++j) {
        const f32x4 x0 = (f32x4){bflo(raw[j].x), bfhi(raw[j].x), bflo(raw[j].y), bfhi(raw[j].y)}, x1 = (f32x4){bflo(raw[j].z), bfhi(raw[j].z), bflo(raw[j].w), bfhi(raw[j].w)};
        const f32x4 o0 = bv[0] + wv[0][0] * h[0][0] + wv[1][0] * h[1][0] + wv[2][0] * h[2][0] + wv[3][0] * x0;
        const f32x4 o1 = bv[1] + wv[0][1] * h[0][1] + wv[1][1] * h[1][1] + wv[2][1] * h[2][1] + wv[3][1] * x1;
        v4u ow; ow.x = pk2(silu_fast(o0.x), silu_fast(o0.y)); ow.y = pk2(silu_fast(o0.z), silu_fast(o0.w)); ow.z = pk2(silu_fast(o1.x), silu_fast(o1.y)); ow.w = pk2(silu_fast(o1.z), silu_fast(o1.w));
        *(v4u*)(dst + (size_t)j * CONVD) = ow;
        h[0][0] = h[1][0]; h[0][1] = h[1][1]; h[1][0] = h[2][0]; h[1][1] = h[2][1]; h[2][0] = x0; h[2][1] = x1;
    }
}
__device__ __forceinline__ void p3_conv(Frame& F) {
    const bf16* PROJ = (const bf16*)(F.ws + WS_PROJ); bf16* XB = (bf16*)(F.out + O_Y);
    const float* cw = F.in[IN_CONVW]; const float* cb = F.in[IN_CONVB];
    const int gw = F.vcu * NWAVES + F.wave, NGW = F.G * NWAVES;
#if EPI_CONV
    { const int strip = gw % 3, rank = gw / 3, cnt = (NGW - strip + 2) / 3, c0 = strip * 512 + 8 * F.lane;
      f32x4 wv[4][2], bv[2];
#pragma unroll
      for (int k = 0; k < 4; ++k) { wv[k][0] = *(const f32x4*)(cw + k * CONVD + c0); wv[k][1] = *(const f32x4*)(cw + k * CONVD + c0 + 4); }
      bv[0] = *(const f32x4*)(cb + c0); bv[1] = *(const f32x4*)(cb + c0 + 4);
      auto loadrows = [&](int blk, v4u (&raw)[6]) __attribute__((always_inline)) { const int row0 = blk * 64; const bool zh = (row0 & (SEQ - 1)) == 0;
#pragma unroll
          for (int i = 0; i < 6; ++i) { raw[i] = (v4u){0u, 0u, 0u, 0u}; if (!(i < 3 && zh)) raw[i] = *(const v4u*)(PROJ + (size_t)(row0 - 3 + i) * NPROJ + 2048 + c0); } };
      auto emit = [&](int blk, const v4u (&raw)[6]) __attribute__((always_inline)) { const int row0 = blk * 64; f32x4 h[6][2];
#pragma unroll
          for (int i = 0; i < 6; ++i) { h[i][0] = (f32x4){bflo(raw[i].x), bfhi(raw[i].x), bflo(raw[i].y), bfhi(raw[i].y)}; h[i][1] = (f32x4){bflo(raw[i].z), bfhi(raw[i].z), bflo(raw[i].w), bfhi(raw[i].w)}; }
#pragma unroll
          for (int j = 0; j < 3; ++j) {
              const f32x4 o0 = bv[0] + wv[0][0] * h[j][0] + wv[1][0] * h[j + 1][0] + wv[2][0] * h[j + 2][0] + wv[3][0] * h[j + 3][0];
              const f32x4 o1 = bv[1] + wv[0][1] * h[j][1] + wv[1][1] * h[j + 1][1] + wv[2][1] * h[j + 2][1] + wv[3][1] * h[j + 3][1];
              v4u ow; ow.x = pk2(silu_fast(o0.x), silu_fast(o0.y)); ow.y = pk2(silu_fast(o0.z), silu_fast(o0.w)); ow.z = pk2(silu_fast(o1.x), silu_fast(o1.y)); ow.w = pk2(silu_fast(o1.z), silu_fast(o1.w));
              *(v4u*)(XB + (size_t)(row0 + j) * CONVD + c0) = ow; } };
      for (int b0 = rank; b0 < MP / 64; b0 += 2 * cnt) { const int b1 = b0 + cnt; const bool two = b1 < MP / 64;
          v4u ra[6], rb[6]; loadrows(b0, ra); if (two) loadrows(b1, rb);
          emit(b0, ra); if (two) emit(b1, rb); }
    }
    constexpr int NQ_S = NB_S * 2 * 3, NQ = NQ_S;
#else
    constexpr int NQ_S = NB_S * 2 * 3, NQ = NQ_S + (MP / 32) * 3;
#endif
    for (int q = (EPI_CONV ? NGW - 1 - gw : gw); q < NQ; q += NGW) {
        int row0, nb8, strip; bool zero_hist = false; const float* hist = nullptr;
        if (q < NQ_S) { const int sh = q / 3; strip = q - sh * 3; const int sb = sh >> 1, half = sh & 1; row0 = MP + sb * DSEQ + 8 * half; nb8 = 1; if (!half) hist = F.in[IN_CCONV] + (size_t)sb * 3 * CONVD; }
        else { const int qq = q - NQ_S, blk = qq / 3; strip = qq - blk * 3; row0 = blk * 32; nb8 = 4; zero_hist = (row0 & (SEQ - 1)) == 0; }
        const int c0 = strip * 512 + 8 * F.lane;
        f32x4 wv[4][2], bv[2], h[3][2];
#pragma unroll
        for (int k = 0; k < 4; ++k) { wv[k][0] = *(const f32x4*)(cw + k * CONVD + c0); wv[k][1] = *(const f32x4*)(cw + k * CONVD + c0 + 4); }
        bv[0] = *(const f32x4*)(cb + c0); bv[1] = *(const f32x4*)(cb + c0 + 4);
#pragma unroll
        for (int i = 0; i < 3; ++i) {
            if (hist) { h[i][0] = *(const f32x4*)(hist + (size_t)i * CONVD + c0); h[i][1] = *(const f32x4*)(hist + (size_t)i * CONVD + c0 + 4); }
            else if (zero_hist) { h[i][0] = (f32x4){0.f, 0.f, 0.f, 0.f}; h[i][1] = h[i][0]; }
            else { const v4u r = *(const v4u*)(PROJ + (size_t)(row0 - 3 + i) * NPROJ + 2048 + c0); h[i][0] = (f32x4){bflo(r.x), bfhi(r.x), bflo(r.y), bfhi(r.y)}; h[i][1] = (f32x4){bflo(r.z), bfhi(r.z), bflo(r.w), bfhi(r.w)}; } }
        v4u rawA[8], rawB[8];
        conv_load8(PROJ + (size_t)row0 * NPROJ + 2048 + c0, rawA);
        for (int b8 = 0; b8 < nb8; b8 += 2) {
            if (b8 + 1 < nb8) conv_load8(PROJ + (size_t)(row0 + 8 * (b8 + 1)) * NPROJ + 2048 + c0, rawB);
            __builtin_amdgcn_sched_barrier(0);
            conv_rows8(rawA, XB + (size_t)(row0 + 8 * b8) * CONVD + c0, wv, bv, h);
            if (b8 + 1 < nb8) {
                if (b8 + 2 < nb8) conv_load8(PROJ + (size_t)(row0 + 8 * (b8 + 2)) * NPROJ + 2048 + c0, rawA);
                __builtin_amdgcn_sched_barrier(0);
                conv_rows8(rawB, XB + (size_t)(row0 + 8 * (b8 + 1)) * CONVD + c0, wv, bv, h); }
        }
    }
}

__device__ __forceinline__ void p4_ssd(Frame& F) {
    const bf16* XB = (const bf16*)(F.out + O_Y); const bf16* PROJ = (const bf16*)(F.ws + WS_PROJ); bf16* MIX = (bf16*)(F.ws + WS_MIX);
    const float* DT = (const float*)(F.ws + WS_DT); float* SSQ = (float*)(F.ws + WS_SSQ);
    LAS unsigned char* Bs = F.lds + RING_OFF; LAS unsigned char* Cs = Bs + 16384; LAS unsigned char* Hs = Bs + 32768; LAS unsigned char* Xs0 = Bs + 49152; LAS unsigned char* Xd = Bs + 65536; LAS unsigned char* Ms = Bs + 81920;
    LAS unsigned char* Xs1 = Bs + 98304;
    LAS float* Ys = (LAS float*)(Bs + 114688);
    const int tid = F.tid, lane = F.lane, w = F.wave, l15 = lane & 15, l4 = lane >> 4;
    const int xj = tid >> 3, xch = tid & 7;
    LAS float* tabw = (LAS float*)(F.lds + LDSX_OFF) + w * 384;
    const int itile = w >> 1, pq0 = 2 * (w & 1);
    for (int it = blockIdx.x; it < NB_P * NH + NB_S * NH; it += F.G) {
        int rowbase, L, h; float* sout; f32x4 st[4];
        if (it < NB_P * NH) { const int b = it >> 4; h = it & 15; rowbase = b * SEQ; L = SEQ; sout = F.out + O_SP + (size_t)it * HD * NST;
#pragma unroll
            for (int pt = 0; pt < 4; ++pt) st[pt] = (f32x4){0.f, 0.f, 0.f, 0.f}; }
        else { const int s = it - NB_P * NH, sb = s >> 4; h = s & 15; rowbase = MP + sb * DSEQ; L = DSEQ; sout = F.out + O_SS + (size_t)s * HD * NST;
            const float* sin = F.in[IN_SSM] + (size_t)s * HD * NST;
#pragma unroll
            for (int pt = 0; pt < 4; ++pt) st[pt] = *(const f32x4*)(sin + (size_t)(16 * pt + l15) * NST + 16 * w + 4 * l4); }
        const int g = h >> 3; const float Ah = -expf(F.in[IN_ALOG][h]) * 1.4426950408889634f, Dh = F.in[IN_DSKIP][h];
        const int nch = (L + 63) >> 6;
        v4u xw, bw[2], cw[2]; float dtr = 0.f;
        { const int nt0 = L < 64 ? L : 64;
          xw = (v4u){0u, 0u, 0u, 0u}; if (xj < nt0) xw = *(const v4u*)(XB + (size_t)(rowbase + xj) * CONVD + h * HD + 8 * xch);
#pragma unroll
          for (int rep = 0; rep < 2; ++rep) { const int tt = (tid >> 4) + 32 * rep; bw[rep] = (v4u){0u, 0u, 0u, 0u}; cw[rep] = (v4u){0u, 0u, 0u, 0u};
              if (tt < nt0) { const bf16* rp = XB + (size_t)(rowbase + tt) * CONVD + 1024 + g * NST + 8 * (tid & 15); bw[rep] = *(const v4u*)rp; cw[rep] = *(const v4u*)(rp + 256); } }
          if (lane < nt0) dtr = DT[(size_t)(rowbase + lane) * 16 + h]; }
        f32x4 yo0p = (f32x4){0.f, 0.f, 0.f, 0.f}, yo1p = yo0p; v4u zwp = (v4u){0u, 0u, 0u, 0u}; f32x2v xkp[4] = {(f32x2v){0.f, 0.f}, (f32x2v){0.f, 0.f}, (f32x2v){0.f, 0.f}, (f32x2v){0.f, 0.f}}; int rowp = 0, ntp = 0;
        auto body = [&](int ci, auto curc, auto prevc) __attribute__((always_inline)) {
            constexpr bool cur = decltype(curc)::value, prev = decltype(prevc)::value;
            const int t0 = ci * 64; const int nt = cur ? ((L - t0) < 64 ? (L - t0) : 64) : 0;
            float acs = 0.f, acs63 = 0.f; v4u zw = (v4u){0u, 0u, 0u, 0u}; f32x2v xkeep[4] = {(f32x2v){0.f, 0.f}, (f32x2v){0.f, 0.f}, (f32x2v){0.f, 0.f}, (f32x2v){0.f, 0.f}}; f32x4 yo0 = (f32x4){0.f, 0.f, 0.f, 0.f}, yo1 = yo0;
            if constexpr (cur) {
                LAS unsigned char* Xs = (ci & 1) ? Xs1 : Xs0;
                const float dtl = (lane < nt) ? dtr : 0.f;
                acs = wave_scan_incl(dtl * Ah);
                acs63 = __shfl(acs, 63);
                LAS float* tab = tabw + (ci & 1) * 192;
                tab[lane] = acs; tab[64 + lane] = dtl; tab[128 + lane] = ex2(acs);
#pragma unroll
                for (int pt = 0; pt < 4; ++pt) { v2u o; o.x = pk2(st[pt].x, st[pt].y); o.y = pk2(st[pt].z, st[pt].w);
                    *(LAS v2u*)(Hs + offr((unsigned)(16 * pt + l15), (unsigned)(2 * w + (lane >> 5))) + 8u * (l4 & 1)) = o; }
#pragma unroll
                for (int rep = 0; rep < 2; ++rep) { const unsigned tt = (unsigned)(tid >> 4) + 32u * rep, ch = (unsigned)tid & 15u;
                    *(LAS v4u*)(Bs + offb(tt, ch)) = bw[rep]; *(LAS v4u*)(Cs + offr(tt, ch)) = cw[rep]; }
                { const float d = tab[64 + xj], dec = ex2(acs63 - tab[xj]);
                  const f32x2v d2 = (f32x2v){d, d}, dd2 = (f32x2v){d * dec, d * dec};
                  const f32x2v X0 = (f32x2v){bflo(xw.x), bfhi(xw.x)}, X1 = (f32x2v){bflo(xw.y), bfhi(xw.y)}, X2 = (f32x2v){bflo(xw.z), bfhi(xw.z)}, X3 = (f32x2v){bflo(xw.w), bfhi(xw.w)};
                  xkeep[0] = X0; xkeep[1] = X1; xkeep[2] = X2; xkeep[3] = X3;
                  const f32x2v A0 = X0 * d2, A1 = X1 * d2, A2_ = X2 * d2, A3 = X3 * d2, B0 = X0 * dd2, B1 = X1 * dd2, B2 = X2 * dd2, B3 = X3 * dd2;
                  v4u a; a.x = pk2(A0.x, A0.y); a.y = pk2(A1.x, A1.y); a.z = pk2(A2_.x, A2_.y); a.w = pk2(A3.x, A3.y);
                  v4u b; b.x = pk2(B0.x, B0.y); b.y = pk2(B1.x, B1.y); b.z = pk2(B2.x, B2.y); b.w = pk2(B3.x, B3.y);
                  *(LAS v4u*)(Xs + offb((unsigned)xj, (unsigned)xch)) = a; *(LAS v4u*)(Xd + offb((unsigned)xj, (unsigned)xch)) = b; }
                if (xj < nt) zw = *(const v4u*)(PROJ + (size_t)(rowbase + t0 + xj) * NPROJ + 1024 + h * HD + 8 * xch);
                if (t0 + 64 < L) { const int r1 = rowbase + t0 + 64;
                    xw = *(const v4u*)(XB + (size_t)(r1 + xj) * CONVD + h * HD + 8 * xch);
#pragma unroll
                    for (int rep = 0; rep < 2; ++rep) { const int tt = (tid >> 4) + 32 * rep; const bf16* rp = XB + (size_t)(r1 + tt) * CONVD + 1024 + g * NST + 8 * (tid & 15); bw[rep] = *(const v4u*)rp; cw[rep] = *(const v4u*)(rp + 256); }
                    dtr = DT[(size_t)(r1 + lane) * 16 + h]; }
            }
            if constexpr (prev) {
                LAS unsigned char* Xsp = ((ci - 1) & 1) ? Xs1 : Xs0;
                f32x4 yd0 = (f32x4){0.f, 0.f, 0.f, 0.f}, yd1 = yd0;
#pragma unroll
                for (int ks = 0; ks < 2; ++ks) { const bf16x8 aM = frag_rowr(Ms, lane, itile, ks), b0 = frag_tr(Xsp, lane, pq0, ks), b1 = frag_tr(Xsp, lane, pq0 + 1, ks);
                    yd0 = MFMA16(b0, aM, yd0); yd1 = MFMA16(b1, aM, yd1); }
                const int irow = 16 * itile + l15; const float e1 = tabw[((ci - 1) & 1) * 192 + 128 + irow];
                const f32x4 y0v = yd0 + e1 * yo0p, y1v = yd1 + e1 * yo1p;
                *(LAS f32x4*)(Ys + irow * 64 + ((16 * pq0 + 4 * l4 + 4 * l15) & 63)) = y0v; *(LAS f32x4*)(Ys + irow * 64 + ((16 * (pq0 + 1) + 4 * l4 + 4 * l15) & 63)) = y1v;
            }
            __syncthreads();
            if constexpr (cur) {
                f32x4 g0 = (f32x4){0.f, 0.f, 0.f, 0.f}, g1 = g0;
#pragma unroll
                for (int ks = 0; ks < 4; ++ks) { const bf16x8 bC = frag_rowr(Cs, lane, itile, ks), a0 = frag_row(Bs, lane, pq0, ks), a1 = frag_row(Bs, lane, pq0 + 1, ks);
                    const bf16x8 h0 = frag_rowr(Hs, lane, pq0, ks), h1 = frag_rowr(Hs, lane, pq0 + 1, ks);
                    g0 = MFMA16(a0, bC, g0); g1 = MFMA16(a1, bC, g1); yo0 = MFMA16(h0, bC, yo0); yo1 = MFMA16(h1, bC, yo1); }
                const float cd = ex2(acs63);
#pragma unroll
                for (int pt = 0; pt < 4; ++pt) st[pt] = st[pt] * cd;
#pragma unroll
                for (int ks = 0; ks < 2; ++ks) { const bf16x8 aB = frag_tr(Bs, lane, w, ks);
#pragma unroll
                    for (int pt = 0; pt < 4; ++pt) { const bf16x8 bX = frag_tr(Xd, lane, pt, ks); st[pt] = MFMA16(aB, bX, st[pt]); } }
                const LAS float* tabc = tabw + (ci & 1) * 192;
                const int i = 16 * itile + l15; const float ai = tabc[i];
#pragma unroll
                for (int jj = 0; jj < 2; ++jj) { const int j0 = 16 * (pq0 + jj) + 4 * l4; const f32x4 gv = jj ? g1 : g0; const f32x4 ajv = *(const LAS f32x4*)(tabc + j0);
                    float m[4];
                    const f32x4 dl = (f32x4){ai, ai, ai, ai} - ajv; const f32x4 mm = gv * (f32x4){ex2(dl.x), ex2(dl.y), ex2(dl.z), ex2(dl.w)};
#pragma unroll
                    for (int r = 0; r < 4; ++r) { m[r] = (j0 + r <= i) ? mm[r] : 0.f; }
                    v2u o; o.x = pk2(m[0], m[1]); o.y = pk2(m[2], m[3]);
                    *(LAS v2u*)(Ms + offr((unsigned)i, (unsigned)(2 * (pq0 + jj) + (lane >> 5))) + 8u * (l4 & 1)) = o; }
            }
            if constexpr (prev) {
                if (xj < ntp) { const size_t row = (size_t)(rowp + xj); const int rot = 4 * (xj & 15);
                    const f32x4 y0 = *(const LAS f32x4*)(Ys + xj * 64 + ((8 * xch + rot) & 63)), y1 = *(const LAS f32x4*)(Ys + xj * 64 + ((8 * xch + 4 + rot) & 63));
                    const unsigned zr[4] = {zwp.x, zwp.y, zwp.z, zwp.w};
                    const f32x2v yv[4] = {(f32x2v){y0.x, y0.y}, (f32x2v){y0.z, y0.w}, (f32x2v){y1.x, y1.y}, (f32x2v){y1.z, y1.w}};
                    f32x2v ss2 = (f32x2v){0.f, 0.f}; unsigned opk[4];
#pragma unroll
                    for (int i = 0; i < 4; ++i) { const f32x2v X = xkp[i], Z = (f32x2v){bflo(zr[i]), bfhi(zr[i])};
                        const f32x2v t = Z * (f32x2v){-1.4426950408889634f, -1.4426950408889634f};
                        const f32x2v dn = (f32x2v){__builtin_amdgcn_exp2f(t.x), __builtin_amdgcn_exp2f(t.y)} + (f32x2v){1.f, 1.f};
                        const f32x2v sz = Z * (f32x2v){__builtin_amdgcn_rcpf(dn.x), __builtin_amdgcn_rcpf(dn.y)};
                        const f32x2v o2 = (X * (f32x2v){Dh, Dh} + yv[i]) * sz;
                        ss2 += o2 * o2; opk[i] = pk2(o2.x, o2.y); }
                    float ss = ss2.x + ss2.y;
                    ss += __shfl_xor(ss, 1); ss += __shfl_xor(ss, 2); ss += __shfl_xor(ss, 4);
                    if (xch == 0) SSQ[row * 16 + h] = ss;
                    v4u ow; ow.x = opk[0]; ow.y = opk[1]; ow.z = opk[2]; ow.w = opk[3];
                    *(v4u*)(MIX + row * MIXW + h * HD + 8 * xch) = ow; }
            }
            __syncthreads();
            yo0p = yo0; yo1p = yo1; zwp = zw; xkp[0] = xkeep[0]; xkp[1] = xkeep[1]; xkp[2] = xkeep[2]; xkp[3] = xkeep[3]; rowp = rowbase + t0; ntp = nt;
        };
        body(0, std::true_type{}, std::false_type{});
        for (int ci = 1; ci < nch; ++ci) body(ci, std::true_type{}, std::true_type{});
        body(nch, std::false_type{}, std::true_type{});
#pragma unroll
        for (int pt = 0; pt < 4; ++pt) *(f32x4*)(sout + (size_t)(16 * pt + l15) * NST + 16 * w + 4 * l4) = st[pt];
    }
}
__device__ __forceinline__ void p4b_gnorm(Frame& F) {
    bf16* MIX = (bf16*)(F.ws + WS_MIX); const float* SSQ = (const float*)(F.ws + WS_SSQ);
    const int gw = F.vcu * NWAVES + F.wave, NGW = F.G * NWAVES, lane = F.lane;
    for (int row = gw; row < MT; row += NGW) {
        float s = SSQ[(size_t)row * 16 + (lane & 15)];
        s += __shfl_xor(s, 1); s += __shfl_xor(s, 2); s += __shfl_xor(s, 4);
        const float sg = __shfl(s, (lane >> 5) * 8);
        const float rs = 1.0f / sqrtf(sg * (1.f / 512.f) + EPS);
        v4u* p = (v4u*)(MIX + (size_t)row * MIXW + 16 * lane);
#pragma unroll
        for (int q = 0; q < 2; ++q) { v4u w = p[q];
            w.x = pk2(bflo(w.x) * rs, bfhi(w.x) * rs); w.y = pk2(bflo(w.y) * rs, bfhi(w.y) * rs); w.z = pk2(bflo(w.z) * rs, bfhi(w.z) * rs); w.w = pk2(bflo(w.w) * rs, bfhi(w.w) * rs);
            p[q] = w; }
    }
}
__device__ __forceinline__ void p9_final(Frame& F) {
    const float* fw = F.in[IN_FNW]; const int gw = F.vcu * NWAVES + F.wave, NGW = F.G * NWAVES, lane = F.lane;
    f32x4 w[4];
#pragma unroll
    for (int j = 0; j < 4; ++j) w[j] = *(const f32x4*)(fw + 256 * j + 4 * lane);
    for (int row = gw; row < MT; row += NGW) {
        GAS f32x4* xr = (GAS f32x4*)(F.out + O_Y + (size_t)row * DM) + lane;
        f32x4 v[4]; float ss = 0.f;
#pragma unroll
        for (int j = 0; j < 4; ++j) { v[j] = xr[64 * j]; ss += (v[j].x * v[j].x + v[j].y * v[j].y) + (v[j].z * v[j].z + v[j].w * v[j].w); }
        const float rs = 1.0f / sqrtf(wave_sum(ss) * (1.f / DM) + EPS);
#pragma unroll
        for (int j = 0; j < 4; ++j) xr[64 * j] = v[j] * rs * w[j];
    }
}

struct Thin4 { f32x4 a[4]; };
template <int NC, bool HOOK>
__device__ __forceinline__ Thin4 thin_tile(Frame& F, const bf16* A, int lda, const bf16* Bt, int ldb, int K, f32x4 fA, f32x4 fB) {
    constexpr int NB = NC / 32;
    const int tid = F.tid, lane = F.lane, w = F.wave;
    LAS unsigned char* base = F.lds + RING_OFF;
    Thin4 r;
#pragma unroll
    for (int i = 0; i < 4; ++i) r.a[i] = (f32x4){0.f, 0.f, 0.f, 0.f};
    v4u ra[2][2], rbv[2][NB];
    auto loadc = [&](int set, int kc) __attribute__((always_inline)) {
#pragma unroll
        for (int i = 0; i < 2; ++i) { const int idx = tid + 512 * i; ra[set][i] = *(const v4u*)(A + (size_t)(idx >> 4) * lda + kc + (idx & 15) * 8); }
#pragma unroll
        for (int i = 0; i < NB; ++i) { const int idx = tid + 512 * i; rbv[set][i] = *(const v4u*)(Bt + (size_t)(idx >> 4) * ldb + kc + (idx & 15) * 8); } };
    int cur = 0;
    auto step = [&](int set, int kc) __attribute__((always_inline)) {
        LAS unsigned char* Ai = base + cur * 49152; LAS unsigned char* Bi = Ai + 16384;
#pragma unroll
        for (int i = 0; i < 2; ++i) { const unsigned idx = (unsigned)(tid + 512 * i); *(LAS v4u*)(Ai + offr(idx >> 4, idx & 15u)) = ra[set][i]; }
#pragma unroll
        for (int i = 0; i < NB; ++i) { const unsigned idx = (unsigned)(tid + 512 * i); *(LAS v4u*)(Bi + offr(idx >> 4, idx & 15u)) = rbv[set][i]; }
        if (kc + 256 < K) loadc(set, kc + 256);
        __syncthreads();
        if constexpr (HOOK) { if (kc == 512) r.a[0] = r.a[0] * fA; if (kc == 1024) r.a[0] = r.a[0] * fB; }
        if constexpr (NC == 128) {
#pragma unroll
            for (int s = 0; s < 4; ++s) { const bf16x8 b = frag_rowr(Bi, lane, w, s);
#pragma unroll
                for (int i = 0; i < 4; ++i) r.a[i] = MFMA16(frag_rowr(Ai, lane, i, s), b, r.a[i]); }
        } else {
#pragma unroll
            for (int s = 0; s < 4; ++s) r.a[0] = MFMA16(frag_rowr(Ai, lane, w & 3, s), frag_rowr(Bi, lane, w >> 2, s), r.a[0]);
        }
        cur ^= 1; };
    loadc(0, 0); loadc(1, 128);
    for (int kc = 0; kc < K; kc += 256) { step(0, kc); step(1, kc + 128); }
    __syncthreads();
    return r;
}
__device__ __forceinline__ void thin_proj(Frame& F) {
    const bf16* Hb = (const bf16*)(F.ws + WS_H) + (size_t)MP * DM; bf16* PROJ = (bf16*)(F.ws + WS_PROJ) + (size_t)MP * NPROJ;
    const int lane = F.lane, w = F.wave, l15 = lane & 15, l4 = lane >> 4;
    for (int q = blockIdx.x; q < 8 * (NPROJ / 128); q += F.G) { const int rb = q / (NPROJ / 128), cb = q - rb * (NPROJ / 128);
        const Thin4 t = thin_tile<128, false>(F, Hb + (size_t)(64 * rb) * DM, DM, (const bf16*)(F.ws + WS_WIN) + (size_t)(128 * cb) * DM, DM, DM, (f32x4){0.f, 0.f, 0.f, 0.f}, (f32x4){0.f, 0.f, 0.f, 0.f});
        const int c = 128 * cb + 16 * w + l15;
#pragma unroll
        for (int i = 0; i < 4; ++i) { const int sb = 4 * rb + i;
#pragma unroll
            for (int r = 0; r < 4; ++r) { const int tok = 4 * l4 + r; const float v = t.a[i][r]; PROJ[(size_t)(16 * sb + tok) * NPROJ + c] = (bf16)f2bf(v);
                if (c < 1024) { if (tok >= 1) F.out[O_PS + ((size_t)(sb * 15 + tok - 1)) * DM + c] = v; }
                else if (c >= 2048) { if (tok >= 13) F.out[O_CS + ((size_t)(sb * 3 + tok - 13)) * CONVD + (c - 2048)] = v; } } }
    }
}
__device__ __forceinline__ void thin_ff1(Frame& F) {
    const bf16* Hb = (const bf16*)(F.ws + WS_H) + (size_t)MP * DM; bf16* HM = (bf16*)(F.ws + WS_HMID) + (size_t)MP * DFF; const float* b1 = F.in[IN_B1];
    const int lane = F.lane, w = F.wave, l15 = lane & 15, l4 = lane >> 4;
    for (int q = blockIdx.x; q < 8 * (DFF / 128); q += F.G) { const int rb = q / (DFF / 128), cb = q - rb * (DFF / 128);
        const Thin4 t = thin_tile<128, false>(F, Hb + (size_t)(64 * rb) * DM, DM, (const bf16*)(F.ws + WS_W1) + (size_t)(128 * cb) * DM, DM, DM, (f32x4){0.f, 0.f, 0.f, 0.f}, (f32x4){0.f, 0.f, 0.f, 0.f});
        const int c = 128 * cb + 16 * w + l15; const float bb = b1[c];
#pragma unroll
        for (int i = 0; i < 4; ++i)
#pragma unroll
            for (int r = 0; r < 4; ++r) { const float a = fmaxf(t.a[i][r] + bb, 0.f); HM[(size_t)(64 * rb + 16 * i + 4 * l4 + r) * DFF + c] = (bf16)f2bf(a * a); }
    }
}
template <int MODE>
__device__ __forceinline__ void thin_resnorm(Frame& F) {
    const int lane = F.lane, w = F.wave, l15 = lane & 15, l4 = lane >> 4, tid = F.tid;
    const float* mod = (const float*)(F.ws + WS_MOD);
    unsigned* slots = (unsigned*)(F.ws + WS_XSL) + (size_t)4 * MT * 4 + (size_t)MODE * MS * 32;
    unsigned* cnt = (unsigned*)(F.ws + WS_CTL) + CW_SEAM + 4 * SEAM_BANK + MODE * 8 * 64;
    LAS float* P = (LAS float*)(F.lds + LDSX_OFF); LAS float* S = P + 128;
    for (int q = F.vcu; q < 8 * 32; q += F.G) { const int rb = q >> 5, cb = q & 31, rt = w & 3, ct = w >> 2, b = NB_P + 4 * rb + rt;
        f32x4 v;
        if constexpr (MODE == 0) {
            const float* ssq = (const float*)(F.ws + WS_SSQ) + (size_t)MP * 16; f32x4 fA, fB;
#pragma unroll
            for (int r = 0; r < 4; ++r) { const f32x4* p = (const f32x4*)(ssq + (size_t)(64 * rb + 16 * rt + 4 * l4 + r) * 16); const f32x4 a = p[0], bq = p[1], cq = p[2], d = p[3];
                const float s0 = ((a.x + a.y) + (a.z + a.w)) + ((bq.x + bq.y) + (bq.z + bq.w)), s1 = ((cq.x + cq.y) + (cq.z + cq.w)) + ((d.x + d.y) + (d.z + d.w));
                const float r0 = 1.0f / sqrtf(s0 * (1.f / 512.f) + EPS), r1 = 1.0f / sqrtf(s1 * (1.f / 512.f) + EPS);
                fA[r] = r0 / r1; fB[r] = r1; }
            v = thin_tile<32, true>(F, (const bf16*)(F.ws + WS_MIX) + (size_t)(MP + 64 * rb) * MIXW, MIXW, (const bf16*)(F.ws + WS_WOUT) + (size_t)(32 * cb) * MIXW, MIXW, MIXW, fA, fB).a[0];
        } else {
            v = thin_tile<32, false>(F, (const bf16*)(F.ws + WS_HMID) + (size_t)(MP + 64 * rb) * DFF, DFF, (const bf16*)(F.ws + WS_W2) + (size_t)(32 * cb) * DFF, DFF, DFF, (f32x4){0.f, 0.f, 0.f, 0.f}, (f32x4){0.f, 0.f, 0.f, 0.f}).a[0];
        }
        const float* bias = MODE == 0 ? (const float*)(F.ws + WS_BIASA) : F.in[IN_B2];
        const float* gate = mod + (size_t)b * NMOD + (MODE == 0 ? 2 * DM : 5 * DM);
        const float* base = MODE == 0 ? F.in[IN_XS] : F.out + O_Y + (size_t)MP * DM;
        const int c = 32 * cb + 16 * ct + l15; const float bb = bias[c], gg = gate[c];
#pragma unroll
        for (int r = 0; r < 4; ++r) { const float x = base[(size_t)(64 * rb + 16 * rt + 4 * l4 + r) * DM + c]; const float t = x + gg * (v[r] + bb); v[r] = t;
            float s = t * t; s += __shfl_xor(s, 1); s += __shfl_xor(s, 2); s += __shfl_xor(s, 4); s += __shfl_xor(s, 8); if (l15 == 0) P[(16 * rt + 4 * l4 + r) * 2 + ct] = s; }
        __syncthreads();
        if (tid < 64) { const float s = P[tid * 2] + P[tid * 2 + 1];
            __hip_atomic_store(slots + ((size_t)(64 * rb + tid) * 32 + cb), __float_as_uint(s), __ATOMIC_RELAXED, __HIP_MEMORY_SCOPE_AGENT);
            asm volatile("s_waitcnt vmcnt(0)" ::: "memory");
            if (lane == 0) __hip_atomic_fetch_add(cnt + 64 * rb, 1u, __ATOMIC_RELAXED, __HIP_MEMORY_SCOPE_AGENT);
            unsigned sp = 0;
            while ((unsigned)__builtin_amdgcn_readfirstlane(__hip_atomic_load(cnt + 64 * rb, __ATOMIC_RELAXED, __HIP_MEMORY_SCOPE_AGENT)) < 32u) { __builtin_amdgcn_s_sleep(2); if (++sp > (1u << 22)) break; }
            const unsigned* sl = slots + (size_t)(64 * rb + tid) * 32; float t = 0.f;
#pragma unroll 8
            for (int i = 0; i < 32; ++i) t += __uint_as_float(__hip_atomic_load(sl + i, __ATOMIC_RELAXED, __HIP_MEMORY_SCOPE_AGENT));
            S[tid] = 1.0f / sqrtf(t * (1.f / DM) + EPS); }
        __syncthreads();
        if constexpr (MODE == 0) { const float a2 = ((const float*)(F.ws + WS_A2))[(size_t)b * DM + c], s2 = mod[(size_t)b * NMOD + 3 * DM + c];
#pragma unroll
            for (int r = 0; r < 4; ++r) { const int lr = 16 * rt + 4 * l4 + r; const size_t row = (size_t)(MP + 64 * rb + lr); F.out[O_Y + row * DM + c] = v[r]; ((bf16*)(F.ws + WS_H))[row * DM + c] = (bf16)f2bf(v[r] * S[lr] * a2 + s2); }
        } else { const float fwc = F.in[IN_FNW][c];
#pragma unroll
            for (int r = 0; r < 4; ++r) { const int lr = 16 * rt + 4 * l4 + r; const size_t row = (size_t)(MP + 64 * rb + lr); F.out[O_Y + row * DM + c] = v[r] * S[lr] * fwc; } }
        __syncthreads();
    }
}

constexpr int N_PHASES = 8;
struct Args { const float* in[27]; float* out; unsigned char* ws; int ph_lo, ph_hi; };
__global__ void __launch_bounds__(NWAVES * 64, 2) hymba_fwd(Args args) {
    extern __shared__ __attribute__((aligned(16))) unsigned char lds[];
    Frame F;
    F.lds = (LAS unsigned char*)lds;
    F.tid = threadIdx.x; F.lane = F.tid & 63; F.wave = __builtin_amdgcn_readfirstlane(F.tid >> 6);
    F.G = gridDim.x; { const int bx = blockIdx.x; F.vcu = (F.G % 8 == 0) ? (bx % 8) * (F.G / 8) + bx / 8 : bx; }
#pragma unroll
    for (int i = 0; i < 27; ++i) F.in[i] = args.in[i];
    F.out = args.out; F.ws = args.ws;
    const int lo = args.ph_lo, hi = args.ph_hi;
    for (int u = F.tid; u < (LDS_BYTES - LDSCTL_OFF) / 4; u += NWAVES * 64) ((LAS unsigned*)(F.lds + LDSCTL_OFF))[u] = 0u;
    __syncthreads();
    XcdBarrier bar; bar.bar = (unsigned*)(F.ws + WS_CTL) + CW_BAR; bar.x = 0; bar.st = nullptr;
    if (hi - lo > 1) bar = xcd_barrier_post((unsigned*)(F.ws + WS_CTL) + CW_BAR, (volatile LAS unsigned*)(F.lds + MISC_OFF) + 8);
#ifndef PHASE_MASK
#define PHASE_MASK 0xff
#endif
#define IN(k) (((PHASE_MASK >> (k)) & 1) && lo <= (k) && (k) < hi)
#ifndef DOUBLE_MASK
#define DOUBLE_MASK 0
#endif
#ifndef THIN_SPLIT
#define THIN_SPLIT 1
#endif
#ifndef STAG5
#define STAG5 0
#endif
#ifndef STAG7
#define STAG7 0
#endif
#define STAGGER(ticks) do { if ((ticks) > 0 && ((F.vcu >> 2) & 1)) { const unsigned long long t0_ = __builtin_amdgcn_s_memrealtime(); while (__builtin_amdgcn_s_memrealtime() - t0_ < (unsigned long long)(ticks)) __builtin_amdgcn_s_sleep(8); } } while (0)
#define REPS(k) for (int rep_ = 0; rep_ < 1 + ((DOUBLE_MASK >> (k)) & 1); ++rep_)
#define SEAM(k) do { if (IN(k) && IN((k) + 1)) { xcd_barrier(bar); } } while (0)
    bf16* Hb = (bf16*)(F.ws + WS_H); bf16* PROJ = (bf16*)(F.ws + WS_PROJ); bf16* MIX = (bf16*)(F.ws + WS_MIX); bf16* HMID = (bf16*)(F.ws + WS_HMID);
    const float* mod = (const float*)(F.ws + WS_MOD);
    const bool thin_first = THIN_SPLIT && ((F.vcu >> 5) & 1);

    if (IN(0)) REPS(0) { p0_mod(F); p0_weights(F); } SEAM(0);
    if (IN(1)) REPS(1) { p_norm(F); } SEAM(1);
    if (IN(2)) REPS(2) {
        pg8::Gemm g{Hb, (const bf16*)(F.ws + WS_WIN), MP, NPROJ, DM}; pg8::ProjOrder S; S.init(MP, NPROJ, F.G, (int)blockIdx.x);
        pg8::EpiProj E{PROJ, F.out, O_PP, O_CP, O_PS, O_CS, (bf16*)(F.out + O_Y), F.in[IN_CONVW], F.in[IN_CONVB], MIX};
#ifdef PROBE_TWICE_P2
        { pg8::TwiceOrder S2; S2.init2(MP, NPROJ, F.G, (int)blockIdx.x); pg8::gemm_phase<pg8::EpiProj, pg8::TwiceOrder, true, true>(F.lds + RING_OFF, g, S2, E); }
#else
        if (thin_first) thin_proj(F);
        pg8::gemm_phase<pg8::EpiProj, pg8::ProjOrder, true, true>(F.lds + RING_OFF, g, S, E);
#endif
        if (!thin_first) thin_proj(F);
#ifdef THIN_TWICE
        thin_proj(F);
#endif
    } SEAM(2);
#ifndef POOL_REPS
#define POOL_REPS 1
#endif
#ifndef CONV_REPS
#define CONV_REPS 1
#endif
    if (IN(3)) REPS(3) { for (int r_ = 0; r_ < POOL_REPS; ++r_) p3_pool(F); for (int r_ = 0; r_ < CONV_REPS; ++r_) p3_conv(F); } SEAM(3);
    if (IN(4)) REPS(4) { p4_ssd(F); }
#ifdef AB_NO_KHOOK
    if (IN(4)) { xcd_barrier(bar); p4b_gnorm(F); }
#endif
    SEAM(4);
    if (IN(5)) REPS(5) {
        pg8::Gemm g{MIX, (const bf16*)(F.ws + WS_WOUT), MP, DM, MIXW}; pg8::PanelOrder S; S.init(MP, F.G, F.vcu);
        pg8::EpiResNorm<0> E{F.in[IN_XP], F.in[IN_XS], F.out + O_Y, (const float*)(F.ws + WS_BIASA), mod + 2 * DM,
                             (unsigned*)(F.ws + WS_XSL) + (size_t)rep_ * 2 * MT * 4, (unsigned*)(F.ws + WS_CTL) + CW_SEAM + rep_ * 2 * SEAM_BANK, F.lds + LDSX_OFF,
                             Hb, (const float*)(F.ws + WS_A2), mod + 3 * DM, (const float*)(F.ws + WS_SSQ), nullptr, MIX};
        if (thin_first) thin_resnorm<0>(F);
        pg8::gemm_phase<pg8::EpiResNorm<0>, pg8::PanelOrder, true, true>(F.lds + RING_OFF, g, S, E);
        if (!thin_first) thin_resnorm<0>(F);
    } SEAM(5);
    if (IN(6)) REPS(6) {
        pg8::Gemm g{Hb, (const bf16*)(F.ws + WS_W1), MP, DFF, DM}; pg8::StaticOrder S; S.init(MP, DFF, F.G, (int)blockIdx.x);
        pg8::EpiRelu2 E{HMID, F.in[IN_B1]};
#ifdef PROBE_TWICE_P6
        { pg8::TwiceOrder S2; S2.init2(MP, DFF, F.G, (int)blockIdx.x); pg8::gemm_phase<pg8::EpiRelu2, pg8::TwiceOrder, true, true>(F.lds + RING_OFF, g, S2, E); }
#else
        if (thin_first) thin_ff1(F);
        pg8::gemm_phase<pg8::EpiRelu2, pg8::StaticOrder, true, true>(F.lds + RING_OFF, g, S, E);
#endif
        if (!thin_first) thin_ff1(F);
#ifdef THIN_TWICE
        thin_ff1(F);
#endif
    } SEAM(6);
    if (IN(7)) REPS(7) {
        pg8::Gemm g{HMID, (const bf16*)(F.ws + WS_W2), MP, DM, DFF}; pg8::PanelOrder S; S.init(MP, F.G, F.vcu);
        float* yout = F.out + O_Y;
        pg8::EpiResNorm<1> E{F.out + O_Y, F.out + O_Y + (size_t)MP * DM, yout, F.in[IN_B2], mod + 5 * DM,
                             (unsigned*)(F.ws + WS_XSL) + (size_t)(1 + 2 * rep_) * MT * 4, (unsigned*)(F.ws + WS_CTL) + CW_SEAM + (1 + 2 * rep_) * SEAM_BANK, F.lds + LDSX_OFF,
                             nullptr, nullptr, nullptr, nullptr, F.in[IN_FNW], MIX};
        if (thin_first) thin_resnorm<1>(F);
        pg8::gemm_phase<pg8::EpiResNorm<1>, pg8::PanelOrder, true, true>(F.lds + RING_OFF, g, S, E);
        if (!thin_first) thin_resnorm<1>(F);
    }
#undef IN
#undef SEAM
}

#ifndef MK_ONE_LAUNCH
#define MK_ONE_LAUNCH 1
#endif
extern "C" void kernel_launch(void* const* d_in, const int* in_sizes, int n_in, void* d_out, int out_size, void* d_ws, size_t ws_size, hipStream_t stream) {
    static int grid = 0;
    if (grid == 0) {
        if (n_in != 27 || in_sizes[0] != MP * DM || (size_t)out_size != O_END || ws_size < WS_END) {
            fprintf(stderr, "kernel_launch: shape mismatch: n_in %d in0 %d out %d ws %zu (need %zu)\n", n_in, n_in > 0 ? in_sizes[0] : -1, out_size, ws_size, (size_t)WS_END); grid = -1; return; }
        int dev = 0, cus = 0, per_cu = 0;
        if (hipGetDevice(&dev) != hipSuccess || hipDeviceGetAttribute(&cus, hipDeviceAttributeMultiprocessorCount, dev) != hipSuccess) { grid = -1; return; }
        if (hipFuncSetAttribute((const void*)hymba_fwd, hipFuncAttributeMaxDynamicSharedMemorySize, LDS_BYTES) != hipSuccess) { fprintf(stderr, "kernel_launch: hipFuncSetAttribute failed\n"); grid = -1; return; }
        if (hipOccupancyMaxActiveBlocksPerMultiprocessor(&per_cu, (const void*)hymba_fwd, NWAVES * 64, LDS_BYTES) != hipSuccess || per_cu < 1) { fprintf(stderr, "kernel_launch: occupancy query says %d blocks per CU\n", per_cu); per_cu = 1; }
        (void)hipGetLastError();
        grid = cus;
        if (grid > cus * per_cu) grid = cus * per_cu;
    }
    if (grid < 0) return;
    Args a{};
    for (int i = 0; i < 27; ++i) a.in[i] = (const float*)d_in[i];
    a.out = (float*)d_out; a.ws = (unsigned char*)d_ws;
#if MK_ONE_LAUNCH
    a.ph_lo = 0; a.ph_hi = N_PHASES;
    if (hipMemsetAsync((char*)d_ws + WS_CTL, 0, CTL_ZERO_BYTES, stream) != hipSuccess) { fprintf(stderr, "kernel_launch: hipMemsetAsync failed\n"); return; }
    hipLaunchKernelGGL(hymba_fwd, dim3(grid), dim3(NWAVES * 64), LDS_BYTES, stream, a);
    { const hipError_t le = hipPeekAtLastError(); if (le != hipSuccess) fprintf(stderr, "kernel_launch: launch failed: %s (grid %d)\n", hipGetErrorName(le), grid); }
#else
    for (int p = 0; p < N_PHASES; ++p) { a.ph_lo = p; a.ph_hi = p + 1;
        hipLaunchKernelGGL(hymba_fwd, dim3(grid), dim3(NWAVES * 64), LDS_BYTES, stream, a);
        const hipError_t le = hipPeekAtLastError(); if (le != hipSuccess) { fprintf(stderr, "kernel_launch: launch %d failed: %s\n", p, hipGetErrorName(le)); break; } }
#endif
}
```
